# Optimizing an MI355X kernel written in HIP

```python
import math
import jax
import jax.numpy as jnp
from jax import lax
import numpy as np

D_MODEL = 1024
BATCH = 8
SEQ = 2048
DEPTH = 2

GRID_W = 64
CTX_LEN = 256
N_EVEN = (DEPTH + 1) // 2
N_ODD = DEPTH // 2
EPS = 1e-6
NEG_INF = -1e30
BLOCK = 128
ROPE_BASE = 10000.0
HY_CH = D_MODEL // 2
HY_ORDER = 2
HY_EMB = 33
HY_FILT_HID = 64
HY_MAX_DECAY = math.log(1e-2) / 0.3
HY_MIN_DECAY = math.log(1e-2) / 1.5
DA_HEADS = 4
DA_HD = D_MODEL // 16
RET_HEADS = 4
RET_DK = D_MODEL // 8
RET_DV = D_MODEL // 8
RET_CHUNK = 128
GQ_KV = 2
GQ_GROUP = 4
GQ_HD = D_MODEL // 16
WINDOW = 128
N_GROUPS = 4
EXP_PER_GROUP = 8
TOP_K = 2
D_EXPERT = D_MODEL // 4

E_SPLIT = (3 * HY_CH, DA_HEADS * 2 * DA_HD, DA_HEADS * 2 * DA_HD, DA_HEADS * 2 * DA_HD)
E_IN = sum(E_SPLIT)
E_MIX = HY_CH + DA_HEADS * 2 * DA_HD
O_SPLIT = (RET_HEADS * RET_DK, RET_HEADS * RET_DK, RET_HEADS * RET_DV, RET_HEADS * RET_DV,
           GQ_KV * GQ_GROUP * GQ_HD, GQ_KV * GQ_HD, GQ_KV * GQ_HD)
O_IN = sum(O_SPLIT)
O_MIX = RET_HEADS * RET_DV + GQ_KV * GQ_GROUP * GQ_HD

kernel_name = "hybrid_hyena_diffattn_retention_swa_hmoe_dit"

f32 = jnp.float32


def split_cols(t, sizes):
    return jnp.split(t, [int(i) for i in np.cumsum(sizes)[:-1]], axis=-1)


def rms_norm(x):
    xf = x.astype(f32)
    return (xf * lax.rsqrt(jnp.mean(xf * xf, axis=-1, keepdims=True) + EPS)).astype(x.dtype)


def modulate(x, shift, scale):
    return x * (1 + scale) + shift


def axial_rope(rows, head_dim):
    row = jnp.repeat(jnp.arange(rows), GRID_W).astype(f32)
    col = jnp.tile(jnp.arange(GRID_W), rows).astype(f32)
    nf = head_dim // 4
    inv = ROPE_BASE ** (-jnp.arange(nf, dtype=f32) / nf)
    ang = jnp.stack([row[:, None] * inv, col[:, None] * inv], axis=1)
    return jnp.cos(ang), jnp.sin(ang)


def apply_axial_rope(x, cos, sin):
    shp = x.shape
    d = shp[-1]
    xr = x.astype(f32).reshape(shp[:-1] + (2, 2, d // 4))
    x1, x2 = xr[..., 0, :], xr[..., 1, :]
    bshape = (cos.shape[0],) + (1,) * (x.ndim - 3) + cos.shape[1:]
    c, s = cos.reshape(bshape), sin.reshape(bshape)
    out = jnp.stack([x1 * c - x2 * s, x2 * c + x1 * s], axis=-2)
    return out.reshape(shp).astype(x.dtype)


def seq_rope(n_tok, head_dim):
    inv = 1.0 / (ROPE_BASE ** jnp.linspace(0.0, 1.0, head_dim // 2, dtype=f32))
    ang = jnp.arange(n_tok, dtype=f32)[:, None] * inv
    return jnp.cos(ang), jnp.sin(ang)


def apply_rope_1d(x, cos, sin):
    x1, x2 = jnp.split(x.astype(f32), 2, axis=-1)
    c, s = cos[:, None, :], sin[:, None, :]
    return jnp.concatenate([x1 * c - x2 * s, x2 * c + x1 * s], axis=-1).astype(x.dtype)


def depthwise_conv3(u, w, b):
    y = lax.conv_general_dilated(u, w[:, None, :].astype(u.dtype), window_strides=(1,),
                                 padding=((1, 1),), dimension_numbers=('NWC', 'WIO', 'NWC'),
                                 feature_group_count=u.shape[-1])
    return y + b


def hyena_filters(L, w1, b1, w2, b2, w3, freq):
    bands = (HY_EMB - 1) // 2
    t = jnp.linspace(0.0, 1.0, L, dtype=f32)[:, None]
    w = (2.0 * math.pi / L) * jnp.arange(L, dtype=f32)[:, None]
    fb = jnp.linspace(1e-4, bands - 1, bands, dtype=f32)[None, :]
    z = jnp.concatenate([t, jnp.cos(fb * w), -jnp.sin(fb * w)], axis=-1)
    h = jnp.sin(freq[0] * (z @ w1 + b1))
    h = jnp.sin(freq[1] * (h @ w2 + b2))
    h = (h @ w3).astype(f32).reshape(L, HY_ORDER, 2, HY_CH)
    deltas = jnp.abs(jnp.linspace(HY_MIN_DECAY, HY_MAX_DECAY, HY_CH, dtype=f32))
    h = h * jnp.exp(-t * deltas)[:, None, None, :]
    fwd, bwd = h[:, :, 0], h[:, :, 1]
    full = jnp.concatenate([fwd, jnp.zeros_like(fwd[:1]), bwd[:0:-1]], axis=0)
    return jnp.fft.rfft(full, axis=0)


def hyena_mixer(u, conv_w, conv_b, filt_f, bias):
    L = u.shape[1]
    u = depthwise_conv3(u, conv_w, conv_b)
    v, x1, x2 = jnp.split(u, 3, axis=-1)
    z = v.astype(f32)
    for n, gate in enumerate((x1, x2)):
        zf = jnp.fft.rfft(z, n=2 * L, axis=1)
        z = jnp.fft.irfft(zf * filt_f[None, :, n, :], n=2 * L, axis=1)[:, :L] + z * bias[n].astype(f32)
        z = gate.astype(f32) * z
    return z.astype(u.dtype)


def diff_attention(q_l, k_l, v_l, q_c, k_c, v_c, lam, lam_init, subln):
    B, S = q_l.shape[:2]
    nb = S // BLOCK
    keys = jnp.concatenate([k_c, k_l], axis=1)
    vals = jnp.concatenate([v_c, v_l], axis=1)

    def attend(qb, kk, vv):
        s = jnp.einsum('bqhmd,bkhmd->bhmqk', qb, kk).astype(f32)
        p = jax.nn.softmax(s, axis=-1)
        a = p[:, :, 0] - lam * p[:, :, 1]
        return jnp.einsum('bhqk,bkhe->bqhe', a.astype(vv.dtype), vv)

    qb = jnp.moveaxis(q_l.reshape((B, nb, BLOCK) + q_l.shape[2:]), 1, 0)
    o = lax.map(lambda qq: attend(qq, keys, vals), qb)
    o_l = jnp.moveaxis(o, 0, 1).reshape((B, S) + o.shape[3:])

    def post(o):
        return (rms_norm(o) * subln * (1.0 - lam_init)).reshape(o.shape[:2] + (-1,))

    o_c = post(attend(q_c, k_c, v_c)) if q_c is not None else None
    return post(o_l), o_c


def sink_softmax(sink, *scores):
    sk = jnp.broadcast_to(sink, scores[0].shape[:-1] + (1,))
    p = jax.nn.softmax(jnp.concatenate((sk,) + scores, axis=-1), axis=-1)
    sizes = [t.shape[-1] for t in scores]
    return jnp.split(p[..., 1:], [int(i) for i in np.cumsum(sizes)[:-1]], axis=-1)


def window_gqa(q_l, k_l, v_l, q_c, k_c, v_c, sink):
    B, S = q_l.shape[:2]
    nb = S // BLOCK

    def bands(t):
        tp = jnp.pad(t, ((0, 0), (BLOCK, BLOCK), (0, 0), (0, 0))).reshape(B, nb + 2, BLOCK, GQ_KV, GQ_HD)
        w = jnp.concatenate([tp[:, :-2], tp[:, 1:-1], tp[:, 2:]], axis=2)
        return jnp.moveaxis(w, 1, 0)

    kw, vw = bands(k_l), bands(v_l)
    qb = jnp.moveaxis(q_l.reshape(B, nb, BLOCK, GQ_KV, GQ_GROUP, GQ_HD), 1, 0)
    i = jnp.arange(BLOCK)[:, None]
    j = jnp.arange(3 * BLOCK)[None, :]
    kpos = (jnp.arange(nb) * BLOCK)[:, None, None] - BLOCK + j[None]
    mask = (jnp.abs(j - BLOCK - i) <= WINDOW)[None] & (kpos >= 0) & (kpos < S)
    sink_col = sink.astype(f32).reshape(GQ_KV, GQ_GROUP, 1, 1)

    def block(args):
        qq, kk, vv, mm = args
        s_ctx = jnp.einsum('bqkgd,bckd->bkgqc', qq, k_c).astype(f32)
        s_loc = jnp.where(mm, jnp.einsum('bqkgd,bjkd->bkgqj', qq, kk).astype(f32), NEG_INF)
        p_ctx, p_loc = sink_softmax(sink_col, s_ctx, s_loc)
        return (jnp.einsum('bkgqc,bckd->bqkgd', p_ctx.astype(v_c.dtype), v_c)
                + jnp.einsum('bkgqj,bjkd->bqkgd', p_loc.astype(vv.dtype), vv))

    o = lax.map(block, (qb, kw, vw, mask))
    o_l = jnp.moveaxis(o, 0, 1).reshape(B, S, -1)
    o_c = None
    if q_c is not None:
        s = jnp.einsum('bqkgd,bckd->bkgqc', q_c, k_c).astype(f32)
        (p,) = sink_softmax(sink_col, s)
        o_c = jnp.einsum('bkgqc,bckd->bqkgd', p.astype(v_c.dtype), v_c).reshape(q_c.shape[0], q_c.shape[1], -1)
    return o_l, o_c


def retention_scan(q, k, v, log_g, s0):
    B, L, H, dk = k.shape
    dv = v.shape[-1]
    n = L // RET_CHUNK
    kc = k.reshape(B, n, RET_CHUNK, H, dk)
    vc = v.reshape(B, n, RET_CHUNK, H, dv)
    idx = jnp.arange(RET_CHUNK, dtype=f32)
    zeta = jnp.exp((RET_CHUNK - 1 - idx)[:, None] * log_g[None, :])
    u = jnp.einsum('bnjhd,jh,bnjhe->bnhde', kc, zeta, vc)
    g_chunk = jnp.exp(RET_CHUNK * log_g)[None, :, None, None]

    def step(s, u_i):
        return g_chunk * s + u_i, s

    s_fin, s_prev = lax.scan(step, s0, jnp.moveaxis(u, 1, 0))
    if q is None:
        return None, s_fin
    qc = q.reshape(B, n, RET_CHUNK, H, dk)
    rel = idx[:, None] - idx[None, :]
    dmat = jnp.where(rel >= 0, jnp.exp(jnp.maximum(rel, 0.0)[None] * log_g[:, None, None]), 0.0)
    att = jnp.einsum('bnihd,bnjhd->bnhij', qc, kc) * dmat
    o = jnp.einsum('bnhij,bnjhe->bnihe', att, vc)
    xi = jnp.exp((idx + 1)[:, None] * log_g[None, :])
    o = o + jnp.einsum('bnihd,nbhde->bnihe', qc, s_prev) * xi[None, None, :, :, None]
    return o.reshape(B, L, H, dv), s_fin


def bidir_retention(q_l, k_l, v_l, q_c, k_c, v_c, decay):
    lg = jax.nn.log_sigmoid(decay.astype(f32))
    cast = lambda t: None if t is None else t.astype(f32)
    flip = lambda t: None if t is None else t[:, ::-1]
    q_l, k_l, v_l, q_c, k_c, v_c = map(cast, (q_l, k_l, v_l, q_c, k_c, v_c))
    B, _, H, dk = k_l.shape
    s0 = jnp.zeros((B, H, dk, v_l.shape[-1]), f32)
    o_cf, s_cf = retention_scan(q_c, k_c, v_c, lg[0], s0)
    o_cb, s_cb = retention_scan(flip(q_c), flip(k_c), flip(v_c), lg[1], s0)
    o_lf, _ = retention_scan(q_l, k_l, v_l, lg[0], s_cf)
    o_lb, _ = retention_scan(flip(q_l), flip(k_l), flip(v_l), lg[1], s_cb)
    o_c = o_cf + flip(o_cb) if q_c is not None else None
    return o_lf + flip(o_lb), o_c


def retention_out(o, g, gn_w):
    B, L, H, dv = o.shape
    mu = jnp.mean(o, axis=-1, keepdims=True)
    var = jnp.mean(jnp.square(o - mu), axis=-1, keepdims=True)
    o = ((o - mu) * lax.rsqrt(var + EPS)).reshape(B, L, H * dv)
    return (o * gn_w.astype(f32) * jax.nn.silu(g.astype(f32))).astype(g.dtype)


def even_mixer(ul, uc, need_ctx, lam_init, w_in, w_out, conv_w, conv_b, f_w1, f_b1, f_w2, f_b2, f_w3,
               f_freq, hy_b, q_norm, k_norm, lam_p, subln, cos_ax, sin_ax):
    B, S, _ = ul.shape
    C = uc.shape[1]
    hy_l, q_l, k_l, v_l = split_cols(ul @ w_in, E_SPLIT)
    hy_c, q_c, k_c, v_c = split_cols(uc @ w_in, E_SPLIT)
    y_hy_l = hyena_mixer(hy_l, conv_w, conv_b, hyena_filters(S, f_w1, f_b1, f_w2, f_b2, f_w3, f_freq), hy_b)
    qk = lambda t, g, L: rms_norm(t.reshape(B, L, DA_HEADS, 2, DA_HD)) * g
    scale = DA_HD ** -0.5
    lam_p = lam_p.astype(f32)
    lam = jnp.exp(jnp.sum(lam_p[0] * lam_p[1])) - jnp.exp(jnp.sum(lam_p[2] * lam_p[3])) + lam_init
    ql = apply_axial_rope(qk(q_l, q_norm, S), cos_ax, sin_ax) * scale
    kl = apply_axial_rope(qk(k_l, k_norm, S), cos_ax, sin_ax)
    kc = qk(k_c, k_norm, C)
    vl = v_l.reshape(B, S, DA_HEADS, 2 * DA_HD)
    vc = v_c.reshape(B, C, DA_HEADS, 2 * DA_HD)
    qc = qk(q_c, q_norm, C) * scale if need_ctx else None
    o_l, o_c = diff_attention(ql, kl, vl, qc, kc, vc, lam, lam_init, subln)
    out_l = jnp.concatenate([y_hy_l, o_l], axis=-1) @ w_out
    out_c = None
    if need_ctx:
        y_hy_c = hyena_mixer(hy_c, conv_w, conv_b, hyena_filters(C, f_w1, f_b1, f_w2, f_b2, f_w3, f_freq), hy_b)
        out_c = jnp.concatenate([y_hy_c, o_c], axis=-1) @ w_out
    return out_l, out_c


def odd_mixer(ul, uc, need_ctx, w_in, w_out, decay, gn_w, q_norm, k_norm, sink, cos_ax, sin_ax, cos_rt, sin_rt):
    B, S, _ = ul.shape
    C = uc.shape[1]
    rq_l, rk_l, rv_l, rg_l, gq_l, gk_l, gv_l = split_cols(ul @ w_in, O_SPLIT)
    rq_c, rk_c, rv_c, rg_c, gq_c, gk_c, gv_c = split_cols(uc @ w_in, O_SPLIT)
    hd = lambda t, L, d: t.reshape(B, L, RET_HEADS, d)
    rscale = RET_DK ** -0.5
    rql = apply_rope_1d(hd(rq_l, S, RET_DK), cos_rt, sin_rt)
    rkl = apply_rope_1d(hd(rk_l, S, RET_DK), cos_rt, sin_rt) * rscale
    rqc = hd(rq_c, C, RET_DK) if need_ctx else None
    o_rl, o_rc = bidir_retention(rql, rkl, hd(rv_l, S, RET_DV), rqc, hd(rk_c, C, RET_DK) * rscale,
                                 hd(rv_c, C, RET_DV), decay)
    y_rl = retention_out(o_rl, rg_l, gn_w)
    gscale = GQ_HD ** -0.5
    gql = apply_axial_rope(rms_norm(gq_l.reshape(B, S, GQ_KV, GQ_GROUP, GQ_HD)) * q_norm, cos_ax, sin_ax) * gscale
    gkl = apply_axial_rope(rms_norm(gk_l.reshape(B, S, GQ_KV, GQ_HD)) * k_norm, cos_ax, sin_ax)
    gkc = rms_norm(gk_c.reshape(B, C, GQ_KV, GQ_HD)) * k_norm
    gqc = rms_norm(gq_c.reshape(B, C, GQ_KV, GQ_GROUP, GQ_HD)) * q_norm * gscale if need_ctx else None
    y_gl, y_gc = window_gqa(gql, gkl, gv_l.reshape(B, S, GQ_KV, GQ_HD), gqc, gkc,
                            gv_c.reshape(B, C, GQ_KV, GQ_HD), sink)
    out_l = jnp.concatenate([y_rl, y_gl], axis=-1) @ w_out
    out_c = None
    if need_ctx:
        out_c = jnp.concatenate([retention_out(o_rc, rg_c, gn_w), y_gc], axis=-1) @ w_out
    return out_l, out_c


def hier_moe(t, w_grp, b_grp, w_rt, b_rt, w_gate, w_up, w_down):
    n_tok = t.shape[0]
    lg = (t @ w_grp + b_grp).astype(f32)
    pg = jax.nn.softmax(lg, axis=-1)
    oh_g = jax.nn.one_hot(jnp.argmax(lg, axis=-1), N_GROUPS, dtype=f32)
    le = (t @ w_rt + b_rt).astype(f32).reshape(n_tok, N_GROUPS, EXP_PER_GROUP)
    le_sel = jnp.einsum('tge,tg->te', le, oh_g)
    top_v, top_i = lax.top_k(le_sel, TOP_K)
    w = jax.nn.softmax(top_v, axis=-1) * jnp.max(pg, axis=-1, keepdims=True)
    comb_e = jnp.einsum('tke,tk->te', jax.nn.one_hot(top_i, EXP_PER_GROUP, dtype=f32), w)
    comb = (oh_g[:, :, None] * comb_e[:, None, :]).astype(t.dtype)
    out = jnp.zeros_like(t)
    for g in range(N_GROUPS):
        a = jax.nn.silu(jnp.einsum('td,edf->tef', t, w_gate[g])) * jnp.einsum('td,edf->tef', t, w_up[g])
        out = out + jnp.einsum('tef,efd->td', a * comb[:, g, :, None], w_down[g])
    return out


def setup_inputs(seed: int = 0) -> dict:
    key = jax.random.key(seed)
    ks = iter(jax.random.split(key, 64))

    def nrm(shape, std):
        return jax.random.normal(next(ks), shape, jnp.float32) * std

    D = D_MODEL
    G, E, F = N_GROUPS, EXP_PER_GROUP, D_EXPERT
    ret_base = jnp.log(jnp.exp2(5.0 + jnp.arange(RET_HEADS, dtype=jnp.float32)) - 1.0)
    return {
        "x": nrm((BATCH, SEQ, D), 1.0),
        "c": nrm((BATCH, D), 1.0),
        "ctx": nrm((BATCH, CTX_LEN, D), 1.0),
        "c_ctx": nrm((D,), 1.0),
        "ada_w": nrm((DEPTH, D, 6 * D), 0.5 * D ** -0.5),
        "ada_b": nrm((DEPTH, 6 * D), 0.02),
        "e_w_in": nrm((N_EVEN, D, E_IN), D ** -0.5),
        "e_w_out": nrm((N_EVEN, E_MIX, D), E_MIX ** -0.5),
        "hy_conv_w": nrm((N_EVEN, 3, 3 * HY_CH), 3 ** -0.5),
        "hy_conv_b": nrm((N_EVEN, 3 * HY_CH), 0.02),
        "hy_f_w1": nrm((N_EVEN, HY_EMB, HY_FILT_HID), HY_EMB ** -0.5),
        "hy_f_b1": nrm((N_EVEN, HY_FILT_HID), 0.1),
        "hy_f_w2": nrm((N_EVEN, HY_FILT_HID, HY_FILT_HID), HY_FILT_HID ** -0.5),
        "hy_f_b2": nrm((N_EVEN, HY_FILT_HID), 0.1),
        "hy_f_w3": nrm((N_EVEN, HY_FILT_HID, HY_ORDER * 2 * HY_CH), 0.05 * HY_FILT_HID ** -0.5),
        "hy_f_freq": 1.0 + nrm((N_EVEN, 2, HY_FILT_HID), 0.1),
        "hy_bias": nrm((N_EVEN, HY_ORDER, HY_CH), 0.1),
        "da_q_norm": 1.0 + nrm((N_EVEN, DA_HD), 0.02),
        "da_k_norm": 1.0 + nrm((N_EVEN, DA_HD), 0.02),
        "da_lam": nrm((N_EVEN, 4, DA_HD), 0.1),
        "da_subln": 1.0 + nrm((N_EVEN, 2 * DA_HD), 0.02),
        "o_w_in": nrm((N_ODD, D, O_IN), D ** -0.5),
        "o_w_out": nrm((N_ODD, O_MIX, D), O_MIX ** -0.5),
        "ret_decay": ret_base[None, None, :] + nrm((N_ODD, 2, RET_HEADS), 0.1),
        "ret_gn": 1.0 + nrm((N_ODD, RET_HEADS * RET_DV), 0.02),
        "gq_q_norm": 1.0 + nrm((N_ODD, GQ_HD), 0.02),
        "gq_k_norm": 1.0 + nrm((N_ODD, GQ_HD), 0.02),
        "gq_sink": nrm((N_ODD, GQ_KV * GQ_GROUP), 0.5),
        "moe_w_grp": nrm((DEPTH, D, G), D ** -0.5),
        "moe_b_grp": nrm((DEPTH, G), 0.01),
        "moe_w_rt": nrm((DEPTH, D, G * E), D ** -0.5),
        "moe_b_rt": nrm((DEPTH, G * E), 0.01),
        "moe_w_gate": nrm((DEPTH, G, E, D, F), D ** -0.5),
        "moe_w_up": nrm((DEPTH, G, E, D, F), D ** -0.5),
        "moe_w_down": nrm((DEPTH, G, E, F, D), F ** -0.5),
    }


def reference(x, c, ctx, c_ctx, ada_w, ada_b, e_w_in, e_w_out, hy_conv_w, hy_conv_b, hy_f_w1, hy_f_b1,
              hy_f_w2, hy_f_b2, hy_f_w3, hy_f_freq, hy_bias, da_q_norm, da_k_norm, da_lam, da_subln,
              o_w_in, o_w_out, ret_decay, ret_gn, gq_q_norm, gq_k_norm, gq_sink, moe_w_grp, moe_b_grp,
              moe_w_rt, moe_b_rt, moe_w_gate, moe_w_up, moe_w_down):
    B, S, D = x.shape
    C = ctx.shape[1]
    ROWS = S // GRID_W
    cos_da, sin_da = axial_rope(ROWS, DA_HD)
    cos_gq, sin_gq = axial_rope(ROWS, GQ_HD)
    cos_rt, sin_rt = seq_rope(S, RET_DK)
    silu_c = jax.nn.silu(c)
    silu_cc = jax.nn.silu(c_ctx)
    hl, hc = x, ctx
    for l in range(DEPTH):
        last = l == DEPTH - 1
        i = l // 2
        mod_l = (silu_c @ ada_w[l] + ada_b[l])[:, None, :]
        mod_c = (silu_cc @ ada_w[l] + ada_b[l])[None, None, :]
        sh1, sc1, g1, sh2, sc2, g2 = jnp.split(mod_l, 6, axis=-1)
        csh1, csc1, cg1, csh2, csc2, cg2 = jnp.split(mod_c, 6, axis=-1)
        ul = modulate(rms_norm(hl), sh1, sc1)
        uc = modulate(rms_norm(hc), csh1, csc1)
        if l % 2 == 0:
            lam_init = 0.8 - 0.6 * math.exp(-0.3 * l)
            ml, mc = even_mixer(ul, uc, not last, lam_init, e_w_in[i], e_w_out[i], hy_conv_w[i], hy_conv_b[i],
                                hy_f_w1[i], hy_f_b1[i], hy_f_w2[i], hy_f_b2[i], hy_f_w3[i], hy_f_freq[i],
                                hy_bias[i], da_q_norm[i], da_k_norm[i], da_lam[i], da_subln[i], cos_da, sin_da)
        else:
            ml, mc = odd_mixer(ul, uc, not last, o_w_in[i], o_w_out[i], ret_decay[i], ret_gn[i],
                               gq_q_norm[i], gq_k_norm[i], gq_sink[i], cos_gq, sin_gq, cos_rt, sin_rt)
        hl = hl + g1 * ml
        vl = modulate(rms_norm(hl), sh2, sc2).reshape(B * S, D)
        moe_args = (moe_w_grp[l], moe_b_grp[l], moe_w_rt[l], moe_b_rt[l], moe_w_gate[l], moe_w_up[l], moe_w_down[l])
        if last:
            hl = hl + g2 * hier_moe(vl, *moe_args).reshape(B, S, D)
        else:
            hc = hc + cg1 * mc
            vc = modulate(rms_norm(hc), csh2, csc2).reshape(B * C, D)
            y = hier_moe(jnp.concatenate([vl, vc], axis=0), *moe_args)
            hl = hl + g2 * y[:B * S].reshape(B, S, D)
            hc = hc + cg2 * y[B * S:].reshape(B, C, D)
    return hl
```

```cpp
#include <hip/hip_runtime.h>
#include <cstdint>
#include <cstdio>

#ifndef MK_PER_PHASE
#define MK_PER_PHASE 0
#endif

#define DI __device__ __forceinline__
#define GAS __attribute__((address_space(1)))
#define LAS __attribute__((address_space(3)))
typedef float f32x4 __attribute__((ext_vector_type(4)));

constexpr int D = 1024, NB = 8, S = 2048, C = 256;
constexpr int MLAT = NB * S, MCTX = NB * C, MALL = MLAT + MCTX;
constexpr int E_IN = 3072, O_IN = 2816;
constexpr int NTHR = 512, NWAVES = 8;
constexpr float EPS = 1e-6f;
constexpr int LDS_BYTES = 147456;

enum { I_X = 0, I_C, I_CTX, I_CCTX, I_ADAW, I_ADAB, I_EWIN, I_EWOUT, I_HYCW, I_HYCB, I_HYW1, I_HYB1, I_HYW2, I_HYB2, I_HYW3, I_HYFREQ, I_HYBIAS,
       I_DAQN, I_DAKN, I_DALAM, I_DASUB, I_OWIN, I_OWOUT, I_RETDEC, I_RETGN, I_GQQN, I_GQKN, I_GQSINK, I_MWGRP, I_MBGRP, I_MWRT, I_MBRT, I_MWG, I_MWU, I_MWD, N_IN };

constexpr size_t MiB = 1u << 20;
constexpr size_t WS_CTL = 0, CTL_ZERO_BYTES = 64 * 1024;
constexpr size_t WS_MOD = 1 * MiB;
constexpr size_t WS_RSTD = WS_MOD + 512 * 1024;
constexpr size_t WS_HFL = 2 * MiB;
constexpr size_t WS_HFC = WS_HFL + 16 * MiB;
constexpr size_t WS_HC = WS_HFC + 2 * MiB;
constexpr size_t WS_U = WS_HC + 8 * MiB;
constexpr size_t WS_MIX = WS_U + 216 * MiB;
constexpr size_t WS_END = WS_MIX + 72 * MiB;
static_assert((size_t)MALL * 3072 * 4 <= 216 * MiB && (size_t)MALL * D * 4 <= 72 * MiB, "ws map");

struct Args { const float* in[N_IN]; float* out; unsigned char* ws; int ph_lo, ph_hi; };

DI float wave_sum(float v) {
#pragma unroll
    for (int o = 32; o > 0; o >>= 1) v += __shfl_xor(v, o);
    return v;
}
DI float wave_max(float v) {
#pragma unroll
    for (int o = 32; o > 0; o >>= 1) v = fmaxf(v, __shfl_xor(v, o));
    return v;
}
DI float silu_f(float x) { return x / (1.f + expf(-x)); }
DI int otid() { int t = threadIdx.x; asm volatile("" : "+v"(t)); return t; }

#define XB_TMO      128
#define XB_XCNT(j)  (256  + 64 * (j))
#define XB_XSUB(j)  (1280 + 64 * (j))
#define XB_XGEN(j)  (2304 + 64 * (j))
#define XB_TOP      3328
#define XB_TOPGEN   3392
#define XCD_BAR_WORDS 3456
#define XB_SPIN_CAP (1u << 22)
DI unsigned xb_ld(unsigned* p)              { return __hip_atomic_load(p, __ATOMIC_RELAXED, __HIP_MEMORY_SCOPE_AGENT); }
DI unsigned xb_add(unsigned* p, unsigned v) { return __hip_atomic_fetch_add(p, v, __ATOMIC_RELAXED, __HIP_MEMORY_SCOPE_AGENT); }
DI unsigned xb_xcc_id() { return (unsigned)__builtin_amdgcn_s_getreg((3 << 11) | 20) & 0xFu; }
#define XB_SPIN(cond, bar) do { unsigned _sp = 0; while (cond) { __builtin_amdgcn_s_sleep(1); \
    if ((++_sp & 255u) == 0u) { if (xb_ld(&(bar)[XB_TMO])) break; if (_sp > XB_SPIN_CAP) { atomicAdd(&(bar)[XB_TMO], 1u); break; } } } } while (0)
struct XcdBarrier { unsigned* bar; unsigned x; volatile LAS unsigned* st; };
DI XcdBarrier xcd_barrier_post(unsigned* bar, volatile LAS unsigned* st) {
    XcdBarrier b; b.bar = bar; b.x = xb_xcc_id(); b.st = st;
    if (threadIdx.x == 0) (void)xb_add(&bar[XB_XCNT(b.x)], 1u);
    return b;
}
DI void xcd_barrier_complete(unsigned* bar, unsigned x, unsigned& nloc, unsigned& nx) {
    const unsigned G = gridDim.x * gridDim.y * gridDim.z;
    unsigned sum, cnt, mine, sp = 0u;
    for (;;) {
        sum = 0u; cnt = 0u; mine = 0u;
#pragma unroll
        for (unsigned j = 0; j < 16; ++j) { const unsigned c = xb_ld(&bar[XB_XCNT(j)]); sum += c; cnt += (c > 0u) ? 1u : 0u; mine = (j == x) ? c : mine; }
        if (sum == G) break;
        __builtin_amdgcn_s_sleep(1);
        if ((++sp & 255u) == 0u) { if (xb_ld(&bar[XB_TMO])) break; if (sp > XB_SPIN_CAP) { atomicAdd(&bar[XB_TMO], 1u); break; } }
    }
    nloc = mine > 0u ? mine : 1u; nx = cnt > 0u ? cnt : 1u;
}
DI void xcd_barrier(const XcdBarrier& b) {
    asm volatile("s_waitcnt vmcnt(0)" ::: "memory");
    __syncthreads();
    if (threadIdx.x == 0) {
        unsigned* bar = b.bar;
        __builtin_amdgcn_s_waitcnt(0);
        unsigned nloc = b.st[0], nx = b.st[1];
        if (nloc == 0u) { xcd_barrier_complete(bar, b.x, nloc, nx); b.st[0] = nloc; b.st[1] = nx; }
        const unsigned old = xb_add(&bar[XB_XSUB(b.x)], 1u);
        const unsigned gen = old / nloc;
        if (old + 1u == (gen + 1u) * nloc) {
            __builtin_amdgcn_fence(__ATOMIC_RELEASE, "agent");
            asm volatile("s_waitcnt vmcnt(0)" ::: "memory");
            const unsigned og = xb_add(&bar[XB_TOP], 1u);
            const unsigned tg = og / nx;
            if (og + 1u == (tg + 1u) * nx) xb_add(&bar[XB_TOPGEN], 1u);
            else XB_SPIN(xb_ld(&bar[XB_TOPGEN]) == tg, bar);
            __builtin_amdgcn_fence(__ATOMIC_ACQUIRE, "agent");
            xb_add(&bar[XB_XGEN(b.x)], 1u);
            asm volatile("s_waitcnt vmcnt(0)" ::: "memory");
        } else {
            XB_SPIN(xb_ld(&bar[XB_XGEN(b.x)]) == gen, bar);
            __builtin_amdgcn_fence(__ATOMIC_ACQUIRE, "agent");
            asm volatile("s_waitcnt vmcnt(0)" ::: "memory");
        }
    }
    __syncthreads();
}

DI void ph_init(const Args& a, float* lds, int bid, int nb) {
    const int tid = otid();
    float* mod = (float*)(a.ws + WS_MOD);
    float* sv = lds;
    float* red = lds + 9 * 1024;
    for (int i = tid; i < 9 * 1024; i += NTHR) { const int r = i >> 10, k = i & 1023; const float x = r < 8 ? a.in[I_C][r * D + k] : a.in[I_CCTX][k]; sv[i] = silu_f(x); }
    __syncthreads();
    for (int it = bid; it < 2 * 96; it += nb) {
        const int l = it / 96, n0 = (it % 96) * 64;
        const int cg = tid & 15, kr = tid >> 4;
        float acc[9][4];
#pragma unroll
        for (int r = 0; r < 9; ++r) { acc[r][0] = acc[r][1] = acc[r][2] = acc[r][3] = 0.f; }
        const float* W = a.in[I_ADAW] + (size_t)l * D * 6144 + n0 + cg * 4;
#pragma unroll 2
        for (int k = kr; k < D; k += 32) {
            const f32x4 w = *(const f32x4*)(W + (size_t)k * 6144);
#pragma unroll
            for (int r = 0; r < 9; ++r) { const float s = sv[r * 1024 + k]; acc[r][0] += s * w.x; acc[r][1] += s * w.y; acc[r][2] += s * w.z; acc[r][3] += s * w.w; }
        }
#pragma unroll
        for (int r = 0; r < 9; ++r)
#pragma unroll
            for (int j = 0; j < 4; ++j) red[(kr * 9 + r) * 64 + cg * 4 + j] = acc[r][j];
        __syncthreads();
        for (int o = tid; o < 9 * 64; o += NTHR) {
            const int r = o >> 6, c = o & 63; float s = 0.f;
#pragma unroll 4
            for (int q = 0; q < 32; ++q) s += red[(q * 9 + r) * 64 + c];
            mod[((size_t)l * 9 + r) * 6144 + n0 + c] = s + a.in[I_ADAB][l * 6144 + n0 + c];
        }
        __syncthreads();
    }
    {
        const f32x4* x4 = (const f32x4*)a.in[I_X]; f32x4* o4 = (f32x4*)a.out;
        for (size_t i = (size_t)bid * NTHR + tid; i < (size_t)MLAT * D / 4; i += (size_t)nb * NTHR) o4[i] = x4[i];
        const f32x4* c4 = (const f32x4*)a.in[I_CTX]; f32x4* h4 = (f32x4*)(a.ws + WS_HC);
        for (size_t i = (size_t)bid * NTHR + tid; i < (size_t)MCTX * D / 4; i += (size_t)nb * NTHR) h4[i] = c4[i];
    }
    {
        float* z = lds;
        float* h1 = lds + 64;
        float* h2 = lds + 128;
        const float* w1 = a.in[I_HYW1]; const float* b1 = a.in[I_HYB1]; const float* w2 = a.in[I_HYW2]; const float* b2 = a.in[I_HYB2];
        const float* w3 = a.in[I_HYW3]; const float* fr = a.in[I_HYFREQ];
        __syncthreads();
        for (int it = bid; it < S + C; it += nb) {
            const bool lat = it < S; const int L = lat ? S : C; const int lag = lat ? it : it - S;
            const float t = (float)lag / (float)(L - 1);
            const float w = (6.283185307179586f / (float)L) * (float)lag;
            if (tid < 33) {
                float v;
                if (tid == 0) v = t;
                else { const int i = (tid - 1) & 15; const float fb = 1e-4f + (float)i * ((15.f - 1e-4f) / 15.f); v = (tid <= 16) ? cosf(fb * w) : -sinf(fb * w); }
                z[tid] = v;
            }
            __syncthreads();
            if (tid < 64) { float s = b1[tid];
#pragma unroll 1
                for (int i = 0; i < 33; ++i) s += z[i] * w1[i * 64 + tid]; h1[tid] = sinf(fr[tid] * s); }
            __syncthreads();
            if (tid < 64) { float s = b2[tid];
#pragma unroll 4
                for (int i = 0; i < 64; ++i) s += h1[i] * w2[i * 64 + tid]; h2[tid] = sinf(fr[64 + tid] * s); }
            __syncthreads();
            for (int o = tid; o < 2048; o += NTHR) {
                float s = 0.f;
#pragma unroll 8
                for (int i = 0; i < 64; ++i) s += h2[i] * w3[i * 2048 + o];
                const int ord = o >> 10, dir = (o >> 9) & 1, ch = o & 511;
                const float dmin = -3.0701134573253945f, dmax = -15.350567286626973f;
                const float delta = fabsf(dmin + (dmax - dmin) * ((float)ch / 511.f));
                s *= expf(-t * delta);
                if (lat) { float* g = (float*)(a.ws + WS_HFL) + ((size_t)ord * 512 + ch) * 4096;
                    if (dir == 0) g[2047 + lag] = s; else if (lag > 0) g[2047 - lag] = s; }
                else { float* g = (float*)(a.ws + WS_HFC) + ((size_t)ord * 512 + ch) * 512;
                    if (dir == 0) g[255 + lag] = s; else if (lag > 0) g[255 - lag] = s; }
            }
            __syncthreads();
        }
    }
}

DI const float* row_ptr(const Args& a, int m) { return m < MLAT ? a.out + (size_t)m * D : (const float*)(a.ws + WS_HC) + (size_t)(m - MLAT) * D; }
DI float* row_ptr_w(const Args& a, int m) { return m < MLAT ? a.out + (size_t)m * D : (float*)(a.ws + WS_HC) + (size_t)(m - MLAT) * D; }
DI int mod_row(int m) { return m < MLAT ? m / S : 8; }
DI void ph_rstd(const Args& a, int bid, int nb, int nrows) {
    const int tid = otid(); const int lane = tid & 63, wv = tid >> 6;
    float* rstd = (float*)(a.ws + WS_RSTD);
    for (int m = bid * NWAVES + wv; m < nrows; m += nb * NWAVES) {
        const f32x4* r = (const f32x4*)row_ptr(a, m); float s = 0.f;
#pragma unroll
        for (int j = 0; j < 4; ++j) { const f32x4 v = r[lane + 64 * j]; s += v.x * v.x + v.y * v.y + v.z * v.z + v.w * v.w; }
        s = wave_sum(s);
        if (lane == 0) rstd[m] = 1.f / sqrtf(s * (1.f / D) + EPS);
    }
}

template <class AL, class EP>
DI void gemm_naive(float* lds, int M, int N, int K, const float* Bm, int ldb, const AL& al, const EP& ep, int bid, int nb) {
    const int tid = otid(), tx = tid & 31, ty = tid >> 5;
    float* As = lds;
    float* Bs = lds + 16 * 132;
    const int ntn = N / 128, ntm = M / 128;
    for (int it = bid; it < ntm * ntn; it += nb) {
        const int tm = it / ntn, tn = it % ntn, m0 = tm * 128, n0 = tn * 128;
        float acc[8][4];
#pragma unroll
        for (int i = 0; i < 8; ++i) { acc[i][0] = acc[i][1] = acc[i][2] = acc[i][3] = 0.f; }
        for (int k0 = 0; k0 < K; k0 += 16) {
            { const int r = tid >> 2, kq = (tid & 3) * 4; const f32x4 v = al.a4(m0 + r, k0 + kq);
              As[(kq + 0) * 132 + r] = v.x; As[(kq + 1) * 132 + r] = v.y; As[(kq + 2) * 132 + r] = v.z; As[(kq + 3) * 132 + r] = v.w; }
            { const int kk = tid >> 5, c4 = (tid & 31) * 4; *(f32x4*)(Bs + kk * 128 + c4) = *(const f32x4*)(Bm + (size_t)(k0 + kk) * ldb + n0 + c4); }
            __syncthreads();
#pragma unroll 4
            for (int kk = 0; kk < 16; ++kk) {
                const f32x4 a0 = *(const f32x4*)(As + kk * 132 + ty * 8), a1 = *(const f32x4*)(As + kk * 132 + ty * 8 + 4);
                const f32x4 b = *(const f32x4*)(Bs + kk * 128 + tx * 4);
                const float av[8] = {a0.x, a0.y, a0.z, a0.w, a1.x, a1.y, a1.z, a1.w};
#pragma unroll
                for (int i = 0; i < 8; ++i) { acc[i][0] += av[i] * b.x; acc[i][1] += av[i] * b.y; acc[i][2] += av[i] * b.z; acc[i][3] += av[i] * b.w; }
            }
            __syncthreads();
        }
#pragma unroll
        for (int i = 0; i < 8; ++i) { f32x4 v = {acc[i][0], acc[i][1], acc[i][2], acc[i][3]}; ep.st(m0 + ty * 8 + i, n0 + tx * 4, v); }
    }
}

struct ALNormMod {
    const float* hl; const float* hc; const float* rstd; const float* mod; int sh_off, sc_off;
    DI f32x4 a4(int m, int k) const {
        const float* r = m < MLAT ? hl + (size_t)m * D : hc + (size_t)(m - MLAT) * D;
        const f32x4 h = *(const f32x4*)(r + k); const float rs = rstd[m];
        const float* mr = mod + (size_t)mod_row(m) * 6144;
        const f32x4 sh = *(const f32x4*)(mr + sh_off + k), sc = *(const f32x4*)(mr + sc_off + k);
        f32x4 o; o.x = h.x * rs * (1.f + sc.x) + sh.x; o.y = h.y * rs * (1.f + sc.y) + sh.y; o.z = h.z * rs * (1.f + sc.z) + sh.z; o.w = h.w * rs * (1.f + sc.w) + sh.w; return o;
    }
};
struct ALPlain { const float* A; int lda; DI f32x4 a4(int m, int k) const { return *(const f32x4*)(A + (size_t)m * lda + k); } };
struct EPStore { float* Cm; int ldc; DI void st(int m, int n, f32x4 v) const { *(f32x4*)(Cm + (size_t)m * ldc + n) = v; } };
struct EPResid { float* hl; float* hc; const float* mod; int g_off;
    DI void st(int m, int n, f32x4 v) const {
        float* r = (m < MLAT ? hl + (size_t)m * D : hc + (size_t)(m - MLAT) * D) + n;
        const f32x4 g = *(const f32x4*)(mod + (size_t)mod_row(m) * 6144 + g_off + n); f32x4 h = *(f32x4*)r;
        h.x += g.x * v.x; h.y += g.y * v.y; h.z += g.z * v.z; h.w += g.w * v.w; *(f32x4*)r = h; }
};

DI void axial_rope64(float& v, int lane, int t) {
    const int axis = lane >> 5, half = (lane >> 4) & 1, f = lane & 15;
    const float pos = (float)(axis == 0 ? (t >> 6) : (t & 63));
    const float inv = exp2f(-(float)f * (13.287712379549449f / 16.f));
    const float ang = pos * inv, c = cosf(ang), s = sinf(ang);
    const float other = __shfl_xor(v, 16);
    v = half == 0 ? (v * c - other * s) : (v * c + other * s);
}
DI void ph_prep0(const Args& a, int bid, int nb) {
    const int tid = otid(); const int lane = tid & 63, wv = tid >> 6;
    float* U = (float*)(a.ws + WS_U);
    const float gq = a.in[I_DAQN][lane], gk = a.in[I_DAKN][lane];
    for (int it = bid * NWAVES + wv; it < MALL * 16; it += nb * NWAVES) {
        const int m = it >> 4, j = it & 15; const bool isq = j < 8;
        float* p = U + (size_t)m * E_IN + 1536 + j * 64 + lane;
        float v = *p;
        const float ss = wave_sum(v * v);
        v = v * (1.f / sqrtf(ss * (1.f / 64.f) + EPS)) * (isq ? gq : gk);
        if (m < MLAT) axial_rope64(v, lane, m & (S - 1));
        if (isq) v *= 0.125f;
        *p = v;
    }
}

DI void ph_hyena(const Args& a, float* lds, int bid, int nb, int item0, int item1) {
    const int tid = otid();
    const float* U = (const float*)(a.ws + WS_U); float* MIX = (float*)(a.ws + WS_MIX);
    float* zs = lds; float* g1 = lds + 2048; float* g2 = lds + 4096; float* ys = lds + 6144; float* gf = lds + 8192;
    const float* cw = a.in[I_HYCW]; const float* cb = a.in[I_HYCB];
    for (int it = item0 + bid; it < item1; it += nb) {
        const bool lat = it < NB * 512; const int r = lat ? it : it - NB * 512; const int b = r >> 9, ch = r & 511;
        const int L = lat ? S : C; const int mb = lat ? b * S : MLAT + b * C;
        __syncthreads();
        for (int t = tid; t < L; t += NTHR) {
#pragma unroll
            for (int q = 0; q < 3; ++q) {
                const int col = q * 512 + ch;
                const float um = t > 0 ? U[(size_t)(mb + t - 1) * E_IN + col] : 0.f, u0 = U[(size_t)(mb + t) * E_IN + col], up = t < L - 1 ? U[(size_t)(mb + t + 1) * E_IN + col] : 0.f;
                const float v = cw[col] * um + cw[1536 + col] * u0 + cw[3072 + col] * up + cb[col];
                (q == 0 ? zs : q == 1 ? g1 : g2)[t] = v;
            }
        }
        for (int n = 0; n < 2; ++n) {
            __syncthreads();
            const float* gsrc = lat ? (const float*)(a.ws + WS_HFL) + ((size_t)n * 512 + ch) * 4096 : (const float*)(a.ws + WS_HFC) + ((size_t)n * 512 + ch) * 512;
            for (int i = tid; i < 2 * L - 1; i += NTHR) gf[i] = gsrc[i];
            __syncthreads();
            const float bias = a.in[I_HYBIAS][n * 512 + ch];
            for (int t = tid; t < L; t += NTHR) {
                float acc = 0.f; const float* gp = gf + t + L - 1;
                for (int s = 0; s < L; ++s) acc += gp[-s] * zs[s];
                ys[t] = (n == 0 ? g1 : g2)[t] * (acc + bias * zs[t]);
            }
            __syncthreads();
            for (int t = tid; t < L; t += NTHR) zs[t] = ys[t];
        }
        __syncthreads();
        for (int t = tid; t < L; t += NTHR) MIX[(size_t)(mb + t) * D + ch] = zs[t];
    }
}

DI void ph_diffattn(const Args& a, float* lds, int bid, int nb) {
    const int tid = otid(); const int lane = tid & 63, wv = tid >> 6;
    const float* U = (const float*)(a.ws + WS_U); float* MIX = (float*)(a.ws + WS_MIX);
    float* qs = lds + wv * 128;
    float* as = lds + 1024 + wv * 2304;
    const float* lp = a.in[I_DALAM];
    const float lam_init = 0.2f;
    const float lam = expf(wave_sum(lp[lane] * lp[64 + lane])) - expf(wave_sum(lp[128 + lane] * lp[192 + lane])) + lam_init;
    const int NQ = MALL * 4;
    for (int it = bid * NWAVES + wv; it < NQ; it += nb * NWAVES) {
        const int m = it >> 2, h = it & 3; const bool lat = m < MLAT; const int b = lat ? m / S : (m - MLAT) / C;
        const int nkeys = lat ? C + S : C;
        const float* qp = U + (size_t)m * E_IN + 1536 + h * 128;
        qs[lane] = qp[lane]; qs[64 + lane] = qp[64 + lane];
        __builtin_amdgcn_wave_barrier();
        float m0 = -1e30f, m1 = -1e30f, l0 = 0.f, l1 = 0.f;
#pragma unroll 1
        for (int i = 0; i < 36; ++i) {
            const int j = lane + 64 * i;
            if (j < nkeys) {
                const int km = j < C ? MLAT + b * C + j : b * S + (j - C);
                const f32x4* kp = (const f32x4*)(U + (size_t)km * E_IN + 2048 + h * 128);
                float d0 = 0.f, d1 = 0.f;
#pragma unroll
                for (int d = 0; d < 16; ++d) { const f32x4 kv = kp[d], kw = kp[16 + d]; const f32x4 q0 = *(const f32x4*)(qs + 4 * d), q1 = *(const f32x4*)(qs + 64 + 4 * d);
                    d0 += kv.x * q0.x + kv.y * q0.y + kv.z * q0.z + kv.w * q0.w; d1 += kw.x * q1.x + kw.y * q1.y + kw.z * q1.z + kw.w * q1.w; }
                const float n0 = fmaxf(m0, d0), n1 = fmaxf(m1, d1);
                l0 = l0 * expf(m0 - n0) + expf(d0 - n0); l1 = l1 * expf(m1 - n1) + expf(d1 - n1); m0 = n0; m1 = n1;
            }
        }
        { const float g0 = wave_max(m0), g1 = wave_max(m1); l0 = wave_sum(l0 * expf(m0 - g0)); l1 = wave_sum(l1 * expf(m1 - g1)); m0 = g0; m1 = g1; }
        const float i0 = 1.f / l0, i1 = lam / l1;
#pragma unroll 1
        for (int i = 0; i < 36; ++i) {
            const int j = lane + 64 * i;
            if (j < nkeys) {
                const int km = j < C ? MLAT + b * C + j : b * S + (j - C);
                const f32x4* kp = (const f32x4*)(U + (size_t)km * E_IN + 2048 + h * 128);
                float d0 = 0.f, d1 = 0.f;
#pragma unroll
                for (int d = 0; d < 16; ++d) { const f32x4 kv = kp[d], kw = kp[16 + d]; const f32x4 q0 = *(const f32x4*)(qs + 4 * d), q1 = *(const f32x4*)(qs + 64 + 4 * d);
                    d0 += kv.x * q0.x + kv.y * q0.y + kv.z * q0.z + kv.w * q0.w; d1 += kw.x * q1.x + kw.y * q1.y + kw.z * q1.z + kw.w * q1.w; }
                as[j] = expf(d0 - m0) * i0 - expf(d1 - m1) * i1;
            }
        }
        __builtin_amdgcn_wave_barrier();
        float o0 = 0.f, o1 = 0.f;
        for (int j = 0; j < nkeys; ++j) {
            const int km = j < C ? MLAT + b * C + j : b * S + (j - C);
            const float* vp = U + (size_t)km * E_IN + 2560 + h * 128; const float aw = as[j];
            o0 += aw * vp[lane]; o1 += aw * vp[64 + lane];
        }
        const float ss = wave_sum(o0 * o0 + o1 * o1); const float rs = (1.f / sqrtf(ss * (1.f / 128.f) + EPS)) * (1.f - lam_init);
        float* op = MIX + (size_t)m * D + 512 + h * 128;
        op[lane] = o0 * rs * a.in[I_DASUB][lane]; op[64 + lane] = o1 * rs * a.in[I_DASUB][64 + lane];
        __builtin_amdgcn_wave_barrier();
    }
}

DI void ph_moe(const Args& a, float* lds, int bid, int nb, int l, int nrows) {
    const int tid = otid(), lane = tid & 63, wv = tid >> 6;
    float* v = lds;
    float* lg = lds + 1024;
    float* sel = lds + 1088;
    float* av = lds + 1152;
    float* red = lds + 2048;
    const float* mod = (const float*)(a.ws + WS_MOD) + (size_t)l * 9 * 6144;
    const float* wgrp = a.in[I_MWGRP] + (size_t)l * D * 4; const float* bgrp = a.in[I_MBGRP] + l * 4;
    const float* wrt = a.in[I_MWRT] + (size_t)l * D * 32; const float* brt = a.in[I_MBRT] + l * 32;
    const float* WG = a.in[I_MWG] + (size_t)l * 32 * D * 256; const float* WU = a.in[I_MWU] + (size_t)l * 32 * D * 256; const float* WD = a.in[I_MWD] + (size_t)l * 32 * 256 * D;
    for (int m = bid; m < nrows; m += nb) {
        float* hr = row_ptr_w(a, m); const float* mr = mod + (size_t)mod_row(m) * 6144;
        __syncthreads();
        const float x0 = hr[tid], x1 = hr[512 + tid];
        float ss = wave_sum(x0 * x0 + x1 * x1);
        if (lane == 0) red[wv] = ss;
        __syncthreads();
        ss = 0.f; for (int i = 0; i < 8; ++i) ss += red[i];
        const float rs = 1.f / sqrtf(ss * (1.f / D) + EPS);
        v[tid] = x0 * rs * (1.f + mr[4 * 1024 + tid]) + mr[3 * 1024 + tid];
        v[512 + tid] = x1 * rs * (1.f + mr[4 * 1024 + 512 + tid]) + mr[3 * 1024 + 512 + tid];
        __syncthreads();
        for (int o = wv; o < 36; o += 8) {
            float s = 0.f;
            if (o < 4) { for (int k = lane; k < D; k += 64) s += v[k] * wgrp[k * 4 + o]; }
            else { for (int k = lane; k < D; k += 64) s += v[k] * wrt[k * 32 + (o - 4)]; }
            s = wave_sum(s);
            if (lane == 0) lg[o] = s + (o < 4 ? bgrp[o] : brt[o - 4]);
        }
        __syncthreads();
        if (tid == 0) {
            int g = 0; float gm = lg[0];
            for (int i = 1; i < 4; ++i) if (lg[i] > gm) { gm = lg[i]; g = i; }
            float den = 0.f; for (int i = 0; i < 4; ++i) den += expf(lg[i] - gm);
            const float pg = 1.f / den;
            const float* le = lg + 4 + g * 8;
            int e0 = 0; float v0 = le[0];
            for (int i = 1; i < 8; ++i) if (le[i] > v0) { v0 = le[i]; e0 = i; }
            int e1 = -1; float v1 = -3.4e38f;
            for (int i = 0; i < 8; ++i) if (i != e0 && le[i] > v1) { v1 = le[i]; e1 = i; }
            const float p1 = expf(v1 - v0); const float w0 = pg / (1.f + p1), w1 = pg * p1 / (1.f + p1);
            sel[0] = __int_as_float(g * 8 + e0); sel[1] = __int_as_float(g * 8 + e1); sel[2] = w0; sel[3] = w1;
        }
        __syncthreads();
        {
            const int ei = tid >> 8, f = tid & 255; const int e = __float_as_int(sel[ei]);
            const float* wg = WG + (size_t)e * D * 256 + f; const float* wu = WU + (size_t)e * D * 256 + f;
            float ag = 0.f, au = 0.f;
            for (int k = 0; k < D; ++k) { const float vk = v[k]; ag += vk * wg[(size_t)k * 256]; au += vk * wu[(size_t)k * 256]; }
            av[ei * 256 + f] = silu_f(ag) * au * sel[2 + ei];
        }
        __syncthreads();
        {
            const int e0 = __float_as_int(sel[0]), e1 = __float_as_int(sel[1]);
            const float* d0 = WD + (size_t)e0 * 256 * D; const float* d1 = WD + (size_t)e1 * 256 * D;
            float o0 = 0.f, o1 = 0.f;
            for (int f = 0; f < 256; ++f) { const float a0 = av[f], a1 = av[256 + f]; o0 += a0 * d0[(size_t)f * D + tid] + a1 * d1[(size_t)f * D + tid]; o1 += a0 * d0[(size_t)f * D + 512 + tid] + a1 * d1[(size_t)f * D + 512 + tid]; }
            hr[tid] = x0 + mr[5 * 1024 + tid] * o0; hr[512 + tid] = x1 + mr[5 * 1024 + 512 + tid] * o1;
        }
    }
}

DI void ph_prep1(const Args& a, int bid, int nb) {
    const int tid = otid(); const int lane = tid & 63, wv = tid >> 6;
    float* U = (float*)(a.ws + WS_U);
    const float gq = a.in[I_GQQN][lane], gk = a.in[I_GQKN][lane];
    const float rscale = 0.08838834764831845f;
    for (int it = bid * NWAVES + wv; it < MALL * 18; it += nb * NWAVES) {
        const int m = it / 18, j = it % 18; const bool lat = m < MLAT; const int t = m & (S - 1);
        if (j < 8) {
            float* p = U + (size_t)m * O_IN + j * 128;
            float x1 = p[lane], x2 = p[64 + lane];
            if (lat) { const float inv = exp2f(-(float)lane * (13.287712379549449f / 63.f)); const float ang = (float)t * inv, c = cosf(ang), s = sinf(ang);
                const float y1 = x1 * c - x2 * s, y2 = x2 * c + x1 * s; x1 = y1; x2 = y2; }
            if (j >= 4) { x1 *= rscale; x2 *= rscale; }
            p[lane] = x1; p[64 + lane] = x2;
        } else {
            const bool isq = j < 16;
            float* p = U + (size_t)m * O_IN + (isq ? 2048 + (j - 8) * 64 : 2560 + (j - 16) * 64) + lane;
            float v = *p; const float ss = wave_sum(v * v);
            v = v * (1.f / sqrtf(ss * (1.f / 64.f) + EPS)) * (isq ? gq : gk);
            if (lat) axial_rope64(v, lane, t);
            if (isq) v *= 0.125f;
            *p = v;
        }
    }
}

DI void ph_retention(const Args& a, float* lds, int bid, int nb) {
    const int tid = otid(); const int lane = tid & 63, wv = tid >> 6;
    const float* U = (const float*)(a.ws + WS_U); float* MIX = (float*)(a.ws + WS_MIX);
    float* qs = lds + wv * 128; float* as = lds + 1024 + wv * 2304;
    for (int it = bid * NWAVES + wv; it < MLAT * 4; it += nb * NWAVES) {
        const int m = it >> 2, h = it & 3, b = m / S, t = m & (S - 1);
        const float df = a.in[I_RETDEC][h], db = a.in[I_RETDEC][4 + h];
        const float lgf = fminf(df, 0.f) - log1pf(expf(-fabsf(df))), lgb = fminf(db, 0.f) - log1pf(expf(-fabsf(db)));
        const float* qp = U + (size_t)m * O_IN + h * 128;
        qs[lane] = qp[lane]; qs[64 + lane] = qp[64 + lane];
        __builtin_amdgcn_wave_barrier();
#pragma unroll 1
        for (int i = 0; i < 36; ++i) {
            const int j = lane + 64 * i;
            const int km = j < C ? MLAT + b * C + j : b * S + (j - C);
            const f32x4* kp = (const f32x4*)(U + (size_t)km * O_IN + 512 + h * 128);
            float d0 = 0.f;
#pragma unroll 8
            for (int d = 0; d < 32; ++d) { const f32x4 kv = kp[d]; const f32x4 q0 = *(const f32x4*)(qs + 4 * d); d0 += kv.x * q0.x + kv.y * q0.y + kv.z * q0.z + kv.w * q0.w; }
            float w;
            if (j < C) w = expf((float)(C + t - j) * lgf) + expf((float)(S - t + j) * lgb);
            else { const int s = j - C; w = (s <= t ? expf((float)(t - s) * lgf) : 0.f) + (s >= t ? expf((float)(s - t) * lgb) : 0.f); }
            as[j] = w * d0;
        }
        __builtin_amdgcn_wave_barrier();
        float o0 = 0.f, o1 = 0.f;
        for (int j = 0; j < C + S; ++j) {
            const int km = j < C ? MLAT + b * C + j : b * S + (j - C);
            const float* vp = U + (size_t)km * O_IN + 1024 + h * 128; const float aw = as[j];
            o0 += aw * vp[lane]; o1 += aw * vp[64 + lane];
        }
        const float mu = wave_sum(o0 + o1) * (1.f / 128.f); const float c0 = o0 - mu, c1 = o1 - mu;
        const float var = wave_sum(c0 * c0 + c1 * c1) * (1.f / 128.f); const float rs = 1.f / sqrtf(var + EPS);
        const float* gp = U + (size_t)m * O_IN + 1536 + h * 128; const float* gn = a.in[I_RETGN] + h * 128;
        float* op = MIX + (size_t)m * D + h * 128;
        op[lane] = c0 * rs * gn[lane] * silu_f(gp[lane]); op[64 + lane] = c1 * rs * gn[64 + lane] * silu_f(gp[64 + lane]);
        __builtin_amdgcn_wave_barrier();
    }
}

DI void ph_gqa(const Args& a, float* lds, int bid, int nb) {
    const int tid = otid(); const int lane = tid & 63, wv = tid >> 6;
    const float* U = (const float*)(a.ws + WS_U); float* MIX = (float*)(a.ws + WS_MIX);
    float* qs = lds + wv * 64; float* as = lds + 512 + wv * 576;
    for (int it = bid * NWAVES + wv; it < MLAT * 8; it += nb * NWAVES) {
        const int m = it >> 3, hd = it & 7, kv = hd >> 2, b = m / S, t = m & (S - 1);
        const float sink = a.in[I_GQSINK][hd];
        qs[lane] = U[(size_t)m * O_IN + 2048 + hd * 64 + lane];
        __builtin_amdgcn_wave_barrier();
        float mx = sink;
#pragma unroll 1
        for (int i = 0; i < 9; ++i) {
            const int j = lane + 64 * i; float sv = -1e30f;
            int km = -1;
            if (j < C) km = MLAT + b * C + j;
            else { const int li = j - C, s = t - 128 + li; if (li <= 256 && s >= 0 && s < S) km = b * S + s; }
            if (km >= 0) {
                const f32x4* kp = (const f32x4*)(U + (size_t)km * O_IN + 2560 + kv * 64);
                float d0 = 0.f;
#pragma unroll
                for (int d = 0; d < 16; ++d) { const f32x4 kk = kp[d]; const f32x4 q0 = *(const f32x4*)(qs + 4 * d); d0 += kk.x * q0.x + kk.y * q0.y + kk.z * q0.z + kk.w * q0.w; }
                sv = d0; mx = fmaxf(mx, d0);
            }
            as[j] = sv;
        }
        mx = wave_max(mx);
        float l = 0.f;
#pragma unroll 1
        for (int i = 0; i < 9; ++i) { const float sv = as[lane + 64 * i]; const float e = sv > -1e29f ? expf(sv - mx) : 0.f; as[lane + 64 * i] = e; l += e; }
        l = wave_sum(l) + expf(sink - mx);
        const float il = 1.f / l;
        __builtin_amdgcn_wave_barrier();
        float o = 0.f;
        for (int j = 0; j < C + 257; ++j) {
            int km;
            if (j < C) km = MLAT + b * C + j;
            else { const int s = t - 128 + (j - C); if (s < 0 || s >= S) continue; km = b * S + s; }
            o += as[j] * U[(size_t)km * O_IN + 2688 + kv * 64 + lane];
        }
        MIX[(size_t)m * D + 512 + hd * 64 + lane] = o * il;
        __builtin_amdgcn_wave_barrier();
    }
}

constexpr int N_PHASES = 13;
__global__ void __launch_bounds__(NTHR, 2) fwd_kernel(Args a) {
    extern __shared__ __attribute__((aligned(16))) unsigned char lds_raw[];
    float* lds = (float*)lds_raw;
    volatile LAS unsigned* MISC = (volatile LAS unsigned*)((LAS unsigned char*)lds_raw + LDS_BYTES - 64);
    const int bid = blockIdx.x, nb = gridDim.x;
    if (threadIdx.x < 16) MISC[threadIdx.x] = 0u;
    __syncthreads();
    XcdBarrier bar; bar.bar = (unsigned*)(a.ws + WS_CTL); bar.x = 0; bar.st = nullptr;
    const bool multi = (a.ph_hi - a.ph_lo) > 1;
    if (multi) bar = xcd_barrier_post((unsigned*)(a.ws + WS_CTL), MISC);
    const float* modb = (const float*)(a.ws + WS_MOD);
    float* U = (float*)(a.ws + WS_U); float* MIX = (float*)(a.ws + WS_MIX); float* HC = (float*)(a.ws + WS_HC); const float* rstd = (const float*)(a.ws + WS_RSTD);
    const int lo = a.ph_lo, hi = a.ph_hi;
#define IN(k) (lo <= (k) && (k) < hi)
#define SEAM(k) do { if (IN(k) && IN((k) + 1)) xcd_barrier(bar); } while (0)
    if (IN(0)) { ph_init(a, lds, bid, nb); } SEAM(0);
    if (IN(1)) { ph_rstd(a, bid, nb, MALL); } SEAM(1);
    if (IN(2)) { ALNormMod al{a.out, HC, rstd, modb, 0, 1024}; EPStore ep{U, E_IN}; gemm_naive(lds, MALL, E_IN, D, a.in[I_EWIN], E_IN, al, ep, bid, nb); } SEAM(2);
    if (IN(3)) { ph_prep0(a, bid, nb); } SEAM(3);
    if (IN(4)) { ph_hyena(a, lds, bid, nb, 0, 2 * NB * 512); __syncthreads(); ph_diffattn(a, lds, bid, nb); } SEAM(4);
    if (IN(5)) { ALPlain al{MIX, D}; EPResid ep{a.out, HC, modb, 2048}; gemm_naive(lds, MALL, D, D, a.in[I_EWOUT], D, al, ep, bid, nb); } SEAM(5);
    if (IN(6)) { ph_moe(a, lds, bid, nb, 0, MALL); } SEAM(6);
    if (IN(7)) { ph_rstd(a, bid, nb, MALL); } SEAM(7);
    if (IN(8)) { ALNormMod al{a.out, HC, rstd, modb + 9 * 6144, 0, 1024}; EPStore ep{U, O_IN}; gemm_naive(lds, MALL, O_IN, D, a.in[I_OWIN], O_IN, al, ep, bid, nb); } SEAM(8);
    if (IN(9)) { ph_prep1(a, bid, nb); } SEAM(9);
    if (IN(10)) { ph_retention(a, lds, bid, nb); __syncthreads(); ph_gqa(a, lds, bid, nb); } SEAM(10);
    if (IN(11)) { ALPlain al{MIX, D}; EPResid ep{a.out, HC, modb + 9 * 6144, 2048}; gemm_naive(lds, MLAT, D, D, a.in[I_OWOUT], D, al, ep, bid, nb); } SEAM(11);
    if (IN(12)) { ph_moe(a, lds, bid, nb, 1, MLAT); }
#undef IN
#undef SEAM
}

extern "C" void kernel_launch(void* const* d_in, const int* in_sizes, int n_in, void* d_out, int out_size, void* d_ws, size_t ws_size, hipStream_t stream) {
    static int grid = 0;
    if (grid == 0) {
        if (n_in != N_IN || out_size != MLAT * D || ws_size < WS_END) { fprintf(stderr, "kernel_launch: unexpected shapes (n_in %d out %d ws %zu)\n", n_in, out_size, ws_size); grid = -1; return; }
        int dev = 0, cus = 0;
        if (hipGetDevice(&dev) != hipSuccess || hipDeviceGetAttribute(&cus, hipDeviceAttributeMultiprocessorCount, dev) != hipSuccess) { grid = -1; return; }
        if (hipFuncSetAttribute((const void*)fwd_kernel, hipFuncAttributeMaxDynamicSharedMemorySize, LDS_BYTES) != hipSuccess) { grid = -1; return; }
        grid = cus;
    }
    if (grid < 0) return;
    (void)hipMemsetAsync((char*)d_ws + WS_CTL, 0, CTL_ZERO_BYTES, stream);
    Args a{};
    for (int i = 0; i < N_IN; ++i) a.in[i] = (const float*)d_in[i];
    a.out = (float*)d_out; a.ws = (unsigned char*)d_ws;
#if MK_PER_PHASE
    for (int p = 0; p < N_PHASES; ++p) { a.ph_lo = p; a.ph_hi = p + 1; hipLaunchKernelGGL(fwd_kernel, dim3(grid), dim3(NTHR), LDS_BYTES, stream, a); }
#else
    a.ph_lo = 0; a.ph_hi = N_PHASES;
    hipLaunchKernelGGL(fwd_kernel, dim3(grid), dim3(NTHR), LDS_BYTES, stream, a);
#endif
}
```

```cpp
#include <hip/hip_runtime.h>
#include <cstdint>
#include <cstdio>

#ifndef MK_PER_PHASE
#define MK_PER_PHASE 0
#endif

#define DI __device__ __forceinline__
#define GAS __attribute__((address_space(1)))
#define LAS __attribute__((address_space(3)))
typedef float f32x4 __attribute__((ext_vector_type(4)));
typedef unsigned u32x4 __attribute__((ext_vector_type(4)));
typedef unsigned u32x2 __attribute__((ext_vector_type(2)));
typedef unsigned short bf16_t;

constexpr int D = 1024, NB = 8, S = 2048, C = 256;
constexpr int MLAT = NB * S, MCTX = NB * C, MALL = MLAT + MCTX;
constexpr int E_IN = 3072, O_IN = 2816;
constexpr int NTHR = 512, NWAVES = 8;
constexpr float EPS = 1e-6f;
constexpr int LDS_BYTES = 147456;

enum { I_X = 0, I_C, I_CTX, I_CCTX, I_ADAW, I_ADAB, I_EWIN, I_EWOUT, I_HYCW, I_HYCB, I_HYW1, I_HYB1, I_HYW2, I_HYB2, I_HYW3, I_HYFREQ, I_HYBIAS,
       I_DAQN, I_DAKN, I_DALAM, I_DASUB, I_OWIN, I_OWOUT, I_RETDEC, I_RETGN, I_GQQN, I_GQKN, I_GQSINK, I_MWGRP, I_MBGRP, I_MWRT, I_MBRT, I_MWG, I_MWU, I_MWD, N_IN };

constexpr size_t MiB = 1u << 20;
constexpr size_t WS_CTL = 0, CTL_ZERO_BYTES = 64 * 1024;
constexpr size_t WS_MOD = 1 * MiB;
constexpr size_t WS_HFL = 2 * MiB;
constexpr size_t WS_HFC = WS_HFL + 16 * MiB;
constexpr size_t WS_HC = WS_HFC + 2 * MiB;
constexpr size_t WS_WEIN = WS_HC + 8 * MiB;
constexpr size_t WS_WEOUT = WS_WEIN + 6 * MiB;
constexpr size_t WS_WOIN = WS_WEOUT + 2 * MiB;
constexpr size_t WS_WOOUT = WS_WOIN + 6 * MiB;
constexpr size_t WS_XN = WS_WOOUT + 2 * MiB;
constexpr size_t WS_U = WS_XN + 36 * MiB;
constexpr size_t WS_MIX = WS_U + 108 * MiB;
constexpr size_t WS_MW1 = WS_MIX + 36 * MiB;
constexpr size_t WS_MW2 = WS_MW1 + 32 * MiB;
constexpr size_t WS_TOK = WS_MW2 + 16 * MiB;
constexpr size_t WS_ROWW = WS_TOK + 1 * MiB;
constexpr size_t WS_ATT = WS_ROWW + 1 * MiB;
constexpr size_t WS_END = WS_ATT + 48 * MiB;
static_assert((size_t)176 * 256 * 1024 * 2 <= 108 * MiB && (size_t)176 * 256 * 256 * 2 <= 36 * MiB && (size_t)8 * MALL * 4 <= 1 * MiB, "moe overlays");
static_assert((size_t)MALL * 3072 * 2 <= 108 * MiB && (size_t)MALL * D * 2 <= 36 * MiB, "ws map");

struct Args { const float* in[N_IN]; float* out; unsigned char* ws; int ph_lo, ph_hi; };

DI float wave_sum(float v) {
#pragma unroll
    for (int o = 32; o > 0; o >>= 1) v += __shfl_xor(v, o);
    return v;
}
DI float wave_max(float v) {
#pragma unroll
    for (int o = 32; o > 0; o >>= 1) v = fmaxf(v, __shfl_xor(v, o));
    return v;
}
DI float silu_f(float x) { return x / (1.f + expf(-x)); }
DI int otid() { int t = threadIdx.x; asm volatile("" : "+v"(t)); return t; }
DI float bf2f(bf16_t v) { return __uint_as_float((unsigned)v << 16); }
DI unsigned f2bf(float f) { unsigned u = __float_as_uint(f); return (u + 0x7fffu + ((u >> 16) & 1u)) >> 16; }
DI unsigned pk2(float lo, float hi) { return f2bf(lo) | (f2bf(hi) << 16); }
DI f32x4 ld4bf(const bf16_t* p) { const u32x2 w = *(const u32x2*)p; f32x4 r; r.x = __uint_as_float(w.x << 16); r.y = __uint_as_float(w.x & 0xffff0000u); r.z = __uint_as_float(w.y << 16); r.w = __uint_as_float(w.y & 0xffff0000u); return r; }

#define XB_TMO      128
#define XB_XCNT(j)  (256  + 64 * (j))
#define XB_XSUB(j)  (1280 + 64 * (j))
#define XB_XGEN(j)  (2304 + 64 * (j))
#define XB_TOP      3328
#define XB_TOPGEN   3392
#define XCD_BAR_WORDS 3456
#define XB_SPIN_CAP (1u << 22)
DI unsigned xb_ld(unsigned* p)              { return __hip_atomic_load(p, __ATOMIC_RELAXED, __HIP_MEMORY_SCOPE_AGENT); }
DI unsigned xb_add(unsigned* p, unsigned v) { return __hip_atomic_fetch_add(p, v, __ATOMIC_RELAXED, __HIP_MEMORY_SCOPE_AGENT); }
DI unsigned xb_xcc_id() { return (unsigned)__builtin_amdgcn_s_getreg((3 << 11) | 20) & 0xFu; }
#define XB_SPIN(cond, bar) do { unsigned _sp = 0; while (cond) { __builtin_amdgcn_s_sleep(1); \
    if ((++_sp & 255u) == 0u) { if (xb_ld(&(bar)[XB_TMO])) break; if (_sp > XB_SPIN_CAP) { atomicAdd(&(bar)[XB_TMO], 1u); break; } } } } while (0)
struct XcdBarrier { unsigned* bar; unsigned x; volatile LAS unsigned* st; };
DI XcdBarrier xcd_barrier_post(unsigned* bar, volatile LAS unsigned* st) {
    XcdBarrier b; b.bar = bar; b.x = xb_xcc_id(); b.st = st;
    if (threadIdx.x == 0) (void)xb_add(&bar[XB_XCNT(b.x)], 1u);
    return b;
}
DI void xcd_barrier_complete(unsigned* bar, unsigned x, unsigned& nloc, unsigned& nx) {
    const unsigned G = gridDim.x * gridDim.y * gridDim.z;
    unsigned sum, cnt, mine, sp = 0u;
    for (;;) {
        sum = 0u; cnt = 0u; mine = 0u;
#pragma unroll
        for (unsigned j = 0; j < 16; ++j) { const unsigned c = xb_ld(&bar[XB_XCNT(j)]); sum += c; cnt += (c > 0u) ? 1u : 0u; mine = (j == x) ? c : mine; }
        if (sum == G) break;
        __builtin_amdgcn_s_sleep(1);
        if ((++sp & 255u) == 0u) { if (xb_ld(&bar[XB_TMO])) break; if (sp > XB_SPIN_CAP) { atomicAdd(&bar[XB_TMO], 1u); break; } }
    }
    nloc = mine > 0u ? mine : 1u; nx = cnt > 0u ? cnt : 1u;
}
DI void xcd_barrier(const XcdBarrier& b) {
    asm volatile("s_waitcnt vmcnt(0)" ::: "memory");
    __syncthreads();
    if (threadIdx.x == 0) {
        unsigned* bar = b.bar;
        __builtin_amdgcn_s_waitcnt(0);
        unsigned nloc = b.st[0], nx = b.st[1];
        if (nloc == 0u) { xcd_barrier_complete(bar, b.x, nloc, nx); b.st[0] = nloc; b.st[1] = nx; }
        const unsigned old = xb_add(&bar[XB_XSUB(b.x)], 1u);
        const unsigned gen = old / nloc;
        if (old + 1u == (gen + 1u) * nloc) {
            __builtin_amdgcn_fence(__ATOMIC_RELEASE, "agent");
            asm volatile("s_waitcnt vmcnt(0)" ::: "memory");
            const unsigned og = xb_add(&bar[XB_TOP], 1u);
            const unsigned tg = og / nx;
            if (og + 1u == (tg + 1u) * nx) xb_add(&bar[XB_TOPGEN], 1u);
            else XB_SPIN(xb_ld(&bar[XB_TOPGEN]) == tg, bar);
            __builtin_amdgcn_fence(__ATOMIC_ACQUIRE, "agent");
            xb_add(&bar[XB_XGEN(b.x)], 1u);
            asm volatile("s_waitcnt vmcnt(0)" ::: "memory");
        } else {
            XB_SPIN(xb_ld(&bar[XB_XGEN(b.x)]) == gen, bar);
            __builtin_amdgcn_fence(__ATOMIC_ACQUIRE, "agent");
            asm volatile("s_waitcnt vmcnt(0)" ::: "memory");
        }
    }
    __syncthreads();
}

namespace pg8 {
#define PG8_LAS __attribute__((address_space(3)))
typedef unsigned short bf16_t;
typedef short bf16x8 __attribute__((ext_vector_type(8)));
typedef float f32x4 __attribute__((ext_vector_type(4)));
typedef unsigned u32x4 __attribute__((ext_vector_type(4)));
constexpr int BM = 256, BK = 64, HALF = 128, HTB = HALF * BK * 2  , STAGE_BYTES = 8 * HTB, NXCD = 8, WGM = 8;

__host__ __device__ __forceinline__ int lds_byte(int r, int c) { const int st = (r >> 4) * 2 + (c >> 5), rr = r & 15, cc = c & 31, ob = rr * 64 + cc * 2; return st * 1024 + (ob ^ (((ob >> 9) & 1) << 5)); }
__host__ __device__ __forceinline__ void stage_rc(int b, int& R, int& C) { const int st = b / 1024, sb = b % 1024, swz = sb ^ (((sb >> 9) & 1) << 5); R = (st >> 1) * 16 + swz / 64; C = (st & 1) * 32 + (swz % 64) / 2; }
__host__ __device__ __forceinline__ int perm32(int rho) { const int n = rho >> 4, i = rho & 15; return 8 * (i >> 2) + 4 * n + (i & 3); }

struct Unit { int pm, pn; };
struct Gemm { const bf16_t* A; const bf16_t* Bt; int M, N, K; };

struct StaticOrder {
    int nM, nN, nwg, G, c;
    __host__ __device__ void init(int M, int N, int G_, int c_) { nM = M / BM; nN = N / BM; nwg = nM * nN; G = G_; c = c_; }
    __host__ __device__ bool next(int i, Unit& u) const {
        const long L = (long)i * G + c; if (L >= nwg) return false;
        int wgid = (int)L; { const int q = nwg / NXCD, r = nwg % NXCD, xcd = wgid % NXCD, off = wgid / NXCD; wgid = (xcd < r ? xcd * (q + 1) : r * (q + 1) + (xcd - r) * q) + off; }
        const int nig = WGM * nN, gid = wgid / nig, fm = gid * WGM, gsz = (nM - fm) < WGM ? (nM - fm) : WGM;
        u.pm = fm + ((wgid % nig) % gsz); u.pn = (wgid % nig) / gsz; return true;
    }
    __device__ __forceinline__ void a_ready(const Unit&) const {}
    __device__ __forceinline__ void done(const Unit&) const {}
};

__device__ __forceinline__ unsigned cvt_pk_bf16(float lo, float hi) { unsigned r; asm volatile("v_cvt_pk_bf16_f32 %0, %1, %2" : "=v"(r) : "v"(lo), "v"(hi)); return r; }
template <class Epi, class Sched, bool ALIGN_EPI = false, bool SP2 = false>
__device__ __forceinline__ void gemm_phase(PG8_LAS unsigned char* lds, const Gemm g, const Sched& S, const Epi& E) {
    const int tid = threadIdx.x, wid = __builtin_amdgcn_readfirstlane(tid >> 6), lane = tid & 63, wr = wid >> 2, wc = wid & 3, fr = lane & 15, fq = lane >> 4;
    const int K = g.K, nt = K / BK;
    unsigned voffA[2], voffB[2];
#pragma unroll
    for (int i = 0; i < 2; ++i) { int R, C; stage_rc(tid * 16 + i * 8192, R, C); const int Rb = Epi::PERM ? ((R & ~31) + perm32(R & 31)) : R;
        voffA[i] = (unsigned)(R * K + C) * 2u; voffB[i] = (unsigned)(Rb * K + C) * 2u; }
    const size_t kstep = (size_t)(BK * 2);
    const size_t hstep = (size_t)HALF * K * 2;
    const size_t tstep = 2 * hstep;
    const unsigned ldsw = (unsigned)wid * 1024u;
    const int aoff = lds_byte(wr * 64 + fr, fq * 8), boff = lds_byte(wc * 32 + fr, fq * 8);
#define PG8_SA(b, h) (((b) * 2 + (h)) * HTB)
#define PG8_SB(b, h) ((4 + (b) * 2 + (h)) * HTB)
#define PG8_STAGE(bufoff, gbase, voff) do { _Pragma("unroll") for (int _i = 0; _i < 2; ++_i) \
        __builtin_amdgcn_global_load_lds((const unsigned*)((const char*)(gbase) + (voff)[_i]), (PG8_LAS unsigned*)(lds + (bufoff) + ldsw + _i * 8192), 16, 0, 0); } while (0)
#define PG8_LDA(dst, b, h) do { _Pragma("unroll") for (int m = 0; m < 4; ++m) _Pragma("unroll") for (int k = 0; k < 2; ++k) dst[m][k] = *(const PG8_LAS bf16x8*)(lds + PG8_SA(b, h) + aoff + m * 2048 + k * 1024); } while (0)
#define PG8_LDB(dst, b, h) do { _Pragma("unroll") for (int n = 0; n < 2; ++n) _Pragma("unroll") for (int k = 0; k < 2; ++k) dst[n][k] = *(const PG8_LAS bf16x8*)(lds + PG8_SB(b, h) + boff + n * 2048 + k * 1024); } while (0)
#define PG8_MMA(ai, bj, At, Bt) do { __builtin_amdgcn_s_setprio(1); _Pragma("unroll") for (int m = 0; m < 4; ++m) _Pragma("unroll") for (int n = 0; n < 2; ++n) _Pragma("unroll") for (int k = 0; k < 2; ++k) \
        acc[ai][bj][m][n] = __builtin_amdgcn_mfma_f32_16x16x32_bf16(Bt[n][k], At[m][k], acc[ai][bj][m][n], 0, 0, 0); __builtin_amdgcn_s_setprio(0); } while (0)
#define PG8_WAIT_V(n) asm volatile("s_waitcnt vmcnt(" #n ")" ::: "memory")
#define PG8_WAIT_L(n) asm volatile("s_waitcnt lgkmcnt(" #n ")" ::: "memory")
#define PG8_BAR __builtin_amdgcn_s_barrier()
#define PG8_SCHED __builtin_amdgcn_sched_barrier(0)
    Unit cur, nxt; int ui = 0;
    if (!S.next(0, cur)) return;
    f32x4 acc[2][2][4][2];
#pragma unroll
    for (int a = 0; a < 2; ++a)
#pragma unroll
        for (int b = 0; b < 2; ++b)
#pragma unroll
            for (int m = 0; m < 4; ++m)
#pragma unroll
                for (int n = 0; n < 2; ++n) acc[a][b][m][n] = (f32x4){0.f, 0.f, 0.f, 0.f};
    bf16x8 At[4][2], B0[2][2], B1[2][2];
    const char* cA = (const char*)g.A + (size_t)cur.pm * tstep; const char* cB = (const char*)g.Bt + (size_t)cur.pn * tstep;
    S.a_ready(cur);
    if constexpr (SP2) {
        PG8_STAGE(PG8_SB(0, 0), cB, voffB); PG8_STAGE(PG8_SB(0, 1), cB + hstep, voffB); PG8_STAGE(PG8_SA(0, 0), cA, voffA); PG8_STAGE(PG8_SA(0, 1), cA + hstep, voffA);
        if (wr == 1) PG8_BAR;
        PG8_WAIT_V(2); PG8_BAR;
        PG8_STAGE(PG8_SB(1, 0), cB + kstep, voffB); PG8_STAGE(PG8_SA(1, 0), cA + kstep, voffA); PG8_STAGE(PG8_SB(1, 1), cB + hstep + kstep, voffB);
        PG8_WAIT_V(6); PG8_BAR;
    } else {
        PG8_STAGE(PG8_SB(0, 0), cB, voffB); PG8_STAGE(PG8_SA(0, 0), cA, voffA); PG8_STAGE(PG8_SB(0, 1), cB + hstep, voffB); PG8_STAGE(PG8_SA(0, 1), cA + hstep, voffA);
        if (wr == 1) PG8_BAR;
        PG8_WAIT_V(4); PG8_BAR;
        PG8_STAGE(PG8_SB(1, 0), cB + kstep, voffB); PG8_STAGE(PG8_SA(1, 0), cA + kstep, voffA); PG8_STAGE(PG8_SB(1, 1), cB + hstep + kstep, voffB);
        PG8_WAIT_V(6); PG8_BAR;
    }
    for (;;) {
        const bool has_next = S.next(ui + 1, nxt);
        const char* nA = has_next ? (const char*)g.A + (size_t)nxt.pm * tstep : cA; const char* nB = has_next ? (const char*)g.Bt + (size_t)nxt.pn * tstep : cB;
        for (int t = 0; t < nt; t += 2) {
            const bool last = (t == nt - 2);
            const char* a1 = cA + (size_t)(t + 1) * kstep;
            const char* a2 = last ? nA : cA + (size_t)(t + 2) * kstep; const char* b2 = last ? nB : cB + (size_t)(t + 2) * kstep;
            const char* a3 = a2 + kstep; const char* b3 = b2 + kstep;
            if (last && has_next) S.a_ready(nxt);
            if constexpr (SP2) {
            PG8_LDB(B0, 0, 0); PG8_LDB(B1, 0, 1); PG8_SCHED; PG8_LDA(At, 0, 0); PG8_STAGE(PG8_SA(1, 1), a1 + hstep, voffA);
            PG8_WAIT_V(8); PG8_WAIT_L(0); PG8_BAR; PG8_MMA(0, 0, At, B0); PG8_MMA(0, 1, At, B1); PG8_BAR; PG8_SCHED;
            PG8_LDA(At, 0, 1); PG8_STAGE(PG8_SB(0, 0), b2, voffB); PG8_STAGE(PG8_SB(0, 1), b2 + hstep, voffB); PG8_STAGE(PG8_SA(0, 0), a2, voffA);
            PG8_WAIT_V(8); PG8_WAIT_L(0); PG8_BAR; PG8_MMA(1, 0, At, B0); PG8_MMA(1, 1, At, B1); PG8_BAR; PG8_SCHED;
            PG8_LDB(B0, 1, 0); PG8_LDB(B1, 1, 1); PG8_SCHED; PG8_LDA(At, 1, 0); PG8_STAGE(PG8_SA(0, 1), a2 + hstep, voffA);
            PG8_WAIT_V(8); PG8_WAIT_L(0); PG8_BAR; PG8_MMA(0, 0, At, B0); PG8_MMA(0, 1, At, B1); PG8_BAR; PG8_SCHED;
            PG8_LDA(At, 1, 1); PG8_STAGE(PG8_SB(1, 0), b3, voffB); PG8_STAGE(PG8_SB(1, 1), b3 + hstep, voffB); PG8_STAGE(PG8_SA(1, 0), a3, voffA);
            PG8_WAIT_V(8); PG8_WAIT_L(0); PG8_BAR; PG8_MMA(1, 0, At, B0); PG8_MMA(1, 1, At, B1); PG8_BAR; PG8_SCHED;
            } else {
            PG8_LDB(B0, 0, 0); PG8_SCHED; PG8_LDA(At, 0, 0); PG8_STAGE(PG8_SA(1, 1), a1 + hstep, voffA);
            PG8_WAIT_L(8); PG8_BAR; PG8_WAIT_L(0); PG8_MMA(0, 0, At, B0); PG8_BAR; PG8_SCHED;
            PG8_LDB(B1, 0, 1); PG8_STAGE(PG8_SB(0, 0), b2, voffB);
            PG8_BAR; PG8_WAIT_L(0); PG8_MMA(0, 1, At, B1); PG8_BAR;
            PG8_LDA(At, 0, 1); PG8_STAGE(PG8_SA(0, 0), a2, voffA);
            PG8_BAR; PG8_WAIT_L(0); PG8_MMA(1, 0, At, B0); PG8_BAR; PG8_SCHED;
            PG8_STAGE(PG8_SB(0, 1), b2 + hstep, voffB);
            PG8_WAIT_V(6); PG8_BAR; PG8_MMA(1, 1, At, B1); PG8_BAR;
            PG8_LDB(B0, 1, 0); PG8_SCHED; PG8_LDA(At, 1, 0); PG8_STAGE(PG8_SA(0, 1), a2 + hstep, voffA);
            PG8_WAIT_L(8); PG8_BAR; PG8_WAIT_L(0); PG8_MMA(0, 0, At, B0); PG8_BAR; PG8_SCHED;
            PG8_LDB(B1, 1, 1); PG8_STAGE(PG8_SB(1, 0), b3, voffB);
            PG8_BAR; PG8_WAIT_L(0); PG8_MMA(0, 1, At, B1); PG8_BAR;
            PG8_LDA(At, 1, 1); PG8_STAGE(PG8_SA(1, 0), a3, voffA);
            PG8_BAR; PG8_WAIT_L(0); PG8_MMA(1, 0, At, B0); PG8_BAR; PG8_SCHED;
            PG8_STAGE(PG8_SB(1, 1), b3 + hstep, voffB);
            PG8_WAIT_V(6); PG8_BAR; PG8_MMA(1, 1, At, B1); PG8_BAR;
            }
        }
        if constexpr (ALIGN_EPI) { if (wr == 0) PG8_BAR; }
        if constexpr (!Epi::AFTER_DRAIN) { E(acc, cur, wr, wc, fr, fq); S.done(cur); }
        if (!has_next) break;
#pragma unroll
        for (int a = 0; a < 2; ++a)
#pragma unroll
            for (int b = 0; b < 2; ++b)
#pragma unroll
                for (int m = 0; m < 4; ++m)
#pragma unroll
                    for (int n = 0; n < 2; ++n) acc[a][b][m][n] = (f32x4){0.f, 0.f, 0.f, 0.f};
        cur = nxt; cA = nA; cB = nB; ++ui;
        if constexpr (ALIGN_EPI) { if (wr == 1) PG8_BAR; }
    }
    PG8_WAIT_V(0);
    if constexpr (!ALIGN_EPI) { if (wr == 0) PG8_BAR; }
    PG8_BAR;
    if constexpr (Epi::AFTER_DRAIN) { E.fused(acc, cur, wr, wc, fr, fq, lds, wid, lane); S.done(cur); }
#undef PG8_SA
#undef PG8_SB
#undef PG8_STAGE
#undef PG8_LDA
#undef PG8_LDB
#undef PG8_MMA
#undef PG8_WAIT_V
#undef PG8_WAIT_L
#undef PG8_BAR
#undef PG8_SCHED
}
}
__device__ __forceinline__ unsigned cvt_pk(float lo, float hi) { return pg8::cvt_pk_bf16(lo, hi); }
struct EpiStoreBf16 {
    static constexpr bool PERM = true, AFTER_DRAIN = false;
    bf16_t* O; int ldc;
    __device__ __forceinline__ void operator()(const f32x4 (&acc)[2][2][4][2], const pg8::Unit& u, int wr, int wc, int fr, int fq) const {
        const int row0 = u.pm * 256 + wr * 64 + fr, col0 = u.pn * 256 + wc * 32 + 8 * fq;
#pragma unroll
        for (int ai = 0; ai < 2; ++ai)
#pragma unroll
            for (int m = 0; m < 4; ++m) { bf16_t* rowp = O + (size_t)(row0 + ai * 128 + m * 16) * ldc + col0;
#pragma unroll
                for (int bj = 0; bj < 2; ++bj) { const f32x4 v0 = acc[ai][bj][m][0], v1 = acc[ai][bj][m][1];
                    u32x4 w; w.x = cvt_pk(v0[0], v0[1]); w.y = cvt_pk(v0[2], v0[3]); w.z = cvt_pk(v1[0], v1[1]); w.w = cvt_pk(v1[2], v1[3]);
                    *(u32x4*)(rowp + bj * 128) = w; } }
    }
};
struct EpiResid {
    static constexpr bool PERM = false, AFTER_DRAIN = false;
    float* hl; float* hc; const float* mod; int g_off;
    __device__ __forceinline__ void operator()(const f32x4 (&acc)[2][2][4][2], const pg8::Unit& u, int wr, int wc, int fr, int fq) const {
        const int rowt = u.pm * 256; const int col0 = u.pn * 256 + wc * 32 + 4 * fq;
        float* base = rowt < MLAT ? hl + (size_t)rowt * D : hc + (size_t)(rowt - MLAT) * D;
        const float* g = mod + (size_t)(rowt < MLAT ? rowt / S : 8) * 6144 + g_off + col0;
        f32x4 gv[2][2];
#pragma unroll
        for (int bj = 0; bj < 2; ++bj)
#pragma unroll
            for (int n = 0; n < 2; ++n) gv[bj][n] = *(const f32x4*)(g + bj * 128 + n * 16);
#pragma unroll
        for (int ai = 0; ai < 2; ++ai)
#pragma unroll
            for (int m = 0; m < 4; ++m) { float* rp = base + (size_t)(ai * 128 + wr * 64 + m * 16 + fr) * D + col0;
#pragma unroll
                for (int bj = 0; bj < 2; ++bj)
#pragma unroll
                    for (int n = 0; n < 2; ++n) { f32x4* p = (f32x4*)(rp + bj * 128 + n * 16); *p = *p + gv[bj][n] * acc[ai][bj][m][n]; } }
    }
};

DI void p0_tr(const float* W, int N, int K, int k0, int n0, bf16_t* dst, float* scr, int lane) {
#pragma unroll 8
    for (int i = 0; i < 32; ++i) { const int kk = 2 * i + (lane >> 5); scr[kk * 33 + (lane & 31)] = W[(size_t)(k0 + kk) * N + n0 + (lane & 31)]; }
    __builtin_amdgcn_wave_barrier(); asm volatile("s_waitcnt lgkmcnt(0)" ::: "memory");
    const int c = lane & 7;
#pragma unroll
    for (int j = 0; j < 4; ++j) { const int n = (lane >> 3) + 8 * j; const float* s = scr + (8 * c) * 33 + n;
        u32x4 o; o.x = pk2(s[0 * 33], s[1 * 33]); o.y = pk2(s[2 * 33], s[3 * 33]); o.z = pk2(s[4 * 33], s[5 * 33]); o.w = pk2(s[6 * 33], s[7 * 33]);
        *(u32x4*)(dst + (size_t)n * K + k0 + 8 * c) = o; }
    __builtin_amdgcn_wave_barrier(); asm volatile("s_waitcnt lgkmcnt(0)" ::: "memory");
}
DI void p0_transpose_item(const float* W, int K, int N, bf16_t* WT, float* scr, int item, int lane) {
    const int nblk = N / 32, kb = item / nblk, nbk = item % nblk;
    p0_tr(W, N, K, 64 * kb, 32 * nbk, WT + (size_t)(32 * nbk) * K, scr, lane);
}
DI void ph_moe_convert(const Args& a, float* lds, int bid, int nb, int l) {
    const int tid = otid(); const int lane = tid & 63, wv = tid >> 6;
    float* scr = lds + wv * (64 * 33);
    __syncthreads();
    for (int it = bid * NWAVES + wv; it < 32 * 384; it += nb * NWAVES) {
        const int e = it / 384, r = it % 384, le = l * 32 + e;
        if (r < 256) { const int up = r >> 7, q = r & 127, kb = q >> 3, nbk = q & 7, n0 = 32 * nbk;
            const float* W = a.in[up ? I_MWU : I_MWG] + (size_t)le * D * 256;
            bf16_t* dst = (bf16_t*)(a.ws + WS_MW1) + ((size_t)e * 512 + (n0 >> 7) * 256 + up * 128 + (n0 & 127)) * D;
            p0_tr(W, 256, D, 64 * kb, n0, dst, scr, lane);
        } else { const int q = r - 256, kb = q >> 5, nbk = q & 31, n0 = 32 * nbk;
            const float* W = a.in[I_MWD] + (size_t)le * 256 * D;
            bf16_t* dst = (bf16_t*)(a.ws + WS_MW2) + ((size_t)e * 1024 + n0) * 256;
            p0_tr(W, D, 256, 64 * kb, n0, dst, scr, lane);
        }
    }
    __syncthreads();
}
DI void ph_init(const Args& a, float* lds, int bid, int nb) {
    const int tid = otid();
    float* mod = (float*)(a.ws + WS_MOD);
    float* sv = lds;
    float* red = lds + 9 * 1024;
    for (int i = tid; i < 9 * 1024; i += NTHR) { const int r = i >> 10, k = i & 1023; const float x = r < 8 ? a.in[I_C][r * D + k] : a.in[I_CCTX][k]; sv[i] = silu_f(x); }
    __syncthreads();
    for (int it = bid; it < 2 * 96; it += nb) {
        const int l = it / 96, n0 = (it % 96) * 64;
        const int cg = tid & 15, kr = tid >> 4;
        float acc[9][4];
#pragma unroll
        for (int r = 0; r < 9; ++r) { acc[r][0] = acc[r][1] = acc[r][2] = acc[r][3] = 0.f; }
        const float* W = a.in[I_ADAW] + (size_t)l * D * 6144 + n0 + cg * 4;
#pragma unroll 2
        for (int k = kr; k < D; k += 32) {
            const f32x4 w = *(const f32x4*)(W + (size_t)k * 6144);
#pragma unroll
            for (int r = 0; r < 9; ++r) { const float s = sv[r * 1024 + k]; acc[r][0] += s * w.x; acc[r][1] += s * w.y; acc[r][2] += s * w.z; acc[r][3] += s * w.w; }
        }
#pragma unroll
        for (int r = 0; r < 9; ++r)
#pragma unroll
            for (int j = 0; j < 4; ++j) red[(kr * 9 + r) * 64 + cg * 4 + j] = acc[r][j];
        __syncthreads();
        for (int o = tid; o < 9 * 64; o += NTHR) {
            const int r = o >> 6, c = o & 63; float s = 0.f;
#pragma unroll 4
            for (int q = 0; q < 32; ++q) s += red[(q * 9 + r) * 64 + c];
            mod[((size_t)l * 9 + r) * 6144 + n0 + c] = s + a.in[I_ADAB][l * 6144 + n0 + c];
        }
        __syncthreads();
    }
    {
        const f32x4* x4 = (const f32x4*)a.in[I_X]; f32x4* o4 = (f32x4*)a.out;
        for (size_t i = (size_t)bid * NTHR + tid; i < (size_t)MLAT * D / 4; i += (size_t)nb * NTHR) o4[i] = x4[i];
        const f32x4* c4 = (const f32x4*)a.in[I_CTX]; f32x4* h4 = (f32x4*)(a.ws + WS_HC);
        for (size_t i = (size_t)bid * NTHR + tid; i < (size_t)MCTX * D / 4; i += (size_t)nb * NTHR) h4[i] = c4[i];
    }
    {
        float* z = lds;
        float* h1 = lds + 64;
        float* h2 = lds + 128;
        const float* w1 = a.in[I_HYW1]; const float* b1 = a.in[I_HYB1]; const float* w2 = a.in[I_HYW2]; const float* b2 = a.in[I_HYB2];
        const float* w3 = a.in[I_HYW3]; const float* fr = a.in[I_HYFREQ];
        __syncthreads();
        for (int it = bid; it < S + C; it += nb) {
            const bool lat = it < S; const int L = lat ? S : C; const int lag = lat ? it : it - S;
            const float t = (float)lag / (float)(L - 1);
            const float w = (6.283185307179586f / (float)L) * (float)lag;
            if (tid < 33) {
                float v;
                if (tid == 0) v = t;
                else { const int i = (tid - 1) & 15; const float fb = 1e-4f + (float)i * ((15.f - 1e-4f) / 15.f); v = (tid <= 16) ? cosf(fb * w) : -sinf(fb * w); }
                z[tid] = v;
            }
            __syncthreads();
            if (tid < 64) { float s = b1[tid];
#pragma unroll 1
                for (int i = 0; i < 33; ++i) s += z[i] * w1[i * 64 + tid]; h1[tid] = sinf(fr[tid] * s); }
            __syncthreads();
            if (tid < 64) { float s = b2[tid];
#pragma unroll 4
                for (int i = 0; i < 64; ++i) s += h1[i] * w2[i * 64 + tid]; h2[tid] = sinf(fr[64 + tid] * s); }
            __syncthreads();
            for (int o = tid; o < 2048; o += NTHR) {
                float s = 0.f;
#pragma unroll 8
                for (int i = 0; i < 64; ++i) s += h2[i] * w3[i * 2048 + o];
                const int ord = o >> 10, dir = (o >> 9) & 1, ch = o & 511;
                const float dmin = -3.0701134573253945f, dmax = -15.350567286626973f;
                const float delta = fabsf(dmin + (dmax - dmin) * ((float)ch / 511.f));
                s *= expf(-t * delta);
                if (lat) { float* g = (float*)(a.ws + WS_HFL) + ((size_t)ord * 512 + ch) * 4096;
                    if (dir == 0) g[2047 + lag] = s; else if (lag > 0) g[2047 - lag] = s; }
                else { float* g = (float*)(a.ws + WS_HFC) + ((size_t)ord * 512 + ch) * 512;
                    if (dir == 0) g[255 + lag] = s; else if (lag > 0) g[255 - lag] = s; }
            }
            __syncthreads();
        }
    }
    {
        __syncthreads();
        const int lane = tid & 63, wv = tid >> 6;
        float* scr = lds + wv * (64 * 33);
        constexpr int I_A = (D / 64) * (E_IN / 32), I_B = (D / 64) * (D / 32), I_C2 = (D / 64) * (O_IN / 32);
        constexpr int NIT = I_A + I_B + I_C2 + I_B;
        for (int it = bid * NWAVES + wv; it < NIT; it += nb * NWAVES) {
            int r = it;
            if (r < I_A) { p0_transpose_item(a.in[I_EWIN], D, E_IN, (bf16_t*)(a.ws + WS_WEIN), scr, r, lane); continue; } r -= I_A;
            if (r < I_B) { p0_transpose_item(a.in[I_EWOUT], D, D, (bf16_t*)(a.ws + WS_WEOUT), scr, r, lane); continue; } r -= I_B;
            if (r < I_C2) { p0_transpose_item(a.in[I_OWIN], D, O_IN, (bf16_t*)(a.ws + WS_WOIN), scr, r, lane); continue; } r -= I_C2;
            p0_transpose_item(a.in[I_OWOUT], D, D, (bf16_t*)(a.ws + WS_WOOUT), scr, r, lane);
        }
    }
    ph_moe_convert(a, lds, bid, nb, 0);
}

DI const float* row_ptr(const Args& a, int m) { return m < MLAT ? a.out + (size_t)m * D : (const float*)(a.ws + WS_HC) + (size_t)(m - MLAT) * D; }
DI float* row_ptr_w(const Args& a, int m) { return m < MLAT ? a.out + (size_t)m * D : (float*)(a.ws + WS_HC) + (size_t)(m - MLAT) * D; }
DI int mod_row(int m) { return m < MLAT ? m / S : 8; }
DI void ph_norm(const Args& a, int bid, int nb, int nrows, const float* mod, int sh_off, int sc_off) {
    const int tid = otid(); const int lane = tid & 63, wv = tid >> 6;
    bf16_t* XN = (bf16_t*)(a.ws + WS_XN);
    for (int m = bid * NWAVES + wv; m < nrows; m += nb * NWAVES) {
        const f32x4* r = (const f32x4*)row_ptr(a, m); f32x4 v[4]; float s = 0.f;
#pragma unroll
        for (int j = 0; j < 4; ++j) { v[j] = r[lane + 64 * j]; s += v[j].x * v[j].x + v[j].y * v[j].y + v[j].z * v[j].z + v[j].w * v[j].w; }
        s = wave_sum(s);
        const float rs = 1.f / sqrtf(s * (1.f / D) + EPS);
        const float* mr = mod + (size_t)mod_row(m) * 6144;
        u32x2* o = (u32x2*)(XN + (size_t)m * D);
#pragma unroll
        for (int j = 0; j < 4; ++j) { const f32x4 sh = *(const f32x4*)(mr + sh_off + 4 * (lane + 64 * j)), sc = *(const f32x4*)(mr + sc_off + 4 * (lane + 64 * j));
            u32x2 w; w.x = pk2(v[j].x * rs * (1.f + sc.x) + sh.x, v[j].y * rs * (1.f + sc.y) + sh.y); w.y = pk2(v[j].z * rs * (1.f + sc.z) + sh.z, v[j].w * rs * (1.f + sc.w) + sh.w);
            o[lane + 64 * j] = w; }
    }
}

DI void axial_rope64(float& v, int lane, int t) {
    const int axis = lane >> 5, half = (lane >> 4) & 1, f = lane & 15;
    const float pos = (float)(axis == 0 ? (t >> 6) : (t & 63));
    const float inv = exp2f(-(float)f * (13.287712379549449f / 16.f));
    const float ang = pos * inv, c = cosf(ang), s = sinf(ang);
    const float other = __shfl_xor(v, 16);
    v = half == 0 ? (v * c - other * s) : (v * c + other * s);
}
constexpr int NPOS = C + S;
DI int pos_row(int b, int p) { return p < C ? MLAT + b * C + p : b * S + (p - C); }
DI void ph_prep0(const Args& a, float* lds, int bid, int nb) {
    const int tid = otid(); const int lane = tid & 63, wv = tid >> 6;
    const bf16_t* U = (const bf16_t*)(a.ws + WS_U);
    bf16_t* QP = (bf16_t*)(a.ws + WS_XN); bf16_t* KP = (bf16_t*)(a.ws + WS_ATT); bf16_t* VT = KP + (size_t)32 * 2 * NPOS * 64;
    bf16_t* vs = (bf16_t*)lds;
    const float gq = a.in[I_DAQN][lane], gk = a.in[I_DAKN][lane];
    for (int it = bid; it < 32 * 36; it += nb) {
        const int bh = it / 36, ch = it % 36, b = bh >> 2, h = bh & 3, p0 = ch * 64;
        __syncthreads();
#pragma unroll
        for (int i = 0; i < 2; ++i) { const int c = tid + 512 * i, pp = c >> 4, part = c & 15;
            const u32x4 w = *(const u32x4*)(U + (size_t)pos_row(b, p0 + pp) * E_IN + 2560 + h * 128 + part * 8);
            unsigned* d = (unsigned*)(vs + pp * 130 + part * 8); d[0] = w.x; d[1] = w.y; d[2] = w.z; d[3] = w.w; }
        for (int wi = wv; wi < 256; wi += NWAVES) {
            const int pp = wi >> 2, j = wi & 3, isk = j >> 1, map = j & 1; const int p = p0 + pp;
            float v = bf2f(U[(size_t)pos_row(b, p) * E_IN + 1536 + isk * 512 + h * 128 + map * 64 + lane]);
            const float ss = wave_sum(v * v);
            v = v * (1.f / sqrtf(ss * (1.f / 64.f) + EPS)) * (isk ? gk : gq);
            if (p >= C) axial_rope64(v, lane, p - C);
            if (!isk) v *= 0.125f * 1.4426950408889634f;
            (isk ? KP : QP)[((size_t)(bh * 2 + map) * NPOS + p) * 64 + lane] = (bf16_t)f2bf(v);
        }
        __syncthreads();
        { const int dv = tid >> 2, pg = tid & 3; unsigned w[8];
#pragma unroll
          for (int i = 0; i < 8; ++i) { const unsigned lo = vs[(pg * 16 + 2 * i) * 130 + dv], hi = vs[(pg * 16 + 2 * i + 1) * 130 + dv]; w[i] = lo | (hi << 16); }
          u32x4* d = (u32x4*)(VT + ((size_t)bh * 128 + dv) * NPOS + p0 + pg * 16);
          u32x4 w0 = {w[0], w[1], w[2], w[3]}, w1 = {w[4], w[5], w[6], w[7]}; d[0] = w0; d[1] = w1; }
    }
}

typedef short bf16x8 __attribute__((ext_vector_type(8)));
typedef short s16x4 __attribute__((ext_vector_type(4)));
typedef float f32x16 __attribute__((ext_vector_type(16)));
#define MFMA32(a, b, c) __builtin_amdgcn_mfma_f32_32x32x16_bf16((a), (b), (c), 0, 0, 0)
DI int crow16(int i, int hh) { return (i & 3) + 8 * (i >> 2) + 4 * hh; }
DI bf16x8 pack8(const f32x16& x, int s) {
    u32x4 p; p.x = cvt_pk(x[8 * s], x[8 * s + 1]); p.y = cvt_pk(x[8 * s + 2], x[8 * s + 3]); p.z = cvt_pk(x[8 * s + 4], x[8 * s + 5]); p.w = cvt_pk(x[8 * s + 6], x[8 * s + 7]);
    return __builtin_bit_cast(bf16x8, p);
}
DI void ph_diffattn(const Args& a, unsigned char* lds, int bid, int nb) {
    const int tid = otid(); const int lane = tid & 63, wv = tid >> 6, q32 = lane & 31, hh = lane >> 5, qsub = wv >> 1, map = wv & 1;
    const bf16_t* QP = (const bf16_t*)(a.ws + WS_XN); const bf16_t* KP = (const bf16_t*)(a.ws + WS_ATT); const bf16_t* VT = KP + (size_t)32 * 2 * NPOS * 64;
    bf16_t* MIX = (bf16_t*)(a.ws + WS_MIX);
    constexpr int KBUF = 2 * 64 * 144, VBUF = 128 * 136, TBUF = KBUF + VBUF;
    unsigned char* xbuf = lds + 2 * TBUF;
    const float* lp = a.in[I_DALAM];
    const float lam_init = 0.2f;
    const float lam = expf(wave_sum(lp[lane] * lp[64 + lane])) - expf(wave_sum(lp[128 + lane] * lp[192 + lane])) + lam_init;
    for (int u = bid; u < 32 * 18; u += nb) {
        const int bh = u / 18, qb = u % 18, b = bh >> 2, h = bh & 3; const int nt = qb < 2 ? 4 : 36;
        bf16x8 qf[4];
        { const bf16_t* qg = QP + ((size_t)(bh * 2 + map) * NPOS + qb * 128 + qsub * 32 + q32) * 64 + 8 * hh;
#pragma unroll
          for (int ks = 0; ks < 4; ++ks) qf[ks] = *(const bf16x8*)(qg + 16 * ks); }
        const bf16_t* Kg = KP + (size_t)(bh * 2) * NPOS * 64; const bf16_t* Vg = VT + (size_t)bh * 128 * NPOS;
        u32x4 st[4];
        auto gload = [&](int t) {
#pragma unroll
            for (int i = 0; i < 2; ++i) { const int c = tid + 512 * i;
                st[i] = *(const u32x4*)(Kg + ((size_t)(c >> 9) * NPOS + t * 64 + ((c >> 3) & 63)) * 64 + (c & 7) * 8);
                st[2 + i] = *(const u32x4*)(Vg + (size_t)(c >> 3) * NPOS + t * 64 + (c & 7) * 8); } };
        auto lstore = [&](int buf) {
            unsigned char* kb = lds + buf * TBUF; unsigned char* vb = kb + KBUF;
#pragma unroll
            for (int i = 0; i < 2; ++i) { const int c = tid + 512 * i;
                *(u32x4*)(kb + (c >> 9) * (64 * 144) + ((c >> 3) & 63) * 144 + (c & 7) * 16) = st[i];
                u32x2* d = (u32x2*)(vb + (c >> 3) * 136 + (c & 7) * 16); u32x2 lo = {st[2 + i].x, st[2 + i].y}, hi = {st[2 + i].z, st[2 + i].w}; d[0] = lo; d[1] = hi; } };
        __syncthreads();
        gload(0); lstore(0);
        __syncthreads();
        f32x16 O[4];
#pragma unroll
        for (int d = 0; d < 4; ++d)
#pragma unroll
            for (int i = 0; i < 16; ++i) O[d][i] = 0.f;
        float m_run = -1e30f, l_run = 0.f;
        for (int t = 0; t < nt; ++t) {
            if (t + 1 < nt) gload(t + 1);
            const unsigned char* kb = lds + (t & 1) * TBUF + map * (64 * 144); const unsigned char* vb = lds + (t & 1) * TBUF + KBUF;
            f32x16 S0, S1;
#pragma unroll
            for (int i = 0; i < 16; ++i) { S0[i] = 0.f; S1[i] = 0.f; }
#pragma unroll
            for (int ks = 0; ks < 4; ++ks) {
                const bf16x8 k0 = *(const bf16x8*)(kb + q32 * 144 + 32 * ks + 16 * hh), k1 = *(const bf16x8*)(kb + (32 + q32) * 144 + 32 * ks + 16 * hh);
                S0 = MFMA32(k0, qf[ks], S0); S1 = MFMA32(k1, qf[ks], S1);
            }
            float mx = S0[0];
#pragma unroll
            for (int i = 1; i < 16; ++i) mx = fmaxf(mx, S0[i]);
#pragma unroll
            for (int i = 0; i < 16; ++i) mx = fmaxf(mx, S1[i]);
            mx = fmaxf(mx, __shfl_xor(mx, 32));
            const float m_new = fmaxf(m_run, mx); const float alpha = exp2f(m_run - m_new); m_run = m_new;
            float rsum = 0.f;
#pragma unroll
            for (int i = 0; i < 16; ++i) { S0[i] = exp2f(S0[i] - m_new); S1[i] = exp2f(S1[i] - m_new); rsum += S0[i] + S1[i]; }
            rsum += __shfl_xor(rsum, 32);
            l_run = l_run * alpha + rsum;
#pragma unroll
            for (int d = 0; d < 4; ++d)
#pragma unroll
                for (int i = 0; i < 16; ++i) O[d][i] *= alpha;
            const bf16x8 p00 = pack8(S0, 0), p01 = pack8(S0, 1), p10 = pack8(S1, 0), p11 = pack8(S1, 1);
#pragma unroll
            for (int d = 0; d < 4; ++d) {
                const unsigned char* vr = vb + (32 * d + q32) * 136 + 8 * hh;
                auto vfrag = [&](int koff) { const s16x4 lo = *(const s16x4*)(vr + koff * 2), hi = *(const s16x4*)(vr + koff * 2 + 16); return __builtin_shufflevector(lo, hi, 0, 1, 2, 3, 4, 5, 6, 7); };
                O[d] = MFMA32(vfrag(0), p00, O[d]); O[d] = MFMA32(vfrag(16), p01, O[d]); O[d] = MFMA32(vfrag(32), p10, O[d]); O[d] = MFMA32(vfrag(48), p11, O[d]);
            }
            if (t + 1 < nt) lstore((t + 1) & 1);
            __syncthreads();
        }
        float* xb = (float*)xbuf + qsub * (128 * 32);
        if (map == 1) { const float sc = lam / l_run;
#pragma unroll
            for (int d = 0; d < 4; ++d)
#pragma unroll
                for (int i = 0; i < 16; ++i) xb[(32 * d + crow16(i, hh)) * 32 + q32] = O[d][i] * sc; }
        __syncthreads();
        bf16_t* ob = (bf16_t*)lds;
        if (map == 0) { const float sc = 1.f / l_run; float ss = 0.f;
#pragma unroll
            for (int d = 0; d < 4; ++d)
#pragma unroll
                for (int i = 0; i < 16; ++i) { const float o = O[d][i] * sc - xb[(32 * d + crow16(i, hh)) * 32 + q32]; O[d][i] = o; ss += o * o; }
            ss += __shfl_xor(ss, 32);
            const float rs = (1.f / sqrtf(ss * (1.f / 128.f) + EPS)) * (1.f - lam_init);
#pragma unroll
            for (int d = 0; d < 4; ++d)
#pragma unroll
                for (int i = 0; i < 16; ++i) { const int dv = 32 * d + crow16(i, hh); ob[(qsub * 32 + q32) * 136 + dv] = (bf16_t)f2bf(O[d][i] * rs * a.in[I_DASUB][dv]); } }
        __syncthreads();
#pragma unroll
        for (int i = 0; i < 4; ++i) { const int c = tid + 512 * i, qq = c >> 4, part = c & 15;
            const u32x2* s = (const u32x2*)(ob + qq * 136 + part * 8); const u32x2 lo = s[0], hi = s[1]; u32x4 w = {lo.x, lo.y, hi.x, hi.y};
            *(u32x4*)(MIX + (size_t)pos_row(b, qb * 128 + qq) * D + 512 + h * 128 + part * 8) = w; }
    }
}

DI void ph_hyena(const Args& a, float* lds, int bid, int nb, int item0, int item1) {
    const int tid = otid();
    const bf16_t* U = (const bf16_t*)(a.ws + WS_U); bf16_t* MIX = (bf16_t*)(a.ws + WS_MIX);
    float* zs = lds; float* g1 = lds + 2048; float* g2 = lds + 4096; float* ys = lds + 6144; float* gf = lds + 8192;
    const float* cw = a.in[I_HYCW]; const float* cb = a.in[I_HYCB];
    for (int it = item0 + bid; it < item1; it += nb) {
        const bool lat = it < NB * 512; const int r = lat ? it : it - NB * 512; const int b = r >> 9, ch = r & 511;
        const int L = lat ? S : C; const int mb = lat ? b * S : MLAT + b * C;
        __syncthreads();
        for (int t = tid; t < L; t += NTHR) {
#pragma unroll
            for (int q = 0; q < 3; ++q) {
                const int col = q * 512 + ch;
                const float um = t > 0 ? bf2f(U[(size_t)(mb + t - 1) * E_IN + col]) : 0.f, u0 = bf2f(U[(size_t)(mb + t) * E_IN + col]), up = t < L - 1 ? bf2f(U[(size_t)(mb + t + 1) * E_IN + col]) : 0.f;
                const float v = cw[col] * um + cw[1536 + col] * u0 + cw[3072 + col] * up + cb[col];
                (q == 0 ? zs : q == 1 ? g1 : g2)[t] = v;
            }
        }
        for (int n = 0; n < 2; ++n) {
            __syncthreads();
            const float* gsrc = lat ? (const float*)(a.ws + WS_HFL) + ((size_t)n * 512 + ch) * 4096 : (const float*)(a.ws + WS_HFC) + ((size_t)n * 512 + ch) * 512;
            for (int i = tid; i < 2 * L - 1; i += NTHR) gf[i] = gsrc[i];
            __syncthreads();
            const float bias = a.in[I_HYBIAS][n * 512 + ch];
            for (int t = tid; t < L; t += NTHR) {
                float acc = 0.f; const float* gp = gf + t + L - 1;
                for (int s = 0; s < L; ++s) acc += gp[-s] * zs[s];
                ys[t] = (n == 0 ? g1 : g2)[t] * (acc + bias * zs[t]);
            }
            __syncthreads();
            for (int t = tid; t < L; t += NTHR) zs[t] = ys[t];
        }
        __syncthreads();
        for (int t = tid; t < L; t += NTHR) MIX[(size_t)(mb + t) * D + ch] = (bf16_t)f2bf(zs[t]);
    }
}

constexpr int CW_CNT = 8192;
constexpr int MOE_MAXT = 176;
DI void ph_route(const Args& a, float* lds, int bid, int nb, int l, int nrows) {
    const int tid = otid(); const int lane = tid & 63, wv = tid >> 6;
    const float* mod = (const float*)(a.ws + WS_MOD) + (size_t)l * 9 * 6144;
    const float* wgrp = a.in[I_MWGRP] + (size_t)l * D * 4; const float* bgrp = a.in[I_MBGRP] + l * 4;
    const float* wrt = a.in[I_MWRT] + (size_t)l * D * 32; const float* brt = a.in[I_MBRT] + l * 32;
    bf16_t* XN = (bf16_t*)(a.ws + WS_XN);
    unsigned* cnt = (unsigned*)(a.ws + WS_CTL) + CW_CNT + l * 32 * 64;
    int* tok_e = (int*)(a.ws + WS_TOK); int* tok_pos = tok_e + 2 * MALL; float* tok_w = (float*)(tok_pos + 2 * MALL);
    float* part = lds + wv * (36 * 65);
    for (int m = bid * NWAVES + wv; m < nrows; m += nb * NWAVES) {
        const f32x4* r = (const f32x4*)row_ptr(a, m); f32x4 v[4]; float s = 0.f;
#pragma unroll
        for (int j = 0; j < 4; ++j) { v[j] = r[lane + 64 * j]; s += v[j].x * v[j].x + v[j].y * v[j].y + v[j].z * v[j].z + v[j].w * v[j].w; }
        s = wave_sum(s);
        const float rs = 1.f / sqrtf(s * (1.f / D) + EPS);
        const float* mr = mod + (size_t)mod_row(m) * 6144;
        u32x2* o = (u32x2*)(XN + (size_t)m * D);
#pragma unroll
        for (int j = 0; j < 4; ++j) { const f32x4 sh = *(const f32x4*)(mr + 3072 + 4 * (lane + 64 * j)), sc = *(const f32x4*)(mr + 4096 + 4 * (lane + 64 * j));
            v[j].x = v[j].x * rs * (1.f + sc.x) + sh.x; v[j].y = v[j].y * rs * (1.f + sc.y) + sh.y; v[j].z = v[j].z * rs * (1.f + sc.z) + sh.z; v[j].w = v[j].w * rs * (1.f + sc.w) + sh.w;
            u32x2 w; w.x = pk2(v[j].x, v[j].y); w.y = pk2(v[j].z, v[j].w); o[lane + 64 * j] = w; }
        float p[36];
#pragma unroll
        for (int i = 0; i < 36; ++i) p[i] = 0.f;
#pragma unroll
        for (int j = 0; j < 4; ++j)
#pragma unroll
            for (int kk = 0; kk < 4; ++kk) { const int k = 4 * (lane + 64 * j) + kk; const float vv = v[j][kk];
                const f32x4 wg = *(const f32x4*)(wgrp + (size_t)k * 4);
                p[0] += vv * wg.x; p[1] += vv * wg.y; p[2] += vv * wg.z; p[3] += vv * wg.w;
#pragma unroll
                for (int q = 0; q < 8; ++q) { const f32x4 wr = *(const f32x4*)(wrt + (size_t)k * 32 + 4 * q); p[4 + 4 * q] += vv * wr.x; p[5 + 4 * q] += vv * wr.y; p[6 + 4 * q] += vv * wr.z; p[7 + 4 * q] += vv * wr.w; } }
#pragma unroll
        for (int i = 0; i < 36; ++i) part[i * 65 + lane] = p[i];
        __builtin_amdgcn_wave_barrier();
        float lgv = 0.f;
        if (lane < 36) { const float* pp = part + lane * 65;
#pragma unroll 8
            for (int i = 0; i < 64; ++i) lgv += pp[i];
            lgv += lane < 4 ? bgrp[lane] : brt[lane - 4]; }
        __builtin_amdgcn_wave_barrier();
        const float g0 = __shfl(lgv, 0), g1 = __shfl(lgv, 1), g2 = __shfl(lgv, 2), g3 = __shfl(lgv, 3);
        int g = 0; float gm = g0;
        if (g1 > gm) { gm = g1; g = 1; } if (g2 > gm) { gm = g2; g = 2; } if (g3 > gm) { gm = g3; g = 3; }
        const float pg = 1.f / (expf(g0 - gm) + expf(g1 - gm) + expf(g2 - gm) + expf(g3 - gm));
        float le[8];
#pragma unroll
        for (int i = 0; i < 8; ++i) le[i] = __shfl(lgv, 4 + 8 * g + i);
        int e0 = 0; float v0 = le[0];
#pragma unroll
        for (int i = 1; i < 8; ++i) if (le[i] > v0) { v0 = le[i]; e0 = i; }
        int e1 = -1; float v1 = -3.4e38f;
#pragma unroll
        for (int i = 0; i < 8; ++i) if (i != e0 && le[i] > v1) { v1 = le[i]; e1 = i; }
        const float p1 = expf(v1 - v0); const float w0 = pg / (1.f + p1), w1 = pg * p1 / (1.f + p1);
        if (lane == 0) {
            const int E0 = g * 8 + e0, E1 = g * 8 + e1;
            const unsigned q0 = __hip_atomic_fetch_add(cnt + E0 * 64, 1u, __ATOMIC_RELAXED, __HIP_MEMORY_SCOPE_AGENT);
            const unsigned q1 = __hip_atomic_fetch_add(cnt + E1 * 64, 1u, __ATOMIC_RELAXED, __HIP_MEMORY_SCOPE_AGENT);
            tok_e[2 * m] = E0; tok_e[2 * m + 1] = E1; tok_pos[2 * m] = (int)q0; tok_pos[2 * m + 1] = (int)q1; tok_w[2 * m] = w0; tok_w[2 * m + 1] = w1;
        }
    }
}
DI void moe_tables(const Args& a, int* tab, int l, int tid) {
    const unsigned* cnt = (const unsigned*)(a.ws + WS_CTL) + CW_CNT + l * 32 * 64;
    if (tid == 0) { int t = 0; for (int e = 0; e < 32; ++e) { tab[e] = t; const int c = (int)__hip_atomic_load(cnt + e * 64, __ATOMIC_RELAXED, __HIP_MEMORY_SCOPE_AGENT); const int nt = (c + 255) >> 8; for (int i = 0; i < nt; ++i) tab[33 + t + i] = e; t += nt; } tab[32] = t; }
    __syncthreads();
}
DI void ph_gather(const Args& a, float* lds, int bid, int nb, int l, int nrows) {
    const int tid = otid(); const int lane = tid & 63, wv = tid >> 6;
    int* tab = (int*)(lds + 32768);
    moe_tables(a, tab, l, tid);
    const bf16_t* XN = (const bf16_t*)(a.ws + WS_XN); bf16_t* XS = (bf16_t*)(a.ws + WS_U);
    const int* tok_e = (const int*)(a.ws + WS_TOK); const int* tok_pos = tok_e + 2 * MALL; const float* tok_w = (const float*)(tok_pos + 2 * MALL); int* tok_dst = (int*)(tok_w + 2 * MALL);
    float* roww = (float*)(a.ws + WS_ROWW);
    for (int m = bid * NWAVES + wv; m < nrows; m += nb * NWAVES) {
        const u32x4* src = (const u32x4*)(XN + (size_t)m * D);
        const u32x4 x0 = src[lane], x1 = src[64 + lane];
#pragma unroll
        for (int k = 0; k < 2; ++k) {
            const int e = tok_e[2 * m + k]; const int dst = tab[e] * 256 + tok_pos[2 * m + k];
            u32x4* d = (u32x4*)(XS + (size_t)dst * D); d[lane] = x0; d[64 + lane] = x1;
            if (lane == 0) { roww[dst] = tok_w[2 * m + k]; tok_dst[2 * m + k] = dst; }
        }
    }
}
template <int NPN> struct MoeOrder {
    const int* tab; int G, c;
    __device__ bool next(int i, pg8::Unit& u) const { const int L = i * G + c; if (L >= tab[32] * NPN) return false; u.pm = L / NPN; u.pn = tab[33 + u.pm] * NPN + (L % NPN); return true; }
    __device__ __forceinline__ void a_ready(const pg8::Unit&) const {}
    __device__ __forceinline__ void done(const pg8::Unit&) const {}
};
struct EpiSwiGLU {
    static constexpr bool PERM = true, AFTER_DRAIN = false;
    bf16_t* H; const float* roww;
    __device__ __forceinline__ void operator()(const f32x4 (&acc)[2][2][4][2], const pg8::Unit& u, int wr, int wc, int fr, int fq) const {
        const int row0 = u.pm * 256 + wr * 64 + fr, col0 = (u.pn & 1) * 128 + wc * 32 + 8 * fq;
#pragma unroll
        for (int ai = 0; ai < 2; ++ai)
#pragma unroll
            for (int m = 0; m < 4; ++m) { const int r = row0 + ai * 128 + m * 16; const float w = roww[r];
                float hv[8];
#pragma unroll
                for (int n = 0; n < 2; ++n)
#pragma unroll
                    for (int j = 0; j < 4; ++j) { const float g = acc[ai][0][m][n][j], up = acc[ai][1][m][n][j]; hv[4 * n + j] = g / (1.f + __expf(-g)) * up * w; }
                u32x4 o; o.x = cvt_pk(hv[0], hv[1]); o.y = cvt_pk(hv[2], hv[3]); o.z = cvt_pk(hv[4], hv[5]); o.w = cvt_pk(hv[6], hv[7]);
                *(u32x4*)(H + (size_t)r * 256 + col0) = o; }
    }
};
struct EpiStoreY {
    static constexpr bool PERM = true, AFTER_DRAIN = false;
    bf16_t* O;
    __device__ __forceinline__ void operator()(const f32x4 (&acc)[2][2][4][2], const pg8::Unit& u, int wr, int wc, int fr, int fq) const {
        const int row0 = u.pm * 256 + wr * 64 + fr, col0 = (u.pn & 3) * 256 + wc * 32 + 8 * fq;
#pragma unroll
        for (int ai = 0; ai < 2; ++ai)
#pragma unroll
            for (int m = 0; m < 4; ++m) { bf16_t* rowp = O + (size_t)(row0 + ai * 128 + m * 16) * D + col0;
#pragma unroll
                for (int bj = 0; bj < 2; ++bj) { const f32x4 v0 = acc[ai][bj][m][0], v1 = acc[ai][bj][m][1];
                    u32x4 w; w.x = cvt_pk(v0[0], v0[1]); w.y = cvt_pk(v0[2], v0[3]); w.z = cvt_pk(v1[0], v1[1]); w.w = cvt_pk(v1[2], v1[3]);
                    *(u32x4*)(rowp + bj * 128) = w; } }
    }
};
DI void ph_combine(const Args& a, int bid, int nb, int l, int nrows, bool next_norm) {
    const int tid = otid(); const int lane = tid & 63, wv = tid >> 6;
    const float* mod = (const float*)(a.ws + WS_MOD) + (size_t)l * 9 * 6144; const float* modn = (const float*)(a.ws + WS_MOD) + (size_t)(l + 1) * 9 * 6144;
    const bf16_t* Y = (const bf16_t*)(a.ws + WS_U); bf16_t* XN = (bf16_t*)(a.ws + WS_XN);
    const int* tok_dst = (const int*)(a.ws + WS_TOK) + 6 * MALL;
    for (int m = bid * NWAVES + wv; m < nrows; m += nb * NWAVES) {
        f32x4* r = (f32x4*)row_ptr_w(a, m); const float* mr = mod + (size_t)mod_row(m) * 6144 + 5120;
        const bf16_t* y0 = Y + (size_t)tok_dst[2 * m] * D; const bf16_t* y1 = Y + (size_t)tok_dst[2 * m + 1] * D;
        f32x4 v[4]; float s = 0.f;
#pragma unroll
        for (int j = 0; j < 4; ++j) { const int c4 = lane + 64 * j; const f32x4 g = *(const f32x4*)(mr + 4 * c4); const f32x4 ya = ld4bf(y0 + 4 * c4), yb = ld4bf(y1 + 4 * c4);
            v[j] = r[c4] + g * (ya + yb); r[c4] = v[j]; s += v[j].x * v[j].x + v[j].y * v[j].y + v[j].z * v[j].z + v[j].w * v[j].w; }
        if (next_norm) {
            s = wave_sum(s); const float rs = 1.f / sqrtf(s * (1.f / D) + EPS);
            const float* mn = modn + (size_t)mod_row(m) * 6144; u32x2* o = (u32x2*)(XN + (size_t)m * D);
#pragma unroll
            for (int j = 0; j < 4; ++j) { const f32x4 sh = *(const f32x4*)(mn + 4 * (lane + 64 * j)), sc = *(const f32x4*)(mn + 1024 + 4 * (lane + 64 * j));
                u32x2 w; w.x = pk2(v[j].x * rs * (1.f + sc.x) + sh.x, v[j].y * rs * (1.f + sc.y) + sh.y); w.y = pk2(v[j].z * rs * (1.f + sc.z) + sh.z, v[j].w * rs * (1.f + sc.w) + sh.w);
                o[lane + 64 * j] = w; }
        }
    }
}

constexpr size_t ATT_KR = 0, ATT_VRT = (size_t)32 * NPOS * 128, ATT_GK = 2 * ATT_VRT, ATT_GVT = ATT_GK + (size_t)16 * NPOS * 64;
constexpr size_t XN_QR = 0, XN_GQ = (size_t)32 * S * 128;
DI void ph_prep1(const Args& a, float* lds, int bid, int nb) {
    const int tid = otid(); const int lane = tid & 63, wv = tid >> 6;
    const bf16_t* U = (const bf16_t*)(a.ws + WS_U);
    bf16_t* XNb = (bf16_t*)(a.ws + WS_XN); bf16_t* ATb = (bf16_t*)(a.ws + WS_ATT);
    bf16_t* vs = (bf16_t*)lds;
    const float gq = a.in[I_GQQN][lane], gk = a.in[I_GQKN][lane];
    const float rscale = 0.08838834764831845f;
    const float inv1d = exp2f(-(float)lane * (13.287712379549449f / 63.f));
    for (int it = bid; it < NB * 36; it += nb) {
        const int b = it / 36, ch = it % 36, p0 = ch * 64;
        __syncthreads();
#pragma unroll
        for (int i = 0; i < 10; ++i) { const int c = tid + 512 * i, pp = c / 80, part = c % 80;
            const u32x4 w = *(const u32x4*)(U + (size_t)pos_row(b, p0 + pp) * O_IN + (part < 64 ? 1024 + part * 8 : 2688 + (part - 64) * 8));
            unsigned* d = (unsigned*)(vs + pp * 642 + part * 8); d[0] = w.x; d[1] = w.y; d[2] = w.z; d[3] = w.w; }
        for (int wi = wv; wi < 64 * 18; wi += NWAVES) {
            const int pp = wi / 18, j = wi % 18; const int p = p0 + pp; const bool lat = p >= C; const int t = p - C;
            const bf16_t* ur = U + (size_t)pos_row(b, p) * O_IN;
            if (j < 8) {
                if (j < 4 && !lat) continue;
                float x1 = bf2f(ur[j * 128 + lane]), x2 = bf2f(ur[j * 128 + 64 + lane]);
                if (lat) { const float ang = (float)t * inv1d, c = cosf(ang), s = sinf(ang); const float y1 = x1 * c - x2 * s, y2 = x2 * c + x1 * s; x1 = y1; x2 = y2; }
                bf16_t* d;
                if (j < 4) d = XNb + XN_QR + ((size_t)(b * 4 + j) * S + t) * 128;
                else { x1 *= rscale; x2 *= rscale; d = ATb + ATT_KR + ((size_t)(b * 4 + (j - 4)) * NPOS + p) * 128; }
                d[lane] = (bf16_t)f2bf(x1); d[64 + lane] = (bf16_t)f2bf(x2);
            } else {
                const bool isq = j < 16;
                if (isq && !lat) continue;
                float v = bf2f(ur[(isq ? 2048 + (j - 8) * 64 : 2560 + (j - 16) * 64) + lane]); const float ss = wave_sum(v * v);
                v = v * (1.f / sqrtf(ss * (1.f / 64.f) + EPS)) * (isq ? gq : gk);
                if (lat) axial_rope64(v, lane, t);
                if (isq) { v *= 0.125f * 1.4426950408889634f; XNb[XN_GQ + ((size_t)(b * 8 + (j - 8)) * S + t) * 64 + lane] = (bf16_t)f2bf(v); }
                else ATb[ATT_GK + ((size_t)(b * 2 + (j - 16)) * NPOS + p) * 64 + lane] = (bf16_t)f2bf(v);
            }
        }
        __syncthreads();
#pragma unroll
        for (int i = 0; i < 5; ++i) { const int task = tid + 512 * i, r = task >> 2, pg = task & 3; unsigned w[8];
#pragma unroll
            for (int q = 0; q < 8; ++q) { const unsigned lo = vs[(pg * 16 + 2 * q) * 642 + r], hi = vs[(pg * 16 + 2 * q + 1) * 642 + r]; w[q] = lo | (hi << 16); }
            bf16_t* d = r < 512 ? ATb + ATT_VRT + ((size_t)(b * 4 + (r >> 7)) * 128 + (r & 127)) * NPOS : ATb + ATT_GVT + ((size_t)(b * 2 + ((r - 512) >> 6)) * 64 + ((r - 512) & 63)) * NPOS;
            u32x4* dd = (u32x4*)(d + p0 + pg * 16); u32x4 w0 = {w[0], w[1], w[2], w[3]}, w1 = {w[4], w[5], w[6], w[7]}; dd[0] = w0; dd[1] = w1; }
    }
}

DI void ph_retention(const Args& a, unsigned char* lds, int bid, int nb) {
    const int tid = otid(); const int lane = tid & 63, wv = tid >> 6, q32 = lane & 31, hh = lane >> 5;
    const bf16_t* XNb = (const bf16_t*)(a.ws + WS_XN); const bf16_t* ATb = (const bf16_t*)(a.ws + WS_ATT);
    const bf16_t* U = (const bf16_t*)(a.ws + WS_U); bf16_t* MIX = (bf16_t*)(a.ws + WS_MIX);
    constexpr int KBUF = 64 * 272, VBUF = 128 * 136, TBUF = KBUF + VBUF;
    for (int u = bid; u < 32 * 8; u += nb) {
        const int bh = u >> 3, qb = u & 7, b = bh >> 2, h = bh & 3, T0 = qb * 256;
        const int t = T0 + wv * 32 + q32;
        const float df = a.in[I_RETDEC][h], db = a.in[I_RETDEC][4 + h];
        const float lf = (fminf(df, 0.f) - log1pf(expf(-fabsf(df)))) * 1.4426950408889634f, lb = (fminf(db, 0.f) - log1pf(expf(-fabsf(db)))) * 1.4426950408889634f;
        bf16x8 qf[8];
        { const bf16_t* qg = XNb + XN_QR + ((size_t)bh * S + t) * 128 + 8 * hh;
#pragma unroll
          for (int ks = 0; ks < 8; ++ks) qf[ks] = *(const bf16x8*)(qg + 16 * ks); }
        const bf16_t* Kg = ATb + ATT_KR + (size_t)bh * NPOS * 128; const bf16_t* Vg = ATb + ATT_VRT + (size_t)bh * 128 * NPOS;
        float* tab = (float*)(lds + 2 * TBUF); const f32x4* tabf = (const f32x4*)tab; const f32x4* tabb = (const f32x4*)(tab + 64);
        __syncthreads();
        if (tid < 64) { tab[tid] = exp2f(-(float)tid * lf); tab[64 + tid] = exp2f((float)tid * lb); }
        u32x4 st[4];
        auto gload = [&](int tt) {
#pragma unroll
            for (int i = 0; i < 2; ++i) { const int c = tid + 512 * i;
                st[i] = *(const u32x4*)(Kg + ((size_t)tt * 64 + (c >> 4)) * 128 + (c & 15) * 8);
                st[2 + i] = *(const u32x4*)(Vg + (size_t)(c >> 3) * NPOS + tt * 64 + (c & 7) * 8); } };
        auto lstore = [&](int buf) {
            unsigned char* kb = lds + buf * TBUF; unsigned char* vb = kb + KBUF;
#pragma unroll
            for (int i = 0; i < 2; ++i) { const int c = tid + 512 * i;
                *(u32x4*)(kb + (c >> 4) * 272 + (c & 15) * 16) = st[i];
                u32x2* d = (u32x2*)(vb + (c >> 3) * 136 + (c & 7) * 16); u32x2 lo = {st[2 + i].x, st[2 + i].y}, hi = {st[2 + i].z, st[2 + i].w}; d[0] = lo; d[1] = hi; } };
        __syncthreads();
        gload(0); lstore(0);
        __syncthreads();
        f32x16 O[4];
#pragma unroll
        for (int d = 0; d < 4; ++d)
#pragma unroll
            for (int i = 0; i < 16; ++i) O[d][i] = 0.f;
        for (int tt = 0; tt < 36; ++tt) {
            if (tt + 1 < 36) gload(tt + 1);
            const unsigned char* kb = lds + (tt & 1) * TBUF; const unsigned char* vb = kb + KBUF;
            f32x16 S0, S1;
#pragma unroll
            for (int i = 0; i < 16; ++i) { S0[i] = 0.f; S1[i] = 0.f; }
#pragma unroll
            for (int ks = 0; ks < 8; ++ks) {
                const bf16x8 k0 = *(const bf16x8*)(kb + q32 * 272 + 32 * ks + 16 * hh), k1 = *(const bf16x8*)(kb + (32 + q32) * 272 + 32 * ks + 16 * hh);
                S0 = MFMA32(k0, qf[ks], S0); S1 = MFMA32(k1, qf[ks], S1);
                if (ks & 1) __builtin_amdgcn_sched_barrier(0);
            }
            const int p0 = tt * 64; const int s0 = p0 - C;
            const int type = tt < 4 ? 0 : (s0 + 64 <= T0 ? 1 : (s0 >= T0 + 256 ? 2 : 3));
            const float bf0 = (float)(t + C - p0 - 4 * hh) * lf;
            const float bb0 = (float)((tt < 4 ? p0 + S : s0) + 4 * hh - t) * lb;
            const float basef = exp2f(bf0), baseb = exp2f(bb0);
            const int dfl = t - (tt < 4 ? 0 : s0) - 4 * hh;
#pragma unroll
            for (int k = 0; k < 4; ++k) {
                const f32x4 f0 = tabf[2 * k], f1 = tabf[8 + 2 * k], g0 = tabb[2 * k], g1 = tabb[8 + 2 * k];
#pragma unroll
                for (int j = 0; j < 4; ++j) {
                    float w0, w1;
                    if (type == 1) { w0 = basef * f0[j]; w1 = basef * f1[j]; }
                    else if (type == 2) { w0 = baseb * g0[j]; w1 = baseb * g1[j]; }
                    else if (type == 0) { w0 = basef * f0[j] + baseb * g0[j]; w1 = basef * f1[j] + baseb * g1[j]; }
                    else { const int d0 = dfl - (8 * k + j), d1 = d0 - 32;
                        w0 = (d0 >= 0 ? basef * f0[j] : 0.f) + (d0 <= 0 ? baseb * g0[j] : 0.f); w1 = (d1 >= 0 ? basef * f1[j] : 0.f) + (d1 <= 0 ? baseb * g1[j] : 0.f); }
                    S0[4 * k + j] *= w0; S1[4 * k + j] *= w1;
                }
                __builtin_amdgcn_sched_barrier(0);
            }
            __builtin_amdgcn_sched_barrier(0);
            const bf16x8 p00 = pack8(S0, 0), p01 = pack8(S0, 1), p10 = pack8(S1, 0), p11 = pack8(S1, 1);
#pragma unroll
            for (int d = 0; d < 4; ++d) {
                const unsigned char* vr = vb + (32 * d + q32) * 136 + 8 * hh;
                auto vfrag = [&](int koff) { const s16x4 lo = *(const s16x4*)(vr + koff * 2), hi = *(const s16x4*)(vr + koff * 2 + 16); return __builtin_shufflevector(lo, hi, 0, 1, 2, 3, 4, 5, 6, 7); };
                O[d] = MFMA32(vfrag(0), p00, O[d]); O[d] = MFMA32(vfrag(16), p01, O[d]); O[d] = MFMA32(vfrag(32), p10, O[d]); O[d] = MFMA32(vfrag(48), p11, O[d]);
                __builtin_amdgcn_sched_barrier(0);
            }
            if (tt + 1 < 36) lstore((tt + 1) & 1);
            __syncthreads();
        }
        const int tid2 = otid(), q32e = tid2 & 31, hhe = (tid2 >> 5) & 1, wve = tid2 >> 6;
        float sm = 0.f;
#pragma unroll
        for (int d = 0; d < 4; ++d)
#pragma unroll
            for (int i = 0; i < 16; ++i) sm += O[d][i];
        sm += __shfl_xor(sm, 32); const float mu = sm * (1.f / 128.f); float sq = 0.f;
#pragma unroll
        for (int d = 0; d < 4; ++d)
#pragma unroll
            for (int i = 0; i < 16; ++i) { O[d][i] -= mu; sq += O[d][i] * O[d][i]; }
        sq += __shfl_xor(sq, 32); const float rs = 1.f / sqrtf(sq * (1.f / 128.f) + EPS);
        bf16_t* ob = (bf16_t*)lds;
#pragma unroll
        for (int d = 0; d < 4; ++d)
#pragma unroll
            for (int i = 0; i < 16; ++i) ob[(wve * 32 + q32e) * 136 + 32 * d + crow16(i, hhe)] = (bf16_t)f2bf(O[d][i] * rs);
        __syncthreads();
#pragma unroll
        for (int i = 0; i < 8; ++i) { const int c = tid2 + 512 * i, qq = c >> 4, part = c & 15; const int m = b * S + T0 + qq;
            const u32x2* s = (const u32x2*)(ob + qq * 136 + part * 8); const u32x2 lo = s[0], hi = s[1];
            const u32x4 gw = *(const u32x4*)(U + (size_t)m * O_IN + 1536 + h * 128 + part * 8);
            const float* gn = a.in[I_RETGN] + h * 128 + part * 8;
            const unsigned ow[4] = {lo.x, lo.y, hi.x, hi.y}; const unsigned gww[4] = {gw.x, gw.y, gw.z, gw.w}; unsigned r[4];
#pragma unroll
            for (int q = 0; q < 4; ++q) { const float o0 = __uint_as_float(ow[q] << 16), o1 = __uint_as_float(ow[q] & 0xffff0000u), g0 = __uint_as_float(gww[q] << 16), g1 = __uint_as_float(gww[q] & 0xffff0000u);
                r[q] = pk2(o0 * gn[2 * q] * silu_f(g0), o1 * gn[2 * q + 1] * silu_f(g1)); }
            u32x4 w = {r[0], r[1], r[2], r[3]};
            *(u32x4*)(MIX + (size_t)m * D + h * 128 + part * 8) = w; }
    }
}

DI void ph_gqa(const Args& a, unsigned char* lds, int bid, int nb) {
    const int tid = otid(); const int lane = tid & 63, wv = tid >> 6, q32 = lane & 31, hh = lane >> 5, g = wv >> 1, qsub = wv & 1;
    const bf16_t* XNb = (const bf16_t*)(a.ws + WS_XN); const bf16_t* ATb = (const bf16_t*)(a.ws + WS_ATT); bf16_t* MIX = (bf16_t*)(a.ws + WS_MIX);
    constexpr int KBUF = 64 * 144, VBUF = 64 * 136, TBUF = KBUF + VBUF;
    for (int u = bid; u < NB * 2 * 32; u += nb) {
        const int b = u >> 6, kv = (u >> 5) & 1, qblk = u & 31, T0 = qblk * 64; const int hd = kv * 4 + g; const int t = T0 + qsub * 32 + q32;
        const float sink2 = a.in[I_GQSINK][hd] * 1.4426950408889634f;
        bf16x8 qf[4];
        { const bf16_t* qg = XNb + XN_GQ + ((size_t)(b * 8 + hd) * S + t) * 64 + 8 * hh;
#pragma unroll
          for (int ks = 0; ks < 4; ++ks) qf[ks] = *(const bf16x8*)(qg + 16 * ks); }
        const bf16_t* Kg = ATb + ATT_GK + (size_t)(b * 2 + kv) * NPOS * 64; const bf16_t* Vg = ATb + ATT_GVT + (size_t)(b * 2 + kv) * 64 * NPOS;
        auto tile_p = [&](int i) { return i < 4 ? 64 * i : C + T0 - 128 + 64 * (i - 4); };
        auto tile_ok = [&](int i) { if (i < 4) return true; const int s0 = T0 - 128 + 64 * (i - 4); return s0 >= 0 && s0 < S; };
        u32x4 st[2];
        auto gload = [&](int i) { const int p = tile_p(i);
            st[0] = *(const u32x4*)(Kg + ((size_t)p + (tid >> 3)) * 64 + (tid & 7) * 8);
            st[1] = *(const u32x4*)(Vg + (size_t)(tid >> 3) * NPOS + p + (tid & 7) * 8); };
        auto lstore = [&](int buf) {
            unsigned char* kb = lds + buf * TBUF; unsigned char* vb = kb + KBUF;
            *(u32x4*)(kb + (tid >> 3) * 144 + (tid & 7) * 16) = st[0];
            u32x2* d = (u32x2*)(vb + (tid >> 3) * 136 + (tid & 7) * 16); u32x2 lo = {st[1].x, st[1].y}, hi = {st[1].z, st[1].w}; d[0] = lo; d[1] = hi; };
        __syncthreads();
        gload(0); lstore(0);
        __syncthreads();
        f32x16 O[2];
#pragma unroll
        for (int d = 0; d < 2; ++d)
#pragma unroll
            for (int i = 0; i < 16; ++i) O[d][i] = 0.f;
        float m_run = -1e30f, l_run = 0.f;
        int buf = 0;
        for (int ti = 0; ti < 9; ++ti) {
            if (!tile_ok(ti)) continue;
            int nx = ti + 1; while (nx < 9 && !tile_ok(nx)) ++nx;
            if (nx < 9) gload(nx);
            const unsigned char* kb = lds + buf * TBUF; const unsigned char* vb = kb + KBUF;
            f32x16 S0, S1;
#pragma unroll
            for (int i = 0; i < 16; ++i) { S0[i] = 0.f; S1[i] = 0.f; }
#pragma unroll
            for (int ks = 0; ks < 4; ++ks) {
                const bf16x8 k0 = *(const bf16x8*)(kb + q32 * 144 + 32 * ks + 16 * hh), k1 = *(const bf16x8*)(kb + (32 + q32) * 144 + 32 * ks + 16 * hh);
                S0 = MFMA32(k0, qf[ks], S0); S1 = MFMA32(k1, qf[ks], S1);
            }
            if (ti >= 4) {
                const int dl = T0 - 128 + 64 * (ti - 4) + 4 * hh - t;
#pragma unroll
                for (int i = 0; i < 16; ++i) { const int d0 = dl + (i & 3) + 8 * (i >> 2), d1 = d0 + 32;
                    if (d0 < -128 || d0 > 128) S0[i] = -1e30f; if (d1 < -128 || d1 > 128) S1[i] = -1e30f; }
            }
            float mx = S0[0];
#pragma unroll
            for (int i = 1; i < 16; ++i) mx = fmaxf(mx, S0[i]);
#pragma unroll
            for (int i = 0; i < 16; ++i) mx = fmaxf(mx, S1[i]);
            mx = fmaxf(mx, __shfl_xor(mx, 32));
            const float m_new = fmaxf(m_run, mx); const float alpha = exp2f(m_run - m_new); m_run = m_new;
            float rsum = 0.f;
#pragma unroll
            for (int i = 0; i < 16; ++i) { S0[i] = exp2f(S0[i] - m_new); S1[i] = exp2f(S1[i] - m_new); rsum += S0[i] + S1[i]; }
            rsum += __shfl_xor(rsum, 32);
            l_run = l_run * alpha + rsum;
#pragma unroll
            for (int d = 0; d < 2; ++d)
#pragma unroll
                for (int i = 0; i < 16; ++i) O[d][i] *= alpha;
            const bf16x8 p00 = pack8(S0, 0), p01 = pack8(S0, 1), p10 = pack8(S1, 0), p11 = pack8(S1, 1);
#pragma unroll
            for (int d = 0; d < 2; ++d) {
                const unsigned char* vr = vb + (32 * d + q32) * 136 + 8 * hh;
                auto vfrag = [&](int koff) { const s16x4 lo = *(const s16x4*)(vr + koff * 2), hi = *(const s16x4*)(vr + koff * 2 + 16); return __builtin_shufflevector(lo, hi, 0, 1, 2, 3, 4, 5, 6, 7); };
                O[d] = MFMA32(vfrag(0), p00, O[d]); O[d] = MFMA32(vfrag(16), p01, O[d]); O[d] = MFMA32(vfrag(32), p10, O[d]); O[d] = MFMA32(vfrag(48), p11, O[d]);
            }
            if (nx < 9) lstore(buf ^ 1);
            buf ^= 1;
            __syncthreads();
        }
        const float il = 1.f / (l_run + exp2f(sink2 - m_run));
        bf16_t* ob = (bf16_t*)(lds + 2 * TBUF);
#pragma unroll
        for (int d = 0; d < 2; ++d)
#pragma unroll
            for (int i = 0; i < 16; ++i) ob[(qsub * 32 + q32) * 264 + g * 64 + 32 * d + crow16(i, hh)] = (bf16_t)f2bf(O[d][i] * il);
        __syncthreads();
#pragma unroll
        for (int i = 0; i < 4; ++i) { const int c = tid + 512 * i, qq = c >> 5, part = c & 31;
            const u32x4 w = *(const u32x4*)(ob + qq * 264 + part * 8);
            *(u32x4*)(MIX + (size_t)(b * S + T0 + qq) * D + 512 + kv * 256 + part * 8) = w; }
    }
}

constexpr int N_PHASES = 20;
DI int opq(int v) { asm volatile("" : "+s"(v)); return v; }
template <class Epi> DI void run_gemm(LAS unsigned char* lds, const bf16_t* A, const bf16_t* Bt, int M, int N, int K, const Epi& E) {
    pg8::Gemm g{A, Bt, M, N, opq(K)}; pg8::StaticOrder So; So.init(M, N, (int)gridDim.x, (int)blockIdx.x);
    pg8::gemm_phase<Epi, pg8::StaticOrder, true, true>(lds, g, So, E);
}
DI void moe_gemm1(const Args& a, float* lds, LAS unsigned char* ldsl, int l) {
    int* tab = (int*)(lds + 33792); moe_tables(a, tab, l, otid());
    pg8::Gemm g{(const bf16_t*)(a.ws + WS_U), (const bf16_t*)(a.ws + WS_MW1), MOE_MAXT * 256, 32 * 512, opq(D)};
    MoeOrder<2> So{tab, (int)gridDim.x, (int)blockIdx.x}; EpiSwiGLU E{(bf16_t*)(a.ws + WS_MIX), (const float*)(a.ws + WS_ROWW)};
    pg8::gemm_phase<EpiSwiGLU, MoeOrder<2>, true, true>(ldsl, g, So, E);
}
DI void moe_gemm2(const Args& a, float* lds, LAS unsigned char* ldsl, int l) {
    int* tab = (int*)(lds + 33792); moe_tables(a, tab, l, otid());
    pg8::Gemm g{(const bf16_t*)(a.ws + WS_MIX), (const bf16_t*)(a.ws + WS_MW2), MOE_MAXT * 256, 32 * 1024, opq(256)};
    MoeOrder<4> So{tab, (int)gridDim.x, (int)blockIdx.x}; EpiStoreY E{(bf16_t*)(a.ws + WS_U)};
    pg8::gemm_phase<EpiStoreY, MoeOrder<4>, true, true>(ldsl, g, So, E);
}
__global__ void __launch_bounds__(NTHR, 2) fwd_kernel(Args a) {
    extern __shared__ __attribute__((aligned(16))) unsigned char lds_raw[];
    float* lds = (float*)lds_raw;
    LAS unsigned char* ldsl = (LAS unsigned char*)lds_raw;
    volatile LAS unsigned* MISC = (volatile LAS unsigned*)(ldsl + LDS_BYTES - 64);
    const int bid = blockIdx.x, nb = gridDim.x;
    if (threadIdx.x < 16) MISC[threadIdx.x] = 0u;
    __syncthreads();
    XcdBarrier bar; bar.bar = (unsigned*)(a.ws + WS_CTL); bar.x = 0; bar.st = nullptr;
    const bool multi = (a.ph_hi - a.ph_lo) > 1;
    if (multi) bar = xcd_barrier_post((unsigned*)(a.ws + WS_CTL), MISC);
    const float* modb = (const float*)(a.ws + WS_MOD);
    bf16_t* U = (bf16_t*)(a.ws + WS_U); bf16_t* MIX = (bf16_t*)(a.ws + WS_MIX); bf16_t* XN = (bf16_t*)(a.ws + WS_XN); float* HC = (float*)(a.ws + WS_HC);
    const int lo = a.ph_lo, hi = a.ph_hi;
#define IN(k) (lo <= (k) && (k) < hi)
#define SEAM(k) do { if (IN(k) && IN((k) + 1)) xcd_barrier(bar); } while (0)
    if (IN(0)) { ph_init(a, lds, bid, nb); } SEAM(0);
    if (IN(1)) { ph_norm(a, bid, nb, MALL, modb, 0, 1024); } SEAM(1);
    if (IN(2)) { EpiStoreBf16 E{U, E_IN}; run_gemm(ldsl, XN, (const bf16_t*)(a.ws + WS_WEIN), MALL, E_IN, D, E); } SEAM(2);
    if (IN(3)) { ph_prep0(a, lds, bid, nb); } SEAM(3);
    if (IN(4)) { ph_diffattn(a, lds_raw, bid, nb); __syncthreads(); ph_hyena(a, lds, bid, nb, 0, 2 * NB * 512); } SEAM(4);
    if (IN(5)) { EpiResid E{a.out, HC, modb, 2048}; run_gemm(ldsl, MIX, (const bf16_t*)(a.ws + WS_WEOUT), MALL, D, D, E); } SEAM(5);
    if (IN(6)) { ph_route(a, lds, bid, nb, 0, MALL); } SEAM(6);
    if (IN(7)) { ph_gather(a, lds, bid, nb, 0, MALL); } SEAM(7);
    if (IN(8)) { moe_gemm1(a, lds, ldsl, 0); } SEAM(8);
    if (IN(9)) { moe_gemm2(a, lds, ldsl, 0); } SEAM(9);
    if (IN(10)) { ph_combine(a, bid, nb, 0, MALL, true); } SEAM(10);
    if (IN(11)) { EpiStoreBf16 E{U, O_IN}; run_gemm(ldsl, XN, (const bf16_t*)(a.ws + WS_WOIN), MALL, O_IN, D, E); } SEAM(11);
    if (IN(12)) { ph_prep1(a, lds, bid, nb); ph_moe_convert(a, lds, bid, nb, 1); } SEAM(12);
    if (IN(13)) { ph_retention(a, lds_raw, bid, nb); __syncthreads(); ph_gqa(a, lds_raw, bid, nb); } SEAM(13);
    if (IN(14)) { EpiResid E{a.out, HC, modb + 9 * 6144, 2048}; run_gemm(ldsl, MIX, (const bf16_t*)(a.ws + WS_WOOUT), MLAT, D, D, E); } SEAM(14);
    if (IN(15)) { ph_route(a, lds, bid, nb, 1, MLAT); } SEAM(15);
    if (IN(16)) { ph_gather(a, lds, bid, nb, 1, MLAT); } SEAM(16);
    if (IN(17)) { moe_gemm1(a, lds, ldsl, 1); } SEAM(17);
    if (IN(18)) { moe_gemm2(a, lds, ldsl, 1); } SEAM(18);
    if (IN(19)) { ph_combine(a, bid, nb, 1, MLAT, false); }
#undef IN
#undef SEAM
}

extern "C" void kernel_launch(void* const* d_in, const int* in_sizes, int n_in, void* d_out, int out_size, void* d_ws, size_t ws_size, hipStream_t stream) {
    static int grid = 0;
    if (grid == 0) {
        if (n_in != N_IN || out_size != MLAT * D || ws_size < WS_END) { fprintf(stderr, "kernel_launch: unexpected shapes (n_in %d out %d ws %zu)\n", n_in, out_size, ws_size); grid = -1; return; }
        int dev = 0, cus = 0;
        if (hipGetDevice(&dev) != hipSuccess || hipDeviceGetAttribute(&cus, hipDeviceAttributeMultiprocessorCount, dev) != hipSuccess) { grid = -1; return; }
        if (hipFuncSetAttribute((const void*)fwd_kernel, hipFuncAttributeMaxDynamicSharedMemorySize, LDS_BYTES) != hipSuccess) { grid = -1; return; }
        grid = cus;
    }
    if (grid < 0) return;
    (void)hipMemsetAsync((char*)d_ws + WS_CTL, 0, CTL_ZERO_BYTES, stream);
    Args a{};
    for (int i = 0; i < N_IN; ++i) a.in[i] = (const float*)d_in[i];
    a.out = (float*)d_out; a.ws = (unsigned char*)d_ws;
#if MK_PER_PHASE
    for (int p = 0; p < N_PHASES; ++p) { a.ph_lo = p; a.ph_hi = p + 1; hipLaunchKernelGGL(fwd_kernel, dim3(grid), dim3(NTHR), LDS_BYTES, stream, a); }
#else
    a.ph_lo = 0; a.ph_hi = N_PHASES;
    hipLaunchKernelGGL(fwd_kernel, dim3(grid), dim3(NTHR), LDS_BYTES, stream, a);
#endif
}
```

```cpp
#include <hip/hip_runtime.h>
#include <cstdint>
#include <cstdio>

#ifndef MK_PER_PHASE
#define MK_PER_PHASE 0
#endif

#define DI __device__ __forceinline__
#define GAS __attribute__((address_space(1)))
#define LAS __attribute__((address_space(3)))
typedef float f32x4 __attribute__((ext_vector_type(4)));
typedef unsigned u32x4 __attribute__((ext_vector_type(4)));
typedef unsigned u32x2 __attribute__((ext_vector_type(2)));
typedef unsigned short bf16_t;

constexpr int D = 1024, NB = 8, S = 2048, C = 256;
constexpr int MLAT = NB * S, MCTX = NB * C, MALL = MLAT + MCTX;
constexpr int E_IN = 3072, O_IN = 2816;
constexpr int NTHR = 512, NWAVES = 8;
constexpr float EPS = 1e-6f;
constexpr int LDS_BYTES = 147456;

enum { I_X = 0, I_C, I_CTX, I_CCTX, I_ADAW, I_ADAB, I_EWIN, I_EWOUT, I_HYCW, I_HYCB, I_HYW1, I_HYB1, I_HYW2, I_HYB2, I_HYW3, I_HYFREQ, I_HYBIAS,
       I_DAQN, I_DAKN, I_DALAM, I_DASUB, I_OWIN, I_OWOUT, I_RETDEC, I_RETGN, I_GQQN, I_GQKN, I_GQSINK, I_MWGRP, I_MBGRP, I_MWRT, I_MBRT, I_MWG, I_MWU, I_MWD, N_IN };

constexpr size_t MiB = 1u << 20;
constexpr size_t WS_CTL = 0, CTL_ZERO_BYTES = 64 * 1024;
constexpr size_t WS_MOD = 1 * MiB;
constexpr size_t WS_HFL = 2 * MiB;
constexpr size_t WS_HFC = WS_HFL + 16 * MiB;
constexpr size_t WS_HC = WS_HFC + 2 * MiB;
constexpr size_t WS_WEIN = WS_HC + 8 * MiB;
constexpr size_t WS_WEOUT = WS_WEIN + 6 * MiB;
constexpr size_t WS_WOIN = WS_WEOUT + 2 * MiB;
constexpr size_t WS_WOOUT = WS_WOIN + 6 * MiB;
constexpr size_t WS_XN = WS_WOOUT + 2 * MiB;
constexpr size_t WS_U = WS_XN + 36 * MiB;
constexpr size_t WS_UT = WS_U;
constexpr size_t WS_UA = WS_U + 54 * MiB;
constexpr size_t WS_MIX = WS_U + 108 * MiB;
constexpr size_t WS_MW1 = WS_MIX + 36 * MiB;
constexpr size_t WS_MW2 = WS_MW1 + 32 * MiB;
constexpr size_t WS_TOK = WS_MW2 + 16 * MiB;
constexpr size_t WS_ROWW = WS_TOK + 1 * MiB;
constexpr size_t WS_ATT = WS_ROWW + 1 * MiB;
constexpr size_t WS_END = WS_ATT + 48 * MiB;
static_assert((size_t)176 * 256 * 1024 * 2 <= 108 * MiB && (size_t)176 * 256 * 256 * 2 <= 36 * MiB && (size_t)8 * MALL * 4 <= 1 * MiB, "moe overlays");
static_assert((size_t)MALL * 3072 * 2 <= 108 * MiB && (size_t)MALL * D * 2 <= 36 * MiB, "ws map");

struct Args { const float* in[N_IN]; float* out; unsigned char* ws; int ph_lo, ph_hi; };

DI float wave_sum(float v) {
#pragma unroll
    for (int o = 32; o > 0; o >>= 1) v += __shfl_xor(v, o);
    return v;
}
DI float wave_max(float v) {
#pragma unroll
    for (int o = 32; o > 0; o >>= 1) v = fmaxf(v, __shfl_xor(v, o));
    return v;
}
DI float silu_f(float x) { return x / (1.f + expf(-x)); }
DI int otid() { int t = threadIdx.x; asm volatile("" : "+v"(t)); return t; }
DI float bf2f(bf16_t v) { return __uint_as_float((unsigned)v << 16); }
DI unsigned f2bf(float f) { unsigned u = __float_as_uint(f); return (u + 0x7fffu + ((u >> 16) & 1u)) >> 16; }
DI unsigned pk2(float lo, float hi) { return f2bf(lo) | (f2bf(hi) << 16); }
DI f32x4 ld4bf(const bf16_t* p) { const u32x2 w = *(const u32x2*)p; f32x4 r; r.x = __uint_as_float(w.x << 16); r.y = __uint_as_float(w.x & 0xffff0000u); r.z = __uint_as_float(w.y << 16); r.w = __uint_as_float(w.y & 0xffff0000u); return r; }

#define XB_TMO      128
#define XB_XCNT(j)  (256  + 64 * (j))
#define XB_XSUB(j)  (1280 + 64 * (j))
#define XB_XGEN(j)  (2304 + 64 * (j))
#define XB_TOP      3328
#define XB_TOPGEN   3392
#define XCD_BAR_WORDS 3456
#define XB_SPIN_CAP (1u << 22)
DI unsigned xb_ld(unsigned* p)              { return __hip_atomic_load(p, __ATOMIC_RELAXED, __HIP_MEMORY_SCOPE_AGENT); }
DI unsigned xb_add(unsigned* p, unsigned v) { return __hip_atomic_fetch_add(p, v, __ATOMIC_RELAXED, __HIP_MEMORY_SCOPE_AGENT); }
DI unsigned xb_xcc_id() { return (unsigned)__builtin_amdgcn_s_getreg((3 << 11) | 20) & 0xFu; }
#define XB_SPIN(cond, bar) do { unsigned _sp = 0; while (cond) { __builtin_amdgcn_s_sleep(1); \
    if ((++_sp & 255u) == 0u) { if (xb_ld(&(bar)[XB_TMO])) break; if (_sp > XB_SPIN_CAP) { atomicAdd(&(bar)[XB_TMO], 1u); break; } } } } while (0)
struct XcdBarrier { unsigned* bar; unsigned x; volatile LAS unsigned* st; };
DI XcdBarrier xcd_barrier_post(unsigned* bar, volatile LAS unsigned* st) {
    XcdBarrier b; b.bar = bar; b.x = xb_xcc_id(); b.st = st;
    if (threadIdx.x == 0) (void)xb_add(&bar[XB_XCNT(b.x)], 1u);
    return b;
}
DI void xcd_barrier_complete(unsigned* bar, unsigned x, unsigned& nloc, unsigned& nx) {
    const unsigned G = gridDim.x * gridDim.y * gridDim.z;
    unsigned sum, cnt, mine, sp = 0u;
    for (;;) {
        sum = 0u; cnt = 0u; mine = 0u;
#pragma unroll
        for (unsigned j = 0; j < 16; ++j) { const unsigned c = xb_ld(&bar[XB_XCNT(j)]); sum += c; cnt += (c > 0u) ? 1u : 0u; mine = (j == x) ? c : mine; }
        if (sum == G) break;
        __builtin_amdgcn_s_sleep(1);
        if ((++sp & 255u) == 0u) { if (xb_ld(&bar[XB_TMO])) break; if (sp > XB_SPIN_CAP) { atomicAdd(&bar[XB_TMO], 1u); break; } }
    }
    nloc = mine > 0u ? mine : 1u; nx = cnt > 0u ? cnt : 1u;
}
DI void xcd_barrier(const XcdBarrier& b) {
    asm volatile("s_waitcnt vmcnt(0)" ::: "memory");
    __syncthreads();
    if (threadIdx.x == 0) {
        unsigned* bar = b.bar;
        __builtin_amdgcn_s_waitcnt(0);
        unsigned nloc = b.st[0], nx = b.st[1];
        if (nloc == 0u) { xcd_barrier_complete(bar, b.x, nloc, nx); b.st[0] = nloc; b.st[1] = nx; }
        const unsigned old = xb_add(&bar[XB_XSUB(b.x)], 1u);
        const unsigned gen = old / nloc;
        if (old + 1u == (gen + 1u) * nloc) {
            __builtin_amdgcn_fence(__ATOMIC_RELEASE, "agent");
            asm volatile("s_waitcnt vmcnt(0)" ::: "memory");
            const unsigned og = xb_add(&bar[XB_TOP], 1u);
            const unsigned tg = og / nx;
            if (og + 1u == (tg + 1u) * nx) xb_add(&bar[XB_TOPGEN], 1u);
            else XB_SPIN(xb_ld(&bar[XB_TOPGEN]) == tg, bar);
            __builtin_amdgcn_fence(__ATOMIC_ACQUIRE, "agent");
            xb_add(&bar[XB_XGEN(b.x)], 1u);
            asm volatile("s_waitcnt vmcnt(0)" ::: "memory");
        } else {
            XB_SPIN(xb_ld(&bar[XB_XGEN(b.x)]) == gen, bar);
            __builtin_amdgcn_fence(__ATOMIC_ACQUIRE, "agent");
            asm volatile("s_waitcnt vmcnt(0)" ::: "memory");
        }
    }
    __syncthreads();
}

namespace pg8 {
#define PG8_LAS __attribute__((address_space(3)))
typedef unsigned short bf16_t;
typedef short bf16x8 __attribute__((ext_vector_type(8)));
typedef float f32x4 __attribute__((ext_vector_type(4)));
typedef unsigned u32x4 __attribute__((ext_vector_type(4)));
constexpr int BM = 256, BK = 64, HALF = 128, HTB = HALF * BK * 2  , STAGE_BYTES = 8 * HTB, NXCD = 8, WGM = 8;

__host__ __device__ __forceinline__ int lds_byte(int r, int c) { const int st = (r >> 4) * 2 + (c >> 5), rr = r & 15, cc = c & 31, ob = rr * 64 + cc * 2; return st * 1024 + (ob ^ (((ob >> 9) & 1) << 5)); }
__host__ __device__ __forceinline__ void stage_rc(int b, int& R, int& C) { const int st = b / 1024, sb = b % 1024, swz = sb ^ (((sb >> 9) & 1) << 5); R = (st >> 1) * 16 + swz / 64; C = (st & 1) * 32 + (swz % 64) / 2; }
__host__ __device__ __forceinline__ int perm32(int rho) { const int n = rho >> 4, i = rho & 15; return 8 * (i >> 2) + 4 * n + (i & 3); }

struct Unit { int pm, pn; };
struct Gemm { const bf16_t* A; const bf16_t* Bt; int M, N, K; };

struct StaticOrder {
    int nM, nN, nwg, G, c;
    __host__ __device__ void init(int M, int N, int G_, int c_) { nM = M / BM; nN = N / BM; nwg = nM * nN; G = G_; c = c_; }
    __host__ __device__ bool next(int i, Unit& u) const {
        const long L = (long)i * G + c; if (L >= nwg) return false;
        int wgid = (int)L; { const int q = nwg / NXCD, r = nwg % NXCD, xcd = wgid % NXCD, off = wgid / NXCD; wgid = (xcd < r ? xcd * (q + 1) : r * (q + 1) + (xcd - r) * q) + off; }
        const int nig = WGM * nN, gid = wgid / nig, fm = gid * WGM, gsz = (nM - fm) < WGM ? (nM - fm) : WGM;
        u.pm = fm + ((wgid % nig) % gsz); u.pn = (wgid % nig) / gsz; return true;
    }
    __device__ __forceinline__ void a_ready(const Unit&) const {}
    __device__ __forceinline__ void done(const Unit&) const {}
};

__device__ __forceinline__ unsigned cvt_pk_bf16(float lo, float hi) { unsigned r; asm volatile("v_cvt_pk_bf16_f32 %0, %1, %2" : "=v"(r) : "v"(lo), "v"(hi)); return r; }
template <class Epi, class Sched, bool ALIGN_EPI = false, bool SP2 = false>
__device__ __forceinline__ void gemm_phase(PG8_LAS unsigned char* lds, const Gemm g, const Sched& S, const Epi& E) {
    const int tid = threadIdx.x, wid = __builtin_amdgcn_readfirstlane(tid >> 6), lane = tid & 63, wr = wid >> 2, wc = wid & 3, fr = lane & 15, fq = lane >> 4;
    const int K = g.K, nt = K / BK;
    unsigned voffA[2], voffB[2];
#pragma unroll
    for (int i = 0; i < 2; ++i) { int R, C; stage_rc(tid * 16 + i * 8192, R, C); const int Rb = Epi::PERM ? ((R & ~31) + perm32(R & 31)) : R;
        voffA[i] = (unsigned)(R * K + C) * 2u; voffB[i] = (unsigned)(Rb * K + C) * 2u; }
    const size_t kstep = (size_t)(BK * 2);
    const size_t hstep = (size_t)HALF * K * 2;
    const size_t tstep = 2 * hstep;
    const unsigned ldsw = (unsigned)wid * 1024u;
    const int aoff = lds_byte(wr * 64 + fr, fq * 8), boff = lds_byte(wc * 32 + fr, fq * 8);
#define PG8_SA(b, h) (((b) * 2 + (h)) * HTB)
#define PG8_SB(b, h) ((4 + (b) * 2 + (h)) * HTB)
#define PG8_STAGE(bufoff, gbase, voff) do { _Pragma("unroll") for (int _i = 0; _i < 2; ++_i) \
        __builtin_amdgcn_global_load_lds((const unsigned*)((const char*)(gbase) + (voff)[_i]), (PG8_LAS unsigned*)(lds + (bufoff) + ldsw + _i * 8192), 16, 0, 0); } while (0)
#define PG8_LDA(dst, b, h) do { _Pragma("unroll") for (int m = 0; m < 4; ++m) _Pragma("unroll") for (int k = 0; k < 2; ++k) dst[m][k] = *(const PG8_LAS bf16x8*)(lds + PG8_SA(b, h) + aoff + m * 2048 + k * 1024); } while (0)
#define PG8_LDB(dst, b, h) do { _Pragma("unroll") for (int n = 0; n < 2; ++n) _Pragma("unroll") for (int k = 0; k < 2; ++k) dst[n][k] = *(const PG8_LAS bf16x8*)(lds + PG8_SB(b, h) + boff + n * 2048 + k * 1024); } while (0)
#define PG8_MMA(ai, bj, At, Bt) do { __builtin_amdgcn_s_setprio(1); _Pragma("unroll") for (int m = 0; m < 4; ++m) _Pragma("unroll") for (int n = 0; n < 2; ++n) _Pragma("unroll") for (int k = 0; k < 2; ++k) \
        acc[ai][bj][m][n] = __builtin_amdgcn_mfma_f32_16x16x32_bf16(Bt[n][k], At[m][k], acc[ai][bj][m][n], 0, 0, 0); __builtin_amdgcn_s_setprio(0); } while (0)
#define PG8_WAIT_V(n) asm volatile("s_waitcnt vmcnt(" #n ")" ::: "memory")
#define PG8_WAIT_L(n) asm volatile("s_waitcnt lgkmcnt(" #n ")" ::: "memory")
#define PG8_BAR __builtin_amdgcn_s_barrier()
#define PG8_SCHED __builtin_amdgcn_sched_barrier(0)
    Unit cur, nxt; int ui = 0;
    if (!S.next(0, cur)) return;
    f32x4 acc[2][2][4][2];
#pragma unroll
    for (int a = 0; a < 2; ++a)
#pragma unroll
        for (int b = 0; b < 2; ++b)
#pragma unroll
            for (int m = 0; m < 4; ++m)
#pragma unroll
                for (int n = 0; n < 2; ++n) acc[a][b][m][n] = (f32x4){0.f, 0.f, 0.f, 0.f};
    bf16x8 At[4][2], B0[2][2], B1[2][2];
    const char* cA = (const char*)g.A + (size_t)cur.pm * tstep; const char* cB = (const char*)g.Bt + (size_t)cur.pn * tstep;
    S.a_ready(cur);
    if constexpr (SP2) {
        PG8_STAGE(PG8_SB(0, 0), cB, voffB); PG8_STAGE(PG8_SB(0, 1), cB + hstep, voffB); PG8_STAGE(PG8_SA(0, 0), cA, voffA); PG8_STAGE(PG8_SA(0, 1), cA + hstep, voffA);
        if (wr == 1) PG8_BAR;
        PG8_WAIT_V(2); PG8_BAR;
        PG8_STAGE(PG8_SB(1, 0), cB + kstep, voffB); PG8_STAGE(PG8_SA(1, 0), cA + kstep, voffA); PG8_STAGE(PG8_SB(1, 1), cB + hstep + kstep, voffB);
        PG8_WAIT_V(6); PG8_BAR;
    } else {
        PG8_STAGE(PG8_SB(0, 0), cB, voffB); PG8_STAGE(PG8_SA(0, 0), cA, voffA); PG8_STAGE(PG8_SB(0, 1), cB + hstep, voffB); PG8_STAGE(PG8_SA(0, 1), cA + hstep, voffA);
        if (wr == 1) PG8_BAR;
        PG8_WAIT_V(4); PG8_BAR;
        PG8_STAGE(PG8_SB(1, 0), cB + kstep, voffB); PG8_STAGE(PG8_SA(1, 0), cA + kstep, voffA); PG8_STAGE(PG8_SB(1, 1), cB + hstep + kstep, voffB);
        PG8_WAIT_V(6); PG8_BAR;
    }
    for (;;) {
        const bool has_next = S.next(ui + 1, nxt);
        const char* nA = has_next ? (const char*)g.A + (size_t)nxt.pm * tstep : cA; const char* nB = has_next ? (const char*)g.Bt + (size_t)nxt.pn * tstep : cB;
        for (int t = 0; t < nt; t += 2) {
            const bool last = (t == nt - 2);
            const char* a1 = cA + (size_t)(t + 1) * kstep;
            const char* a2 = last ? nA : cA + (size_t)(t + 2) * kstep; const char* b2 = last ? nB : cB + (size_t)(t + 2) * kstep;
            const char* a3 = a2 + kstep; const char* b3 = b2 + kstep;
            if (last && has_next) S.a_ready(nxt);
            if constexpr (SP2) {
            PG8_LDB(B0, 0, 0); PG8_LDB(B1, 0, 1); PG8_SCHED; PG8_LDA(At, 0, 0); PG8_STAGE(PG8_SA(1, 1), a1 + hstep, voffA);
            PG8_WAIT_V(8); PG8_WAIT_L(0); PG8_BAR; PG8_MMA(0, 0, At, B0); PG8_MMA(0, 1, At, B1); PG8_BAR; PG8_SCHED;
            PG8_LDA(At, 0, 1); PG8_STAGE(PG8_SB(0, 0), b2, voffB); PG8_STAGE(PG8_SB(0, 1), b2 + hstep, voffB); PG8_STAGE(PG8_SA(0, 0), a2, voffA);
            PG8_WAIT_V(8); PG8_WAIT_L(0); PG8_BAR; PG8_MMA(1, 0, At, B0); PG8_MMA(1, 1, At, B1); PG8_BAR; PG8_SCHED;
            PG8_LDB(B0, 1, 0); PG8_LDB(B1, 1, 1); PG8_SCHED; PG8_LDA(At, 1, 0); PG8_STAGE(PG8_SA(0, 1), a2 + hstep, voffA);
            PG8_WAIT_V(8); PG8_WAIT_L(0); PG8_BAR; PG8_MMA(0, 0, At, B0); PG8_MMA(0, 1, At, B1); PG8_BAR; PG8_SCHED;
            PG8_LDA(At, 1, 1); PG8_STAGE(PG8_SB(1, 0), b3, voffB); PG8_STAGE(PG8_SB(1, 1), b3 + hstep, voffB); PG8_STAGE(PG8_SA(1, 0), a3, voffA);
            PG8_WAIT_V(8); PG8_WAIT_L(0); PG8_BAR; PG8_MMA(1, 0, At, B0); PG8_MMA(1, 1, At, B1); PG8_BAR; PG8_SCHED;
            } else {
            PG8_LDB(B0, 0, 0); PG8_SCHED; PG8_LDA(At, 0, 0); PG8_STAGE(PG8_SA(1, 1), a1 + hstep, voffA);
            PG8_WAIT_L(8); PG8_BAR; PG8_WAIT_L(0); PG8_MMA(0, 0, At, B0); PG8_BAR; PG8_SCHED;
            PG8_LDB(B1, 0, 1); PG8_STAGE(PG8_SB(0, 0), b2, voffB);
            PG8_BAR; PG8_WAIT_L(0); PG8_MMA(0, 1, At, B1); PG8_BAR;
            PG8_LDA(At, 0, 1); PG8_STAGE(PG8_SA(0, 0), a2, voffA);
            PG8_BAR; PG8_WAIT_L(0); PG8_MMA(1, 0, At, B0); PG8_BAR; PG8_SCHED;
            PG8_STAGE(PG8_SB(0, 1), b2 + hstep, voffB);
            PG8_WAIT_V(6); PG8_BAR; PG8_MMA(1, 1, At, B1); PG8_BAR;
            PG8_LDB(B0, 1, 0); PG8_SCHED; PG8_LDA(At, 1, 0); PG8_STAGE(PG8_SA(0, 1), a2 + hstep, voffA);
            PG8_WAIT_L(8); PG8_BAR; PG8_WAIT_L(0); PG8_MMA(0, 0, At, B0); PG8_BAR; PG8_SCHED;
            PG8_LDB(B1, 1, 1); PG8_STAGE(PG8_SB(1, 0), b3, voffB);
            PG8_BAR; PG8_WAIT_L(0); PG8_MMA(0, 1, At, B1); PG8_BAR;
            PG8_LDA(At, 1, 1); PG8_STAGE(PG8_SA(1, 0), a3, voffA);
            PG8_BAR; PG8_WAIT_L(0); PG8_MMA(1, 0, At, B0); PG8_BAR; PG8_SCHED;
            PG8_STAGE(PG8_SB(1, 1), b3 + hstep, voffB);
            PG8_WAIT_V(6); PG8_BAR; PG8_MMA(1, 1, At, B1); PG8_BAR;
            }
        }
        if constexpr (ALIGN_EPI) { if (wr == 0) PG8_BAR; }
        if constexpr (!Epi::AFTER_DRAIN) { E(acc, cur, wr, wc, fr, fq); S.done(cur); }
        if (!has_next) break;
#pragma unroll
        for (int a = 0; a < 2; ++a)
#pragma unroll
            for (int b = 0; b < 2; ++b)
#pragma unroll
                for (int m = 0; m < 4; ++m)
#pragma unroll
                    for (int n = 0; n < 2; ++n) acc[a][b][m][n] = (f32x4){0.f, 0.f, 0.f, 0.f};
        cur = nxt; cA = nA; cB = nB; ++ui;
        if constexpr (ALIGN_EPI) { if (wr == 1) PG8_BAR; }
    }
    PG8_WAIT_V(0);
    if constexpr (!ALIGN_EPI) { if (wr == 0) PG8_BAR; }
    PG8_BAR;
    if constexpr (Epi::AFTER_DRAIN) { E.fused(acc, cur, wr, wc, fr, fq, lds, wid, lane); S.done(cur); }
#undef PG8_SA
#undef PG8_SB
#undef PG8_STAGE
#undef PG8_LDA
#undef PG8_LDB
#undef PG8_MMA
#undef PG8_WAIT_V
#undef PG8_WAIT_L
#undef PG8_BAR
#undef PG8_SCHED
}
}
__device__ __forceinline__ unsigned cvt_pk(float lo, float hi) { return pg8::cvt_pk_bf16(lo, hi); }
struct EpiStoreBf16 {
    static constexpr bool PERM = true, AFTER_DRAIN = false;
    bf16_t* O; int ldc;
    __device__ __forceinline__ void operator()(const f32x4 (&acc)[2][2][4][2], const pg8::Unit& u, int wr, int wc, int fr, int fq) const {
        const int row0 = u.pm * 256 + wr * 64 + fr, col0 = u.pn * 256 + wc * 32 + 8 * fq;
#pragma unroll
        for (int ai = 0; ai < 2; ++ai)
#pragma unroll
            for (int m = 0; m < 4; ++m) { bf16_t* rowp = O + (size_t)(row0 + ai * 128 + m * 16) * ldc + col0;
#pragma unroll
                for (int bj = 0; bj < 2; ++bj) { const f32x4 v0 = acc[ai][bj][m][0], v1 = acc[ai][bj][m][1];
                    u32x4 w; w.x = cvt_pk(v0[0], v0[1]); w.y = cvt_pk(v0[2], v0[3]); w.z = cvt_pk(v1[0], v1[1]); w.w = cvt_pk(v1[2], v1[3]);
                    *(u32x4*)(rowp + bj * 128) = w; } }
    }
};
struct EpiStoreL0 {
    static constexpr bool PERM = true, AFTER_DRAIN = false;
    bf16_t* UT; bf16_t* UA;
    __device__ __forceinline__ void operator()(const f32x4 (&acc)[2][2][4][2], const pg8::Unit& u, int wr, int wc, int fr, int fq) const {
        const int row0 = u.pm * 256 + wr * 64 + fr, col0 = u.pn * 256 + wc * 32 + 8 * fq;
        if (u.pn < 6) {
#pragma unroll
            for (int bj = 0; bj < 2; ++bj)
#pragma unroll
                for (int n = 0; n < 2; ++n)
#pragma unroll
                    for (int j = 0; j < 4; ++j) { bf16_t* cp = UT + (size_t)(col0 + bj * 128 + 4 * n + j) * MALL + row0;
#pragma unroll
                        for (int ai = 0; ai < 2; ++ai)
#pragma unroll
                            for (int m = 0; m < 4; ++m) cp[ai * 128 + m * 16] = (bf16_t)(cvt_pk(acc[ai][bj][m][n][j], 0.f) & 0xffffu); }
        } else {
#pragma unroll
            for (int ai = 0; ai < 2; ++ai)
#pragma unroll
                for (int m = 0; m < 4; ++m) { bf16_t* rowp = UA + (size_t)(row0 + ai * 128 + m * 16) * 1536 + (col0 - 1536);
#pragma unroll
                    for (int bj = 0; bj < 2; ++bj) { const f32x4 v0 = acc[ai][bj][m][0], v1 = acc[ai][bj][m][1];
                        u32x4 w; w.x = cvt_pk(v0[0], v0[1]); w.y = cvt_pk(v0[2], v0[3]); w.z = cvt_pk(v1[0], v1[1]); w.w = cvt_pk(v1[2], v1[3]);
                        *(u32x4*)(rowp + bj * 128) = w; } }
        }
    }
};
struct EpiResid {
    static constexpr bool PERM = false, AFTER_DRAIN = false;
    float* hl; float* hc; const float* mod; int g_off;
    __device__ __forceinline__ void operator()(const f32x4 (&acc)[2][2][4][2], const pg8::Unit& u, int wr, int wc, int fr, int fq) const {
        const int rowt = u.pm * 256; const int col0 = u.pn * 256 + wc * 32 + 4 * fq;
        float* base = rowt < MLAT ? hl + (size_t)rowt * D : hc + (size_t)(rowt - MLAT) * D;
        const float* g = mod + (size_t)(rowt < MLAT ? rowt / S : 8) * 6144 + g_off + col0;
        f32x4 gv[2][2];
#pragma unroll
        for (int bj = 0; bj < 2; ++bj)
#pragma unroll
            for (int n = 0; n < 2; ++n) gv[bj][n] = *(const f32x4*)(g + bj * 128 + n * 16);
#pragma unroll
        for (int ai = 0; ai < 2; ++ai)
#pragma unroll
            for (int m = 0; m < 4; ++m) { float* rp = base + (size_t)(ai * 128 + wr * 64 + m * 16 + fr) * D + col0;
#pragma unroll
                for (int bj = 0; bj < 2; ++bj)
#pragma unroll
                    for (int n = 0; n < 2; ++n) { f32x4* p = (f32x4*)(rp + bj * 128 + n * 16); *p = *p + gv[bj][n] * acc[ai][bj][m][n]; } }
    }
};

DI void p0_tr(const float* W, int N, int K, int k0, int n0, bf16_t* dst, float* scr, int lane) {
#pragma unroll 8
    for (int i = 0; i < 32; ++i) { const int kk = 2 * i + (lane >> 5); scr[kk * 33 + (lane & 31)] = W[(size_t)(k0 + kk) * N + n0 + (lane & 31)]; }
    __builtin_amdgcn_wave_barrier(); asm volatile("s_waitcnt lgkmcnt(0)" ::: "memory");
    const int c = lane & 7;
#pragma unroll
    for (int j = 0; j < 4; ++j) { const int n = (lane >> 3) + 8 * j; const float* s = scr + (8 * c) * 33 + n;
        u32x4 o; o.x = pk2(s[0 * 33], s[1 * 33]); o.y = pk2(s[2 * 33], s[3 * 33]); o.z = pk2(s[4 * 33], s[5 * 33]); o.w = pk2(s[6 * 33], s[7 * 33]);
        *(u32x4*)(dst + (size_t)n * K + k0 + 8 * c) = o; }
    __builtin_amdgcn_wave_barrier(); asm volatile("s_waitcnt lgkmcnt(0)" ::: "memory");
}
DI void p0_transpose_item(const float* W, int K, int N, bf16_t* WT, float* scr, int item, int lane) {
    const int nblk = N / 32, kb = item / nblk, nbk = item % nblk;
    p0_tr(W, N, K, 64 * kb, 32 * nbk, WT + (size_t)(32 * nbk) * K, scr, lane);
}
DI void ph_moe_convert(const Args& a, float* lds, int bid, int nb, int l) {
    const int tid = otid(); const int lane = tid & 63, wv = tid >> 6;
    float* scr = lds + wv * (64 * 33);
    __syncthreads();
    for (int it = bid * NWAVES + wv; it < 32 * 384; it += nb * NWAVES) {
        const int e = it / 384, r = it % 384, le = l * 32 + e;
        if (r < 256) { const int up = r >> 7, q = r & 127, kb = q >> 3, nbk = q & 7, n0 = 32 * nbk;
            const float* W = a.in[up ? I_MWU : I_MWG] + (size_t)le * D * 256;
            bf16_t* dst = (bf16_t*)(a.ws + WS_MW1) + ((size_t)e * 512 + (n0 >> 7) * 256 + up * 128 + (n0 & 127)) * D;
            p0_tr(W, 256, D, 64 * kb, n0, dst, scr, lane);
        } else { const int q = r - 256, kb = q >> 5, nbk = q & 31, n0 = 32 * nbk;
            const float* W = a.in[I_MWD] + (size_t)le * 256 * D;
            bf16_t* dst = (bf16_t*)(a.ws + WS_MW2) + ((size_t)e * 1024 + n0) * 256;
            p0_tr(W, D, 256, 64 * kb, n0, dst, scr, lane);
        }
    }
    __syncthreads();
}
DI void ph_init(const Args& a, float* lds, int bid, int nb) {
    const int tid = otid();
    float* mod = (float*)(a.ws + WS_MOD);
    float* sv = lds;
    float* red = lds + 9 * 1024;
    for (int i = tid; i < 9 * 1024; i += NTHR) { const int r = i >> 10, k = i & 1023; const float x = r < 8 ? a.in[I_C][r * D + k] : a.in[I_CCTX][k]; sv[i] = silu_f(x); }
    __syncthreads();
    for (int it = bid; it < 2 * 96; it += nb) {
        const int l = it / 96, n0 = (it % 96) * 64;
        const int cg = tid & 15, kr = tid >> 4;
        float acc[9][4];
#pragma unroll
        for (int r = 0; r < 9; ++r) { acc[r][0] = acc[r][1] = acc[r][2] = acc[r][3] = 0.f; }
        const float* W = a.in[I_ADAW] + (size_t)l * D * 6144 + n0 + cg * 4;
#pragma unroll 2
        for (int k = kr; k < D; k += 32) {
            const f32x4 w = *(const f32x4*)(W + (size_t)k * 6144);
#pragma unroll
            for (int r = 0; r < 9; ++r) { const float s = sv[r * 1024 + k]; acc[r][0] += s * w.x; acc[r][1] += s * w.y; acc[r][2] += s * w.z; acc[r][3] += s * w.w; }
        }
#pragma unroll
        for (int r = 0; r < 9; ++r)
#pragma unroll
            for (int j = 0; j < 4; ++j) red[(kr * 9 + r) * 64 + cg * 4 + j] = acc[r][j];
        __syncthreads();
        for (int o = tid; o < 9 * 64; o += NTHR) {
            const int r = o >> 6, c = o & 63; float s = 0.f;
#pragma unroll 4
            for (int q = 0; q < 32; ++q) s += red[(q * 9 + r) * 64 + c];
            mod[((size_t)l * 9 + r) * 6144 + n0 + c] = s + a.in[I_ADAB][l * 6144 + n0 + c];
        }
        __syncthreads();
    }
    {
        const f32x4* x4 = (const f32x4*)a.in[I_X]; f32x4* o4 = (f32x4*)a.out;
        for (size_t i = (size_t)bid * NTHR + tid; i < (size_t)MLAT * D / 4; i += (size_t)nb * NTHR) o4[i] = x4[i];
        const f32x4* c4 = (const f32x4*)a.in[I_CTX]; f32x4* h4 = (f32x4*)(a.ws + WS_HC);
        for (size_t i = (size_t)bid * NTHR + tid; i < (size_t)MCTX * D / 4; i += (size_t)nb * NTHR) h4[i] = c4[i];
    }
    {
        float* z = lds;
        float* h1 = lds + 64;
        float* h2 = lds + 128;
        const float* w1 = a.in[I_HYW1]; const float* b1 = a.in[I_HYB1]; const float* w2 = a.in[I_HYW2]; const float* b2 = a.in[I_HYB2];
        const float* w3 = a.in[I_HYW3]; const float* fr = a.in[I_HYFREQ];
        __syncthreads();
        for (int it = bid; it < S + C; it += nb) {
            const bool lat = it < S; const int L = lat ? S : C; const int lag = lat ? it : it - S;
            const float t = (float)lag / (float)(L - 1);
            const float w = (6.283185307179586f / (float)L) * (float)lag;
            if (tid < 33) {
                float v;
                if (tid == 0) v = t;
                else { const int i = (tid - 1) & 15; const float fb = 1e-4f + (float)i * ((15.f - 1e-4f) / 15.f); v = (tid <= 16) ? cosf(fb * w) : -sinf(fb * w); }
                z[tid] = v;
            }
            __syncthreads();
            if (tid < 64) { float s = b1[tid];
#pragma unroll 1
                for (int i = 0; i < 33; ++i) s += z[i] * w1[i * 64 + tid]; h1[tid] = sinf(fr[tid] * s); }
            __syncthreads();
            if (tid < 64) { float s = b2[tid];
#pragma unroll 4
                for (int i = 0; i < 64; ++i) s += h1[i] * w2[i * 64 + tid]; h2[tid] = sinf(fr[64 + tid] * s); }
            __syncthreads();
            for (int o = tid; o < 2048; o += NTHR) {
                float s = 0.f;
#pragma unroll 8
                for (int i = 0; i < 64; ++i) s += h2[i] * w3[i * 2048 + o];
                const int ord = o >> 10, dir = (o >> 9) & 1, ch = o & 511;
                const float dmin = -3.0701134573253945f, dmax = -15.350567286626973f;
                const float delta = fabsf(dmin + (dmax - dmin) * ((float)ch / 511.f));
                s *= expf(-t * delta);
                if (lat) { float* g = (float*)(a.ws + WS_HFL) + ((size_t)ord * 512 + ch) * 4096;
                    if (dir == 0) g[2047 + lag] = s; else if (lag > 0) g[2047 - lag] = s; }
                else { float* g = (float*)(a.ws + WS_HFC) + ((size_t)ord * 512 + ch) * 512;
                    if (dir == 0) g[255 + lag] = s; else if (lag > 0) g[255 - lag] = s; }
            }
            __syncthreads();
        }
    }
    {
        __syncthreads();
        const int lane = tid & 63, wv = tid >> 6;
        float* scr = lds + wv * (64 * 33);
        constexpr int I_A = (D / 64) * (E_IN / 32), I_B = (D / 64) * (D / 32), I_C2 = (D / 64) * (O_IN / 32);
        constexpr int NIT = I_A + I_B + I_C2 + I_B;
        for (int it = bid * NWAVES + wv; it < NIT; it += nb * NWAVES) {
            int r = it;
            if (r < I_A) { p0_transpose_item(a.in[I_EWIN], D, E_IN, (bf16_t*)(a.ws + WS_WEIN), scr, r, lane); continue; } r -= I_A;
            if (r < I_B) { p0_transpose_item(a.in[I_EWOUT], D, D, (bf16_t*)(a.ws + WS_WEOUT), scr, r, lane); continue; } r -= I_B;
            if (r < I_C2) { p0_transpose_item(a.in[I_OWIN], D, O_IN, (bf16_t*)(a.ws + WS_WOIN), scr, r, lane); continue; } r -= I_C2;
            p0_transpose_item(a.in[I_OWOUT], D, D, (bf16_t*)(a.ws + WS_WOOUT), scr, r, lane);
        }
    }
    ph_moe_convert(a, lds, bid, nb, 0);
}

DI const float* row_ptr(const Args& a, int m) { return m < MLAT ? a.out + (size_t)m * D : (const float*)(a.ws + WS_HC) + (size_t)(m - MLAT) * D; }
DI float* row_ptr_w(const Args& a, int m) { return m < MLAT ? a.out + (size_t)m * D : (float*)(a.ws + WS_HC) + (size_t)(m - MLAT) * D; }
DI int mod_row(int m) { return m < MLAT ? m / S : 8; }
DI void ph_norm(const Args& a, int bid, int nb, int nrows, const float* mod, int sh_off, int sc_off) {
    const int tid = otid(); const int lane = tid & 63, wv = tid >> 6;
    bf16_t* XN = (bf16_t*)(a.ws + WS_XN);
    for (int m = bid * NWAVES + wv; m < nrows; m += nb * NWAVES) {
        const f32x4* r = (const f32x4*)row_ptr(a, m); f32x4 v[4]; float s = 0.f;
#pragma unroll
        for (int j = 0; j < 4; ++j) { v[j] = r[lane + 64 * j]; s += v[j].x * v[j].x + v[j].y * v[j].y + v[j].z * v[j].z + v[j].w * v[j].w; }
        s = wave_sum(s);
        const float rs = 1.f / sqrtf(s * (1.f / D) + EPS);
        const float* mr = mod + (size_t)mod_row(m) * 6144;
        u32x2* o = (u32x2*)(XN + (size_t)m * D);
#pragma unroll
        for (int j = 0; j < 4; ++j) { const f32x4 sh = *(const f32x4*)(mr + sh_off + 4 * (lane + 64 * j)), sc = *(const f32x4*)(mr + sc_off + 4 * (lane + 64 * j));
            u32x2 w; w.x = pk2(v[j].x * rs * (1.f + sc.x) + sh.x, v[j].y * rs * (1.f + sc.y) + sh.y); w.y = pk2(v[j].z * rs * (1.f + sc.z) + sh.z, v[j].w * rs * (1.f + sc.w) + sh.w);
            o[lane + 64 * j] = w; }
    }
}

DI void axial_rope64(float& v, int lane, int t) {
    const int axis = lane >> 5, half = (lane >> 4) & 1, f = lane & 15;
    const float pos = (float)(axis == 0 ? (t >> 6) : (t & 63));
    const float inv = exp2f(-(float)f * (13.287712379549449f / 16.f));
    const float ang = pos * inv, c = cosf(ang), s = sinf(ang);
    const float other = __shfl_xor(v, 16);
    v = half == 0 ? (v * c - other * s) : (v * c + other * s);
}
constexpr int NPOS = C + S;
DI int pos_row(int b, int p) { return p < C ? MLAT + b * C + p : b * S + (p - C); }
DI void ph_prep0(const Args& a, float* lds, int bid, int nb) {
    const int tid = otid(); const int lane = tid & 63, wv = tid >> 6;
    const bf16_t* U = (const bf16_t*)(a.ws + WS_UA);
    bf16_t* QP = (bf16_t*)(a.ws + WS_XN); bf16_t* KP = (bf16_t*)(a.ws + WS_ATT); bf16_t* VT = KP + (size_t)32 * 2 * NPOS * 64;
    bf16_t* vs = (bf16_t*)lds;
    const float gq = a.in[I_DAQN][lane], gk = a.in[I_DAKN][lane];
    for (int it = bid; it < 32 * 36; it += nb) {
        const int bh = it / 36, ch = it % 36, b = bh >> 2, h = bh & 3, p0 = ch * 64;
        __syncthreads();
#pragma unroll
        for (int i = 0; i < 2; ++i) { const int c = tid + 512 * i, pp = c >> 4, part = c & 15;
            const u32x4 w = *(const u32x4*)(U + (size_t)pos_row(b, p0 + pp) * 1536 + 1024 + h * 128 + part * 8);
            unsigned* d = (unsigned*)(vs + pp * 130 + part * 8); d[0] = w.x; d[1] = w.y; d[2] = w.z; d[3] = w.w; }
        for (int wi = wv; wi < 256; wi += NWAVES) {
            const int pp = wi >> 2, j = wi & 3, isk = j >> 1, map = j & 1; const int p = p0 + pp;
            float v = bf2f(U[(size_t)pos_row(b, p) * 1536 + isk * 512 + h * 128 + map * 64 + lane]);
            const float ss = wave_sum(v * v);
            v = v * (1.f / sqrtf(ss * (1.f / 64.f) + EPS)) * (isk ? gk : gq);
            if (p >= C) axial_rope64(v, lane, p - C);
            if (!isk) v *= 0.125f * 1.4426950408889634f;
            (isk ? KP : QP)[((size_t)(bh * 2 + map) * NPOS + p) * 64 + lane] = (bf16_t)f2bf(v);
        }
        __syncthreads();
        { const int dv = tid >> 2, pg = tid & 3; unsigned w[8];
#pragma unroll
          for (int i = 0; i < 8; ++i) { const unsigned lo = vs[(pg * 16 + 2 * i) * 130 + dv], hi = vs[(pg * 16 + 2 * i + 1) * 130 + dv]; w[i] = lo | (hi << 16); }
          u32x4* d = (u32x4*)(VT + ((size_t)bh * 128 + dv) * NPOS + p0 + pg * 16);
          u32x4 w0 = {w[0], w[1], w[2], w[3]}, w1 = {w[4], w[5], w[6], w[7]}; d[0] = w0; d[1] = w1; }
    }
}

typedef short bf16x8 __attribute__((ext_vector_type(8)));
typedef short s16x4 __attribute__((ext_vector_type(4)));
typedef float f32x16 __attribute__((ext_vector_type(16)));
#define MFMA32(a, b, c) __builtin_amdgcn_mfma_f32_32x32x16_bf16((a), (b), (c), 0, 0, 0)
DI int crow16(int i, int hh) { return (i & 3) + 8 * (i >> 2) + 4 * hh; }
DI bf16x8 pack8(const f32x16& x, int s) {
    u32x4 p; p.x = cvt_pk(x[8 * s], x[8 * s + 1]); p.y = cvt_pk(x[8 * s + 2], x[8 * s + 3]); p.z = cvt_pk(x[8 * s + 4], x[8 * s + 5]); p.w = cvt_pk(x[8 * s + 6], x[8 * s + 7]);
    return __builtin_bit_cast(bf16x8, p);
}
DI void ph_diffattn(const Args& a, unsigned char* lds, int bid, int nb) {
    const int tid = otid(); const int lane = tid & 63, wv = tid >> 6, q32 = lane & 31, hh = lane >> 5, qsub = wv >> 1, map = wv & 1;
    const bf16_t* QP = (const bf16_t*)(a.ws + WS_XN); const bf16_t* KP = (const bf16_t*)(a.ws + WS_ATT); const bf16_t* VT = KP + (size_t)32 * 2 * NPOS * 64;
    bf16_t* MIX = (bf16_t*)(a.ws + WS_MIX);
    constexpr int KBUF = 2 * 64 * 144, VBUF = 128 * 136, TBUF = KBUF + VBUF;
    unsigned char* xbuf = lds + 2 * TBUF;
    const float* lp = a.in[I_DALAM];
    const float lam_init = 0.2f;
    const float lam = expf(wave_sum(lp[lane] * lp[64 + lane])) - expf(wave_sum(lp[128 + lane] * lp[192 + lane])) + lam_init;
    for (int u = bid; u < 32 * 18; u += nb) {
        const int bh = u / 18, qb = u % 18, b = bh >> 2, h = bh & 3; const int nt = qb < 2 ? 4 : 36;
        bf16x8 qf[4];
        { const bf16_t* qg = QP + ((size_t)(bh * 2 + map) * NPOS + qb * 128 + qsub * 32 + q32) * 64 + 8 * hh;
#pragma unroll
          for (int ks = 0; ks < 4; ++ks) qf[ks] = *(const bf16x8*)(qg + 16 * ks); }
        const bf16_t* Kg = KP + (size_t)(bh * 2) * NPOS * 64; const bf16_t* Vg = VT + (size_t)bh * 128 * NPOS;
        u32x4 st[4];
        auto gload = [&](int t) {
#pragma unroll
            for (int i = 0; i < 2; ++i) { const int c = tid + 512 * i;
                st[i] = *(const u32x4*)(Kg + ((size_t)(c >> 9) * NPOS + t * 64 + ((c >> 3) & 63)) * 64 + (c & 7) * 8);
                st[2 + i] = *(const u32x4*)(Vg + (size_t)(c >> 3) * NPOS + t * 64 + (c & 7) * 8); } };
        auto lstore = [&](int buf) {
            unsigned char* kb = lds + buf * TBUF; unsigned char* vb = kb + KBUF;
#pragma unroll
            for (int i = 0; i < 2; ++i) { const int c = tid + 512 * i;
                *(u32x4*)(kb + (c >> 9) * (64 * 144) + ((c >> 3) & 63) * 144 + (c & 7) * 16) = st[i];
                u32x2* d = (u32x2*)(vb + (c >> 3) * 136 + (c & 7) * 16); u32x2 lo = {st[2 + i].x, st[2 + i].y}, hi = {st[2 + i].z, st[2 + i].w}; d[0] = lo; d[1] = hi; } };
        __syncthreads();
        gload(0); lstore(0);
        __syncthreads();
        f32x16 O[4];
#pragma unroll
        for (int d = 0; d < 4; ++d)
#pragma unroll
            for (int i = 0; i < 16; ++i) O[d][i] = 0.f;
        float m_run = -1e30f, l_run = 0.f;
        for (int t = 0; t < nt; ++t) {
            if (t + 1 < nt) gload(t + 1);
            const unsigned char* kb = lds + (t & 1) * TBUF + map * (64 * 144); const unsigned char* vb = lds + (t & 1) * TBUF + KBUF;
            f32x16 S0, S1;
#pragma unroll
            for (int i = 0; i < 16; ++i) { S0[i] = 0.f; S1[i] = 0.f; }
#pragma unroll
            for (int ks = 0; ks < 4; ++ks) {
                const bf16x8 k0 = *(const bf16x8*)(kb + q32 * 144 + 32 * ks + 16 * hh), k1 = *(const bf16x8*)(kb + (32 + q32) * 144 + 32 * ks + 16 * hh);
                S0 = MFMA32(k0, qf[ks], S0); S1 = MFMA32(k1, qf[ks], S1);
            }
            float mx = S0[0];
#pragma unroll
            for (int i = 1; i < 16; ++i) mx = fmaxf(mx, S0[i]);
#pragma unroll
            for (int i = 0; i < 16; ++i) mx = fmaxf(mx, S1[i]);
            mx = fmaxf(mx, __shfl_xor(mx, 32));
            const float m_new = fmaxf(m_run, mx); const float alpha = exp2f(m_run - m_new); m_run = m_new;
            float rsum = 0.f;
#pragma unroll
            for (int i = 0; i < 16; ++i) { S0[i] = exp2f(S0[i] - m_new); S1[i] = exp2f(S1[i] - m_new); rsum += S0[i] + S1[i]; }
            rsum += __shfl_xor(rsum, 32);
            l_run = l_run * alpha + rsum;
#pragma unroll
            for (int d = 0; d < 4; ++d)
#pragma unroll
                for (int i = 0; i < 16; ++i) O[d][i] *= alpha;
            const bf16x8 p00 = pack8(S0, 0), p01 = pack8(S0, 1), p10 = pack8(S1, 0), p11 = pack8(S1, 1);
#pragma unroll
            for (int d = 0; d < 4; ++d) {
                const unsigned char* vr = vb + (32 * d + q32) * 136 + 8 * hh;
                auto vfrag = [&](int koff) { const s16x4 lo = *(const s16x4*)(vr + koff * 2), hi = *(const s16x4*)(vr + koff * 2 + 16); return __builtin_shufflevector(lo, hi, 0, 1, 2, 3, 4, 5, 6, 7); };
                O[d] = MFMA32(vfrag(0), p00, O[d]); O[d] = MFMA32(vfrag(16), p01, O[d]); O[d] = MFMA32(vfrag(32), p10, O[d]); O[d] = MFMA32(vfrag(48), p11, O[d]);
            }
            if (t + 1 < nt) lstore((t + 1) & 1);
            __syncthreads();
        }
        float* xb = (float*)xbuf + qsub * (128 * 32);
        if (map == 1) { const float sc = lam / l_run;
#pragma unroll
            for (int d = 0; d < 4; ++d)
#pragma unroll
                for (int i = 0; i < 16; ++i) xb[(32 * d + crow16(i, hh)) * 32 + q32] = O[d][i] * sc; }
        __syncthreads();
        bf16_t* ob = (bf16_t*)lds;
        if (map == 0) { const float sc = 1.f / l_run; float ss = 0.f;
#pragma unroll
            for (int d = 0; d < 4; ++d)
#pragma unroll
                for (int i = 0; i < 16; ++i) { const float o = O[d][i] * sc - xb[(32 * d + crow16(i, hh)) * 32 + q32]; O[d][i] = o; ss += o * o; }
            ss += __shfl_xor(ss, 32);
            const float rs = (1.f / sqrtf(ss * (1.f / 128.f) + EPS)) * (1.f - lam_init);
#pragma unroll
            for (int d = 0; d < 4; ++d)
#pragma unroll
                for (int i = 0; i < 16; ++i) { const int dv = 32 * d + crow16(i, hh); ob[(qsub * 32 + q32) * 136 + dv] = (bf16_t)f2bf(O[d][i] * rs * a.in[I_DASUB][dv]); } }
        __syncthreads();
#pragma unroll
        for (int i = 0; i < 4; ++i) { const int c = tid + 512 * i, qq = c >> 4, part = c & 15;
            const u32x2* s = (const u32x2*)(ob + qq * 136 + part * 8); const u32x2 lo = s[0], hi = s[1]; u32x4 w = {lo.x, lo.y, hi.x, hi.y};
            *(u32x4*)(MIX + (size_t)pos_row(b, qb * 128 + qq) * D + 512 + h * 128 + part * 8) = w; }
    }
}

template <int L>
DI void hyena_channel(unsigned char* lds, const bf16_t* uv, const bf16_t* ux1, const bf16_t* ux2, int bstride, const float* G0, const float* G1,
                      const float* cw, const float* cb, int ch, float bias0, float bias1, bf16_t* yout) {
    constexpr int NA = L / 32, RS = (L + 192) * 2 + 16, FL = 2 * L + 8, NP = NA / 8;
    unsigned char* bufA = lds; unsigned char* bufB = lds + 8 * RS; unsigned char* bufC = lds + 16 * RS; bf16_t* filt = (bf16_t*)(bufC + 8 * L * 2);
    const int tid = otid(); const int lane = tid & 63, wv = tid >> 6, q32 = lane & 31, hh = lane >> 5;
    __syncthreads();
    for (int c = tid; c < 2 * 8 * 25; c += NTHR) { const int bf = c / 200, r = (c % 200) / 25, k = c % 25;
        unsigned char* row = (bf ? bufB : bufA) + r * RS; u32x4 z = {0u, 0u, 0u, 0u};
        *(u32x4*)(row + (k < 12 ? k * 16 : 192 + L * 2 + (k - 12) * 16)) = z; }
#pragma unroll
    for (int q = 0; q < 3; ++q) {
        const bf16_t* src = q == 0 ? uv : q == 1 ? ux1 : ux2;
        const float w0 = cw[q * 512 + ch], w1 = cw[1536 + q * 512 + ch], w2 = cw[3072 + q * 512 + ch], bb = cb[q * 512 + ch];
        for (int c = tid; c < L; c += NTHR) { const int b = c / (L / 8), tc = (c % (L / 8)) * 8; const bf16_t* sp = src + (size_t)b * bstride + tc;
            const u32x4 w = *(const u32x4*)sp; float x[10];
            x[0] = tc > 0 ? bf2f(sp[-1]) : 0.f; x[9] = tc + 8 < L ? bf2f(sp[8]) : 0.f;
            x[1] = __uint_as_float(w.x << 16); x[2] = __uint_as_float(w.x & 0xffff0000u); x[3] = __uint_as_float(w.y << 16); x[4] = __uint_as_float(w.y & 0xffff0000u);
            x[5] = __uint_as_float(w.z << 16); x[6] = __uint_as_float(w.z & 0xffff0000u); x[7] = __uint_as_float(w.w << 16); x[8] = __uint_as_float(w.w & 0xffff0000u);
            u32x4 o; o.x = pk2(w0 * x[0] + w1 * x[1] + w2 * x[2] + bb, w0 * x[1] + w1 * x[2] + w2 * x[3] + bb); o.y = pk2(w0 * x[2] + w1 * x[3] + w2 * x[4] + bb, w0 * x[3] + w1 * x[4] + w2 * x[5] + bb);
            o.z = pk2(w0 * x[4] + w1 * x[5] + w2 * x[6] + bb, w0 * x[5] + w1 * x[6] + w2 * x[7] + bb); o.w = pk2(w0 * x[6] + w1 * x[7] + w2 * x[8] + bb, w0 * x[7] + w1 * x[8] + w2 * x[9] + bb);
            unsigned char* d = q == 2 ? bufC + (b * L + tc) * 2 : (q == 0 ? bufA : bufB) + b * RS + (96 + tc) * 2;
            *(u32x4*)d = o; }
    }
#pragma unroll 1
    for (int n = 0; n < 2; ++n) {
        __syncthreads();
        { const float* G = n == 0 ? G0 : G1;
          for (int idx = tid; idx < 4 * FL; idx += NTHR) { const int r = idx / FL, k = idx % FL, lag = L - k - r;
              filt[idx] = (bf16_t)((lag > -L && lag < L) ? f2bf(G[lag + L - 1]) : 0u); } }
        __syncthreads();
        const unsigned char* zin = n == 0 ? bufA : bufB;
        const float bias = n == 0 ? bias0 : bias1;
        for (int pr = wv; pr < NP; pr += NWAVES) {
            const int A0 = 8 * pr, bcol = q32 >> 2, al = q32 & 3;
            f32x16 acc0, acc1;
#pragma unroll
            for (int i = 0; i < 16; ++i) { acc0[i] = 0.f; acc1[i] = 0.f; }
            const unsigned char* zrow = zin + bcol * RS + (96 + 32 * al + 8 * hh) * 2;
#pragma unroll 2
            for (int d = A0 - (NA - 1); d <= A0 + 7; ++d) {
                const int X0 = 8 * hh - q32 - 32 * d + L, r = X0 & 3;
                const unsigned char* fp = (const unsigned char*)(filt + r * FL + (X0 - r));
                const s16x4 f0 = *(const s16x4*)fp, f1 = *(const s16x4*)(fp + 8), f2 = *(const s16x4*)(fp + 32), f3 = *(const s16x4*)(fp + 40);
                const bf16x8 a0 = __builtin_shufflevector(f0, f1, 0, 1, 2, 3, 4, 5, 6, 7), a1 = __builtin_shufflevector(f2, f3, 0, 1, 2, 3, 4, 5, 6, 7);
                const int ap0 = A0 - d, ap1 = ap0 + 4;
                if (ap0 >= -3 && ap0 <= NA - 1) { const unsigned char* zp = zrow + ap0 * 64; acc0 = MFMA32(a0, *(const bf16x8*)zp, acc0); acc0 = MFMA32(a1, *(const bf16x8*)(zp + 32), acc0); }
                if (ap1 >= -3 && ap1 <= NA - 1) { const unsigned char* zp = zrow + ap1 * 64; acc1 = MFMA32(a0, *(const bf16x8*)zp, acc1); acc1 = MFMA32(a1, *(const bf16x8*)(zp + 32), acc1); }
            }
#pragma unroll
            for (int hb = 0; hb < 2; ++hb)
#pragma unroll
                for (int i = 0; i < 16; ++i) { const int t = 32 * (A0 + 4 * hb + al) + crow16(i, hh);
                    const float zv = bf2f(*(const bf16_t*)(zin + bcol * RS + (96 + t) * 2));
                    bf16_t* gp = (bf16_t*)(n == 0 ? bufB + bcol * RS + (96 + t) * 2 : bufC + (bcol * L + t) * 2);
                    *gp = (bf16_t)f2bf(bf2f(*gp) * ((hb ? acc1[i] : acc0[i]) + bias * zv)); }
        }
    }
    __syncthreads();
    for (int c = tid; c < L; c += NTHR) { const int b = c / (L / 8), tc = (c % (L / 8)) * 8; *(u32x4*)(yout + (size_t)b * bstride + tc) = *(const u32x4*)(bufC + (b * L + tc) * 2); }
}
DI void ph_hyena(const Args& a, unsigned char* lds, int bid, int nb) {
    bf16_t* UT = (bf16_t*)(a.ws + WS_UT);
    const float* cw = a.in[I_HYCW]; const float* cb = a.in[I_HYCB];
    for (int ch = bid; ch < 512; ch += nb) {
        bf16_t* rv = UT + (size_t)ch * MALL; const bf16_t* r1 = UT + (size_t)(512 + ch) * MALL; const bf16_t* r2 = UT + (size_t)(1024 + ch) * MALL;
        const float b0 = a.in[I_HYBIAS][ch], b1 = a.in[I_HYBIAS][512 + ch];
        hyena_channel<S>(lds, rv, r1, r2, S, (const float*)(a.ws + WS_HFL) + (size_t)ch * 4096, (const float*)(a.ws + WS_HFL) + (size_t)(512 + ch) * 4096, cw, cb, ch, b0, b1, rv);
        hyena_channel<C>(lds, rv + MLAT, r1 + MLAT, r2 + MLAT, C, (const float*)(a.ws + WS_HFC) + (size_t)ch * 512, (const float*)(a.ws + WS_HFC) + (size_t)(512 + ch) * 512, cw, cb, ch, b0, b1, rv + MLAT);
    }
}
DI void ph_hy_transpose(const Args& a, float* lds, int bid, int nb) {
    const int tid = otid();
    const bf16_t* UT = (const bf16_t*)(a.ws + WS_UT); bf16_t* MIX = (bf16_t*)(a.ws + WS_MIX);
    bf16_t* ts = (bf16_t*)lds;
    for (int it = bid; it < (MALL / 64) * 8; it += nb) {
        const int mt = it >> 3, ct = it & 7, m0 = mt * 64, c0 = ct * 64;
        __syncthreads();
        { const int chl = tid >> 3, part = tid & 7; const u32x4 w = *(const u32x4*)(UT + (size_t)(c0 + chl) * MALL + m0 + part * 8);
          unsigned* d = (unsigned*)(ts + chl * 66 + part * 8); d[0] = w.x; d[1] = w.y; d[2] = w.z; d[3] = w.w; }
        __syncthreads();
        { const int ml = tid >> 3, part = tid & 7; unsigned w[4];
#pragma unroll
          for (int q = 0; q < 4; ++q) { const unsigned lo = ts[(part * 8 + 2 * q) * 66 + ml], hi = ts[(part * 8 + 2 * q + 1) * 66 + ml]; w[q] = lo | (hi << 16); }
          u32x4 o = {w[0], w[1], w[2], w[3]}; *(u32x4*)(MIX + (size_t)(m0 + ml) * D + c0 + part * 8) = o; }
    }
}

constexpr int CW_CNT = 8192;
constexpr int MOE_MAXT = 176;
DI void ph_route(const Args& a, float* lds, int bid, int nb, int l, int nrows) {
    const int tid = otid(); const int lane = tid & 63, wv = tid >> 6;
    const float* mod = (const float*)(a.ws + WS_MOD) + (size_t)l * 9 * 6144;
    const float* wgrp = a.in[I_MWGRP] + (size_t)l * D * 4; const float* bgrp = a.in[I_MBGRP] + l * 4;
    const float* wrt = a.in[I_MWRT] + (size_t)l * D * 32; const float* brt = a.in[I_MBRT] + l * 32;
    bf16_t* XN = (bf16_t*)(a.ws + WS_XN);
    unsigned* cnt = (unsigned*)(a.ws + WS_CTL) + CW_CNT + l * 32 * 64;
    int* tok_e = (int*)(a.ws + WS_TOK); int* tok_pos = tok_e + 2 * MALL; float* tok_w = (float*)(tok_pos + 2 * MALL);
    float* part = lds + wv * (36 * 65);
    for (int m = bid * NWAVES + wv; m < nrows; m += nb * NWAVES) {
        const f32x4* r = (const f32x4*)row_ptr(a, m); f32x4 v[4]; float s = 0.f;
#pragma unroll
        for (int j = 0; j < 4; ++j) { v[j] = r[lane + 64 * j]; s += v[j].x * v[j].x + v[j].y * v[j].y + v[j].z * v[j].z + v[j].w * v[j].w; }
        s = wave_sum(s);
        const float rs = 1.f / sqrtf(s * (1.f / D) + EPS);
        const float* mr = mod + (size_t)mod_row(m) * 6144;
        u32x2* o = (u32x2*)(XN + (size_t)m * D);
#pragma unroll
        for (int j = 0; j < 4; ++j) { const f32x4 sh = *(const f32x4*)(mr + 3072 + 4 * (lane + 64 * j)), sc = *(const f32x4*)(mr + 4096 + 4 * (lane + 64 * j));
            v[j].x = v[j].x * rs * (1.f + sc.x) + sh.x; v[j].y = v[j].y * rs * (1.f + sc.y) + sh.y; v[j].z = v[j].z * rs * (1.f + sc.z) + sh.z; v[j].w = v[j].w * rs * (1.f + sc.w) + sh.w;
            u32x2 w; w.x = pk2(v[j].x, v[j].y); w.y = pk2(v[j].z, v[j].w); o[lane + 64 * j] = w; }
        float p[36];
#pragma unroll
        for (int i = 0; i < 36; ++i) p[i] = 0.f;
#pragma unroll
        for (int j = 0; j < 4; ++j)
#pragma unroll
            for (int kk = 0; kk < 4; ++kk) { const int k = 4 * (lane + 64 * j) + kk; const float vv = v[j][kk];
                const f32x4 wg = *(const f32x4*)(wgrp + (size_t)k * 4);
                p[0] += vv * wg.x; p[1] += vv * wg.y; p[2] += vv * wg.z; p[3] += vv * wg.w;
#pragma unroll
                for (int q = 0; q < 8; ++q) { const f32x4 wr = *(const f32x4*)(wrt + (size_t)k * 32 + 4 * q); p[4 + 4 * q] += vv * wr.x; p[5 + 4 * q] += vv * wr.y; p[6 + 4 * q] += vv * wr.z; p[7 + 4 * q] += vv * wr.w; } }
#pragma unroll
        for (int i = 0; i < 36; ++i) part[i * 65 + lane] = p[i];
        __builtin_amdgcn_wave_barrier();
        float lgv = 0.f;
        if (lane < 36) { const float* pp = part + lane * 65;
#pragma unroll 8
            for (int i = 0; i < 64; ++i) lgv += pp[i];
            lgv += lane < 4 ? bgrp[lane] : brt[lane - 4]; }
        __builtin_amdgcn_wave_barrier();
        const float g0 = __shfl(lgv, 0), g1 = __shfl(lgv, 1), g2 = __shfl(lgv, 2), g3 = __shfl(lgv, 3);
        int g = 0; float gm = g0;
        if (g1 > gm) { gm = g1; g = 1; } if (g2 > gm) { gm = g2; g = 2; } if (g3 > gm) { gm = g3; g = 3; }
        const float pg = 1.f / (expf(g0 - gm) + expf(g1 - gm) + expf(g2 - gm) + expf(g3 - gm));
        float le[8];
#pragma unroll
        for (int i = 0; i < 8; ++i) le[i] = __shfl(lgv, 4 + 8 * g + i);
        int e0 = 0; float v0 = le[0];
#pragma unroll
        for (int i = 1; i < 8; ++i) if (le[i] > v0) { v0 = le[i]; e0 = i; }
        int e1 = -1; float v1 = -3.4e38f;
#pragma unroll
        for (int i = 0; i < 8; ++i) if (i != e0 && le[i] > v1) { v1 = le[i]; e1 = i; }
        const float p1 = expf(v1 - v0); const float w0 = pg / (1.f + p1), w1 = pg * p1 / (1.f + p1);
        if (lane == 0) {
            const int E0 = g * 8 + e0, E1 = g * 8 + e1;
            const unsigned q0 = __hip_atomic_fetch_add(cnt + E0 * 64, 1u, __ATOMIC_RELAXED, __HIP_MEMORY_SCOPE_AGENT);
            const unsigned q1 = __hip_atomic_fetch_add(cnt + E1 * 64, 1u, __ATOMIC_RELAXED, __HIP_MEMORY_SCOPE_AGENT);
            tok_e[2 * m] = E0; tok_e[2 * m + 1] = E1; tok_pos[2 * m] = (int)q0; tok_pos[2 * m + 1] = (int)q1; tok_w[2 * m] = w0; tok_w[2 * m + 1] = w1;
        }
    }
}
DI void moe_tables(const Args& a, int* tab, int l, int tid) {
    const unsigned* cnt = (const unsigned*)(a.ws + WS_CTL) + CW_CNT + l * 32 * 64;
    if (tid == 0) { int t = 0; for (int e = 0; e < 32; ++e) { tab[e] = t; const int c = (int)__hip_atomic_load(cnt + e * 64, __ATOMIC_RELAXED, __HIP_MEMORY_SCOPE_AGENT); const int nt = (c + 255) >> 8; for (int i = 0; i < nt; ++i) tab[33 + t + i] = e; t += nt; } tab[32] = t; }
    __syncthreads();
}
DI void ph_gather(const Args& a, float* lds, int bid, int nb, int l, int nrows) {
    const int tid = otid(); const int lane = tid & 63, wv = tid >> 6;
    int* tab = (int*)(lds + 32768);
    moe_tables(a, tab, l, tid);
    const bf16_t* XN = (const bf16_t*)(a.ws + WS_XN); bf16_t* XS = (bf16_t*)(a.ws + WS_U);
    const int* tok_e = (const int*)(a.ws + WS_TOK); const int* tok_pos = tok_e + 2 * MALL; const float* tok_w = (const float*)(tok_pos + 2 * MALL); int* tok_dst = (int*)(tok_w + 2 * MALL);
    float* roww = (float*)(a.ws + WS_ROWW);
    for (int m = bid * NWAVES + wv; m < nrows; m += nb * NWAVES) {
        const u32x4* src = (const u32x4*)(XN + (size_t)m * D);
        const u32x4 x0 = src[lane], x1 = src[64 + lane];
#pragma unroll
        for (int k = 0; k < 2; ++k) {
            const int e = tok_e[2 * m + k]; const int dst = tab[e] * 256 + tok_pos[2 * m + k];
            u32x4* d = (u32x4*)(XS + (size_t)dst * D); d[lane] = x0; d[64 + lane] = x1;
            if (lane == 0) { roww[dst] = tok_w[2 * m + k]; tok_dst[2 * m + k] = dst; }
        }
    }
}
template <int NPN> struct MoeOrder {
    const int* tab; int G, c;
    __device__ bool next(int i, pg8::Unit& u) const { const int L = i * G + c; if (L >= tab[32] * NPN) return false; u.pm = L / NPN; u.pn = tab[33 + u.pm] * NPN + (L % NPN); return true; }
    __device__ __forceinline__ void a_ready(const pg8::Unit&) const {}
    __device__ __forceinline__ void done(const pg8::Unit&) const {}
};
struct EpiSwiGLU {
    static constexpr bool PERM = true, AFTER_DRAIN = false;
    bf16_t* H; const float* roww;
    __device__ __forceinline__ void operator()(const f32x4 (&acc)[2][2][4][2], const pg8::Unit& u, int wr, int wc, int fr, int fq) const {
        const int row0 = u.pm * 256 + wr * 64 + fr, col0 = (u.pn & 1) * 128 + wc * 32 + 8 * fq;
#pragma unroll
        for (int ai = 0; ai < 2; ++ai)
#pragma unroll
            for (int m = 0; m < 4; ++m) { const int r = row0 + ai * 128 + m * 16; const float w = roww[r];
                float hv[8];
#pragma unroll
                for (int n = 0; n < 2; ++n)
#pragma unroll
                    for (int j = 0; j < 4; ++j) { const float g = acc[ai][0][m][n][j], up = acc[ai][1][m][n][j]; hv[4 * n + j] = g / (1.f + __expf(-g)) * up * w; }
                u32x4 o; o.x = cvt_pk(hv[0], hv[1]); o.y = cvt_pk(hv[2], hv[3]); o.z = cvt_pk(hv[4], hv[5]); o.w = cvt_pk(hv[6], hv[7]);
                *(u32x4*)(H + (size_t)r * 256 + col0) = o; }
    }
};
struct EpiStoreY {
    static constexpr bool PERM = true, AFTER_DRAIN = false;
    bf16_t* O;
    __device__ __forceinline__ void operator()(const f32x4 (&acc)[2][2][4][2], const pg8::Unit& u, int wr, int wc, int fr, int fq) const {
        const int row0 = u.pm * 256 + wr * 64 + fr, col0 = (u.pn & 3) * 256 + wc * 32 + 8 * fq;
#pragma unroll
        for (int ai = 0; ai < 2; ++ai)
#pragma unroll
            for (int m = 0; m < 4; ++m) { bf16_t* rowp = O + (size_t)(row0 + ai * 128 + m * 16) * D + col0;
#pragma unroll
                for (int bj = 0; bj < 2; ++bj) { const f32x4 v0 = acc[ai][bj][m][0], v1 = acc[ai][bj][m][1];
                    u32x4 w; w.x = cvt_pk(v0[0], v0[1]); w.y = cvt_pk(v0[2], v0[3]); w.z = cvt_pk(v1[0], v1[1]); w.w = cvt_pk(v1[2], v1[3]);
                    *(u32x4*)(rowp + bj * 128) = w; } }
    }
};
DI void ph_combine(const Args& a, int bid, int nb, int l, int nrows, bool next_norm) {
    const int tid = otid(); const int lane = tid & 63, wv = tid >> 6;
    const float* mod = (const float*)(a.ws + WS_MOD) + (size_t)l * 9 * 6144; const float* modn = (const float*)(a.ws + WS_MOD) + (size_t)(l + 1) * 9 * 6144;
    const bf16_t* Y = (const bf16_t*)(a.ws + WS_U); bf16_t* XN = (bf16_t*)(a.ws + WS_XN);
    const int* tok_dst = (const int*)(a.ws + WS_TOK) + 6 * MALL;
    for (int m = bid * NWAVES + wv; m < nrows; m += nb * NWAVES) {
        f32x4* r = (f32x4*)row_ptr_w(a, m); const float* mr = mod + (size_t)mod_row(m) * 6144 + 5120;
        const bf16_t* y0 = Y + (size_t)tok_dst[2 * m] * D; const bf16_t* y1 = Y + (size_t)tok_dst[2 * m + 1] * D;
        f32x4 v[4]; float s = 0.f;
#pragma unroll
        for (int j = 0; j < 4; ++j) { const int c4 = lane + 64 * j; const f32x4 g = *(const f32x4*)(mr + 4 * c4); const f32x4 ya = ld4bf(y0 + 4 * c4), yb = ld4bf(y1 + 4 * c4);
            v[j] = r[c4] + g * (ya + yb); r[c4] = v[j]; s += v[j].x * v[j].x + v[j].y * v[j].y + v[j].z * v[j].z + v[j].w * v[j].w; }
        if (next_norm) {
            s = wave_sum(s); const float rs = 1.f / sqrtf(s * (1.f / D) + EPS);
            const float* mn = modn + (size_t)mod_row(m) * 6144; u32x2* o = (u32x2*)(XN + (size_t)m * D);
#pragma unroll
            for (int j = 0; j < 4; ++j) { const f32x4 sh = *(const f32x4*)(mn + 4 * (lane + 64 * j)), sc = *(const f32x4*)(mn + 1024 + 4 * (lane + 64 * j));
                u32x2 w; w.x = pk2(v[j].x * rs * (1.f + sc.x) + sh.x, v[j].y * rs * (1.f + sc.y) + sh.y); w.y = pk2(v[j].z * rs * (1.f + sc.z) + sh.z, v[j].w * rs * (1.f + sc.w) + sh.w);
                o[lane + 64 * j] = w; }
        }
    }
}

constexpr size_t ATT_KR = 0, ATT_VRT = (size_t)32 * NPOS * 128, ATT_GK = 2 * ATT_VRT, ATT_GVT = ATT_GK + (size_t)16 * NPOS * 64;
constexpr size_t XN_QR = 0, XN_GQ = (size_t)32 * S * 128;
DI void ph_prep1(const Args& a, float* lds, int bid, int nb) {
    const int tid = otid(); const int lane = tid & 63, wv = tid >> 6;
    const bf16_t* U = (const bf16_t*)(a.ws + WS_U);
    bf16_t* XNb = (bf16_t*)(a.ws + WS_XN); bf16_t* ATb = (bf16_t*)(a.ws + WS_ATT);
    bf16_t* vs = (bf16_t*)lds;
    const float gq = a.in[I_GQQN][lane], gk = a.in[I_GQKN][lane];
    const float rscale = 0.08838834764831845f;
    const float inv1d = exp2f(-(float)lane * (13.287712379549449f / 63.f));
    for (int it = bid; it < NB * 36; it += nb) {
        const int b = it / 36, ch = it % 36, p0 = ch * 64;
        __syncthreads();
#pragma unroll
        for (int i = 0; i < 10; ++i) { const int c = tid + 512 * i, pp = c / 80, part = c % 80;
            const u32x4 w = *(const u32x4*)(U + (size_t)pos_row(b, p0 + pp) * O_IN + (part < 64 ? 1024 + part * 8 : 2688 + (part - 64) * 8));
            unsigned* d = (unsigned*)(vs + pp * 642 + part * 8); d[0] = w.x; d[1] = w.y; d[2] = w.z; d[3] = w.w; }
        for (int wi = wv; wi < 64 * 18; wi += NWAVES) {
            const int pp = wi / 18, j = wi % 18; const int p = p0 + pp; const bool lat = p >= C; const int t = p - C;
            const bf16_t* ur = U + (size_t)pos_row(b, p) * O_IN;
            if (j < 8) {
                if (j < 4 && !lat) continue;
                float x1 = bf2f(ur[j * 128 + lane]), x2 = bf2f(ur[j * 128 + 64 + lane]);
                if (lat) { const float ang = (float)t * inv1d, c = cosf(ang), s = sinf(ang); const float y1 = x1 * c - x2 * s, y2 = x2 * c + x1 * s; x1 = y1; x2 = y2; }
                bf16_t* d;
                if (j < 4) d = XNb + XN_QR + ((size_t)(b * 4 + j) * S + t) * 128;
                else { x1 *= rscale; x2 *= rscale; d = ATb + ATT_KR + ((size_t)(b * 4 + (j - 4)) * NPOS + p) * 128; }
                d[lane] = (bf16_t)f2bf(x1); d[64 + lane] = (bf16_t)f2bf(x2);
            } else {
                const bool isq = j < 16;
                if (isq && !lat) continue;
                float v = bf2f(ur[(isq ? 2048 + (j - 8) * 64 : 2560 + (j - 16) * 64) + lane]); const float ss = wave_sum(v * v);
                v = v * (1.f / sqrtf(ss * (1.f / 64.f) + EPS)) * (isq ? gq : gk);
                if (lat) axial_rope64(v, lane, t);
                if (isq) { v *= 0.125f * 1.4426950408889634f; XNb[XN_GQ + ((size_t)(b * 8 + (j - 8)) * S + t) * 64 + lane] = (bf16_t)f2bf(v); }
                else ATb[ATT_GK + ((size_t)(b * 2 + (j - 16)) * NPOS + p) * 64 + lane] = (bf16_t)f2bf(v);
            }
        }
        __syncthreads();
#pragma unroll
        for (int i = 0; i < 5; ++i) { const int task = tid + 512 * i, r = task >> 2, pg = task & 3; unsigned w[8];
#pragma unroll
            for (int q = 0; q < 8; ++q) { const unsigned lo = vs[(pg * 16 + 2 * q) * 642 + r], hi = vs[(pg * 16 + 2 * q + 1) * 642 + r]; w[q] = lo | (hi << 16); }
            bf16_t* d = r < 512 ? ATb + ATT_VRT + ((size_t)(b * 4 + (r >> 7)) * 128 + (r & 127)) * NPOS : ATb + ATT_GVT + ((size_t)(b * 2 + ((r - 512) >> 6)) * 64 + ((r - 512) & 63)) * NPOS;
            u32x4* dd = (u32x4*)(d + p0 + pg * 16); u32x4 w0 = {w[0], w[1], w[2], w[3]}, w1 = {w[4], w[5], w[6], w[7]}; dd[0] = w0; dd[1] = w1; }
    }
}

DI void ph_retention(const Args& a, unsigned char* lds, int bid, int nb) {
    const int tid = otid(); const int lane = tid & 63, wv = tid >> 6, q32 = lane & 31, hh = lane >> 5;
    const bf16_t* XNb = (const bf16_t*)(a.ws + WS_XN); const bf16_t* ATb = (const bf16_t*)(a.ws + WS_ATT);
    const bf16_t* U = (const bf16_t*)(a.ws + WS_U); bf16_t* MIX = (bf16_t*)(a.ws + WS_MIX);
    constexpr int KBUF = 64 * 272, VBUF = 128 * 136, TBUF = KBUF + VBUF;
    for (int u = bid; u < 32 * 8; u += nb) {
        const int bh = u >> 3, qb = u & 7, b = bh >> 2, h = bh & 3, T0 = qb * 256;
        const int t = T0 + wv * 32 + q32;
        const float df = a.in[I_RETDEC][h], db = a.in[I_RETDEC][4 + h];
        const float lf = (fminf(df, 0.f) - log1pf(expf(-fabsf(df)))) * 1.4426950408889634f, lb = (fminf(db, 0.f) - log1pf(expf(-fabsf(db)))) * 1.4426950408889634f;
        bf16x8 qf[8];
        { const bf16_t* qg = XNb + XN_QR + ((size_t)bh * S + t) * 128 + 8 * hh;
#pragma unroll
          for (int ks = 0; ks < 8; ++ks) qf[ks] = *(const bf16x8*)(qg + 16 * ks); }
        const bf16_t* Kg = ATb + ATT_KR + (size_t)bh * NPOS * 128; const bf16_t* Vg = ATb + ATT_VRT + (size_t)bh * 128 * NPOS;
        float* tab = (float*)(lds + 2 * TBUF); const f32x4* tabf = (const f32x4*)tab; const f32x4* tabb = (const f32x4*)(tab + 64);
        __syncthreads();
        if (tid < 64) { tab[tid] = exp2f(-(float)tid * lf); tab[64 + tid] = exp2f((float)tid * lb); }
        u32x4 st[4];
        auto gload = [&](int tt) {
#pragma unroll
            for (int i = 0; i < 2; ++i) { const int c = tid + 512 * i;
                st[i] = *(const u32x4*)(Kg + ((size_t)tt * 64 + (c >> 4)) * 128 + (c & 15) * 8);
                st[2 + i] = *(const u32x4*)(Vg + (size_t)(c >> 3) * NPOS + tt * 64 + (c & 7) * 8); } };
        auto lstore = [&](int buf) {
            unsigned char* kb = lds + buf * TBUF; unsigned char* vb = kb + KBUF;
#pragma unroll
            for (int i = 0; i < 2; ++i) { const int c = tid + 512 * i;
                *(u32x4*)(kb + (c >> 4) * 272 + (c & 15) * 16) = st[i];
                u32x2* d = (u32x2*)(vb + (c >> 3) * 136 + (c & 7) * 16); u32x2 lo = {st[2 + i].x, st[2 + i].y}, hi = {st[2 + i].z, st[2 + i].w}; d[0] = lo; d[1] = hi; } };
        __syncthreads();
        gload(0); lstore(0);
        __syncthreads();
        f32x16 O[4];
#pragma unroll
        for (int d = 0; d < 4; ++d)
#pragma unroll
            for (int i = 0; i < 16; ++i) O[d][i] = 0.f;
        for (int tt = 0; tt < 36; ++tt) {
            if (tt + 1 < 36) gload(tt + 1);
            const unsigned char* kb = lds + (tt & 1) * TBUF; const unsigned char* vb = kb + KBUF;
            f32x16 S0, S1;
#pragma unroll
            for (int i = 0; i < 16; ++i) { S0[i] = 0.f; S1[i] = 0.f; }
#pragma unroll
            for (int ks = 0; ks < 8; ++ks) {
                const bf16x8 k0 = *(const bf16x8*)(kb + q32 * 272 + 32 * ks + 16 * hh), k1 = *(const bf16x8*)(kb + (32 + q32) * 272 + 32 * ks + 16 * hh);
                S0 = MFMA32(k0, qf[ks], S0); S1 = MFMA32(k1, qf[ks], S1);
                if (ks & 1) __builtin_amdgcn_sched_barrier(0);
            }
            const int p0 = tt * 64; const int s0 = p0 - C;
            const int type = tt < 4 ? 0 : (s0 + 64 <= T0 ? 1 : (s0 >= T0 + 256 ? 2 : 3));
            const float bf0 = (float)(t + C - p0 - 4 * hh) * lf;
            const float bb0 = (float)((tt < 4 ? p0 + S : s0) + 4 * hh - t) * lb;
            const float basef = exp2f(bf0), baseb = exp2f(bb0);
            const int dfl = t - (tt < 4 ? 0 : s0) - 4 * hh;
#pragma unroll
            for (int k = 0; k < 4; ++k) {
                const f32x4 f0 = tabf[2 * k], f1 = tabf[8 + 2 * k], g0 = tabb[2 * k], g1 = tabb[8 + 2 * k];
#pragma unroll
                for (int j = 0; j < 4; ++j) {
                    float w0, w1;
                    if (type == 1) { w0 = basef * f0[j]; w1 = basef * f1[j]; }
                    else if (type == 2) { w0 = baseb * g0[j]; w1 = baseb * g1[j]; }
                    else if (type == 0) { w0 = basef * f0[j] + baseb * g0[j]; w1 = basef * f1[j] + baseb * g1[j]; }
                    else { const int d0 = dfl - (8 * k + j), d1 = d0 - 32;
                        w0 = (d0 >= 0 ? basef * f0[j] : 0.f) + (d0 <= 0 ? baseb * g0[j] : 0.f); w1 = (d1 >= 0 ? basef * f1[j] : 0.f) + (d1 <= 0 ? baseb * g1[j] : 0.f); }
                    S0[4 * k + j] *= w0; S1[4 * k + j] *= w1;
                }
                __builtin_amdgcn_sched_barrier(0);
            }
            __builtin_amdgcn_sched_barrier(0);
            const bf16x8 p00 = pack8(S0, 0), p01 = pack8(S0, 1), p10 = pack8(S1, 0), p11 = pack8(S1, 1);
#pragma unroll
            for (int d = 0; d < 4; ++d) {
                const unsigned char* vr = vb + (32 * d + q32) * 136 + 8 * hh;
                auto vfrag = [&](int koff) { const s16x4 lo = *(const s16x4*)(vr + koff * 2), hi = *(const s16x4*)(vr + koff * 2 + 16); return __builtin_shufflevector(lo, hi, 0, 1, 2, 3, 4, 5, 6, 7); };
                O[d] = MFMA32(vfrag(0), p00, O[d]); O[d] = MFMA32(vfrag(16), p01, O[d]); O[d] = MFMA32(vfrag(32), p10, O[d]); O[d] = MFMA32(vfrag(48), p11, O[d]);
                __builtin_amdgcn_sched_barrier(0);
            }
            if (tt + 1 < 36) lstore((tt + 1) & 1);
            __syncthreads();
        }
        const int tid2 = otid(), q32e = tid2 & 31, hhe = (tid2 >> 5) & 1, wve = tid2 >> 6;
        float sm = 0.f;
#pragma unroll
        for (int d = 0; d < 4; ++d)
#pragma unroll
            for (int i = 0; i < 16; ++i) sm += O[d][i];
        sm += __shfl_xor(sm, 32); const float mu = sm * (1.f / 128.f); float sq = 0.f;
#pragma unroll
        for (int d = 0; d < 4; ++d)
#pragma unroll
            for (int i = 0; i < 16; ++i) { O[d][i] -= mu; sq += O[d][i] * O[d][i]; }
        sq += __shfl_xor(sq, 32); const float rs = 1.f / sqrtf(sq * (1.f / 128.f) + EPS);
        bf16_t* ob = (bf16_t*)lds;
#pragma unroll
        for (int d = 0; d < 4; ++d)
#pragma unroll
            for (int i = 0; i < 16; ++i) ob[(wve * 32 + q32e) * 136 + 32 * d + crow16(i, hhe)] = (bf16_t)f2bf(O[d][i] * rs);
        __syncthreads();
#pragma unroll
        for (int i = 0; i < 8; ++i) { const int c = tid2 + 512 * i, qq = c >> 4, part = c & 15; const int m = b * S + T0 + qq;
            const u32x2* s = (const u32x2*)(ob + qq * 136 + part * 8); const u32x2 lo = s[0], hi = s[1];
            const u32x4 gw = *(const u32x4*)(U + (size_t)m * O_IN + 1536 + h * 128 + part * 8);
            const float* gn = a.in[I_RETGN] + h * 128 + part * 8;
            const unsigned ow[4] = {lo.x, lo.y, hi.x, hi.y}; const unsigned gww[4] = {gw.x, gw.y, gw.z, gw.w}; unsigned r[4];
#pragma unroll
            for (int q = 0; q < 4; ++q) { const float o0 = __uint_as_float(ow[q] << 16), o1 = __uint_as_float(ow[q] & 0xffff0000u), g0 = __uint_as_float(gww[q] << 16), g1 = __uint_as_float(gww[q] & 0xffff0000u);
                r[q] = pk2(o0 * gn[2 * q] * silu_f(g0), o1 * gn[2 * q + 1] * silu_f(g1)); }
            u32x4 w = {r[0], r[1], r[2], r[3]};
            *(u32x4*)(MIX + (size_t)m * D + h * 128 + part * 8) = w; }
    }
}

DI void ph_gqa(const Args& a, unsigned char* lds, int bid, int nb) {
    const int tid = otid(); const int lane = tid & 63, wv = tid >> 6, q32 = lane & 31, hh = lane >> 5, g = wv >> 1, qsub = wv & 1;
    const bf16_t* XNb = (const bf16_t*)(a.ws + WS_XN); const bf16_t* ATb = (const bf16_t*)(a.ws + WS_ATT); bf16_t* MIX = (bf16_t*)(a.ws + WS_MIX);
    constexpr int KBUF = 64 * 144, VBUF = 64 * 136, TBUF = KBUF + VBUF;
    for (int u = bid; u < NB * 2 * 32; u += nb) {
        const int b = u >> 6, kv = (u >> 5) & 1, qblk = u & 31, T0 = qblk * 64; const int hd = kv * 4 + g; const int t = T0 + qsub * 32 + q32;
        const float sink2 = a.in[I_GQSINK][hd] * 1.4426950408889634f;
        bf16x8 qf[4];
        { const bf16_t* qg = XNb + XN_GQ + ((size_t)(b * 8 + hd) * S + t) * 64 + 8 * hh;
#pragma unroll
          for (int ks = 0; ks < 4; ++ks) qf[ks] = *(const bf16x8*)(qg + 16 * ks); }
        const bf16_t* Kg = ATb + ATT_GK + (size_t)(b * 2 + kv) * NPOS * 64; const bf16_t* Vg = ATb + ATT_GVT + (size_t)(b * 2 + kv) * 64 * NPOS;
        auto tile_p = [&](int i) { return i < 4 ? 64 * i : C + T0 - 128 + 64 * (i - 4); };
        auto tile_ok = [&](int i) { if (i < 4) return true; const int s0 = T0 - 128 + 64 * (i - 4); return s0 >= 0 && s0 < S; };
        u32x4 st[2];
        auto gload = [&](int i) { const int p = tile_p(i);
            st[0] = *(const u32x4*)(Kg + ((size_t)p + (tid >> 3)) * 64 + (tid & 7) * 8);
            st[1] = *(const u32x4*)(Vg + (size_t)(tid >> 3) * NPOS + p + (tid & 7) * 8); };
        auto lstore = [&](int buf) {
            unsigned char* kb = lds + buf * TBUF; unsigned char* vb = kb + KBUF;
            *(u32x4*)(kb + (tid >> 3) * 144 + (tid & 7) * 16) = st[0];
            u32x2* d = (u32x2*)(vb + (tid >> 3) * 136 + (tid & 7) * 16); u32x2 lo = {st[1].x, st[1].y}, hi = {st[1].z, st[1].w}; d[0] = lo; d[1] = hi; };
        __syncthreads();
        gload(0); lstore(0);
        __syncthreads();
        f32x16 O[2];
#pragma unroll
        for (int d = 0; d < 2; ++d)
#pragma unroll
            for (int i = 0; i < 16; ++i) O[d][i] = 0.f;
        float m_run = -1e30f, l_run = 0.f;
        int buf = 0;
        for (int ti = 0; ti < 9; ++ti) {
            if (!tile_ok(ti)) continue;
            int nx = ti + 1; while (nx < 9 && !tile_ok(nx)) ++nx;
            if (nx < 9) gload(nx);
            const unsigned char* kb = lds + buf * TBUF; const unsigned char* vb = kb + KBUF;
            f32x16 S0, S1;
#pragma unroll
            for (int i = 0; i < 16; ++i) { S0[i] = 0.f; S1[i] = 0.f; }
#pragma unroll
            for (int ks = 0; ks < 4; ++ks) {
                const bf16x8 k0 = *(const bf16x8*)(kb + q32 * 144 + 32 * ks + 16 * hh), k1 = *(const bf16x8*)(kb + (32 + q32) * 144 + 32 * ks + 16 * hh);
                S0 = MFMA32(k0, qf[ks], S0); S1 = MFMA32(k1, qf[ks], S1);
            }
            if (ti >= 4) {
                const int dl = T0 - 128 + 64 * (ti - 4) + 4 * hh - t;
#pragma unroll
                for (int i = 0; i < 16; ++i) { const int d0 = dl + (i & 3) + 8 * (i >> 2), d1 = d0 + 32;
                    if (d0 < -128 || d0 > 128) S0[i] = -1e30f; if (d1 < -128 || d1 > 128) S1[i] = -1e30f; }
            }
            float mx = S0[0];
#pragma unroll
            for (int i = 1; i < 16; ++i) mx = fmaxf(mx, S0[i]);
#pragma unroll
            for (int i = 0; i < 16; ++i) mx = fmaxf(mx, S1[i]);
            mx = fmaxf(mx, __shfl_xor(mx, 32));
            const float m_new = fmaxf(m_run, mx); const float alpha = exp2f(m_run - m_new); m_run = m_new;
            float rsum = 0.f;
#pragma unroll
            for (int i = 0; i < 16; ++i) { S0[i] = exp2f(S0[i] - m_new); S1[i] = exp2f(S1[i] - m_new); rsum += S0[i] + S1[i]; }
            rsum += __shfl_xor(rsum, 32);
            l_run = l_run * alpha + rsum;
#pragma unroll
            for (int d = 0; d < 2; ++d)
#pragma unroll
                for (int i = 0; i < 16; ++i) O[d][i] *= alpha;
            const bf16x8 p00 = pack8(S0, 0), p01 = pack8(S0, 1), p10 = pack8(S1, 0), p11 = pack8(S1, 1);
#pragma unroll
            for (int d = 0; d < 2; ++d) {
                const unsigned char* vr = vb + (32 * d + q32) * 136 + 8 * hh;
                auto vfrag = [&](int koff) { const s16x4 lo = *(const s16x4*)(vr + koff * 2), hi = *(const s16x4*)(vr + koff * 2 + 16); return __builtin_shufflevector(lo, hi, 0, 1, 2, 3, 4, 5, 6, 7); };
                O[d] = MFMA32(vfrag(0), p00, O[d]); O[d] = MFMA32(vfrag(16), p01, O[d]); O[d] = MFMA32(vfrag(32), p10, O[d]); O[d] = MFMA32(vfrag(48), p11, O[d]);
            }
            if (nx < 9) lstore(buf ^ 1);
            buf ^= 1;
            __syncthreads();
        }
        const float il = 1.f / (l_run + exp2f(sink2 - m_run));
        bf16_t* ob = (bf16_t*)(lds + 2 * TBUF);
#pragma unroll
        for (int d = 0; d < 2; ++d)
#pragma unroll
            for (int i = 0; i < 16; ++i) ob[(qsub * 32 + q32) * 264 + g * 64 + 32 * d + crow16(i, hh)] = (bf16_t)f2bf(O[d][i] * il);
        __syncthreads();
#pragma unroll
        for (int i = 0; i < 4; ++i) { const int c = tid + 512 * i, qq = c >> 5, part = c & 31;
            const u32x4 w = *(const u32x4*)(ob + qq * 264 + part * 8);
            *(u32x4*)(MIX + (size_t)(b * S + T0 + qq) * D + 512 + kv * 256 + part * 8) = w; }
    }
}

constexpr int N_PHASES = 20;
DI int opq(int v) { asm volatile("" : "+s"(v)); return v; }
template <class Epi> DI void run_gemm(LAS unsigned char* lds, const bf16_t* A, const bf16_t* Bt, int M, int N, int K, const Epi& E) {
    pg8::Gemm g{A, Bt, M, N, opq(K)}; pg8::StaticOrder So; So.init(M, N, (int)gridDim.x, (int)blockIdx.x);
    pg8::gemm_phase<Epi, pg8::StaticOrder, true, true>(lds, g, So, E);
}
DI void moe_gemm1(const Args& a, float* lds, LAS unsigned char* ldsl, int l) {
    int* tab = (int*)(lds + 33792); moe_tables(a, tab, l, otid());
    pg8::Gemm g{(const bf16_t*)(a.ws + WS_U), (const bf16_t*)(a.ws + WS_MW1), MOE_MAXT * 256, 32 * 512, opq(D)};
    MoeOrder<2> So{tab, (int)gridDim.x, (int)blockIdx.x}; EpiSwiGLU E{(bf16_t*)(a.ws + WS_MIX), (const float*)(a.ws + WS_ROWW)};
    pg8::gemm_phase<EpiSwiGLU, MoeOrder<2>, true, true>(ldsl, g, So, E);
}
DI void moe_gemm2(const Args& a, float* lds, LAS unsigned char* ldsl, int l) {
    int* tab = (int*)(lds + 33792); moe_tables(a, tab, l, otid());
    pg8::Gemm g{(const bf16_t*)(a.ws + WS_MIX), (const bf16_t*)(a.ws + WS_MW2), MOE_MAXT * 256, 32 * 1024, opq(256)};
    MoeOrder<4> So{tab, (int)gridDim.x, (int)blockIdx.x}; EpiStoreY E{(bf16_t*)(a.ws + WS_U)};
    pg8::gemm_phase<EpiStoreY, MoeOrder<4>, true, true>(ldsl, g, So, E);
}
__global__ void __launch_bounds__(NTHR, 2) fwd_kernel(Args a) {
    extern __shared__ __attribute__((aligned(16))) unsigned char lds_raw[];
    float* lds = (float*)lds_raw;
    LAS unsigned char* ldsl = (LAS unsigned char*)lds_raw;
    volatile LAS unsigned* MISC = (volatile LAS unsigned*)(ldsl + LDS_BYTES - 64);
    const int bid = blockIdx.x, nb = gridDim.x;
    if (threadIdx.x < 16) MISC[threadIdx.x] = 0u;
    __syncthreads();
    XcdBarrier bar; bar.bar = (unsigned*)(a.ws + WS_CTL); bar.x = 0; bar.st = nullptr;
    const bool multi = (a.ph_hi - a.ph_lo) > 1;
    if (multi) bar = xcd_barrier_post((unsigned*)(a.ws + WS_CTL), MISC);
    const float* modb = (const float*)(a.ws + WS_MOD);
    bf16_t* U = (bf16_t*)(a.ws + WS_U); bf16_t* MIX = (bf16_t*)(a.ws + WS_MIX); bf16_t* XN = (bf16_t*)(a.ws + WS_XN); float* HC = (float*)(a.ws + WS_HC);
    const int lo = a.ph_lo, hi = a.ph_hi;
#define IN(k) (lo <= (k) && (k) < hi)
#define SEAM(k) do { if (IN(k) && IN((k) + 1)) xcd_barrier(bar); } while (0)
    if (IN(0)) { ph_init(a, lds, bid, nb); } SEAM(0);
    if (IN(1)) { ph_norm(a, bid, nb, MALL, modb, 0, 1024); } SEAM(1);
    if (IN(2)) { EpiStoreL0 E{(bf16_t*)(a.ws + WS_UT), (bf16_t*)(a.ws + WS_UA)}; run_gemm(ldsl, XN, (const bf16_t*)(a.ws + WS_WEIN), MALL, E_IN, D, E); } SEAM(2);
    if (IN(3)) { ph_prep0(a, lds, bid, nb); } SEAM(3);
    if (IN(4)) { ph_diffattn(a, lds_raw, bid, nb); __syncthreads(); ph_hyena(a, lds_raw, bid, nb); xcd_barrier(bar); ph_hy_transpose(a, lds, bid, nb); } SEAM(4);
    if (IN(5)) { EpiResid E{a.out, HC, modb, 2048}; run_gemm(ldsl, MIX, (const bf16_t*)(a.ws + WS_WEOUT), MALL, D, D, E); } SEAM(5);
    if (IN(6)) { ph_route(a, lds, bid, nb, 0, MALL); } SEAM(6);
    if (IN(7)) { ph_gather(a, lds, bid, nb, 0, MALL); } SEAM(7);
    if (IN(8)) { moe_gemm1(a, lds, ldsl, 0); } SEAM(8);
    if (IN(9)) { moe_gemm2(a, lds, ldsl, 0); } SEAM(9);
    if (IN(10)) { ph_combine(a, bid, nb, 0, MALL, true); } SEAM(10);
    if (IN(11)) { EpiStoreBf16 E{U, O_IN}; run_gemm(ldsl, XN, (const bf16_t*)(a.ws + WS_WOIN), MALL, O_IN, D, E); } SEAM(11);
    if (IN(12)) { ph_prep1(a, lds, bid, nb); ph_moe_convert(a, lds, bid, nb, 1); } SEAM(12);
    if (IN(13)) { ph_retention(a, lds_raw, bid, nb); __syncthreads(); ph_gqa(a, lds_raw, bid, nb); } SEAM(13);
    if (IN(14)) { EpiResid E{a.out, HC, modb + 9 * 6144, 2048}; run_gemm(ldsl, MIX, (const bf16_t*)(a.ws + WS_WOOUT), MLAT, D, D, E); } SEAM(14);
    if (IN(15)) { ph_route(a, lds, bid, nb, 1, MLAT); } SEAM(15);
    if (IN(16)) { ph_gather(a, lds, bid, nb, 1, MLAT); } SEAM(16);
    if (IN(17)) { moe_gemm1(a, lds, ldsl, 1); } SEAM(17);
    if (IN(18)) { moe_gemm2(a, lds, ldsl, 1); } SEAM(18);
    if (IN(19)) { ph_combine(a, bid, nb, 1, MLAT, false); }
#undef IN
#undef SEAM
}

extern "C" void kernel_launch(void* const* d_in, const int* in_sizes, int n_in, void* d_out, int out_size, void* d_ws, size_t ws_size, hipStream_t stream) {
    static int grid = 0;
    if (grid == 0) {
        if (n_in != N_IN || out_size != MLAT * D || ws_size < WS_END) { fprintf(stderr, "kernel_launch: unexpected shapes (n_in %d out %d ws %zu)\n", n_in, out_size, ws_size); grid = -1; return; }
        int dev = 0, cus = 0;
        if (hipGetDevice(&dev) != hipSuccess || hipDeviceGetAttribute(&cus, hipDeviceAttributeMultiprocessorCount, dev) != hipSuccess) { grid = -1; return; }
        if (hipFuncSetAttribute((const void*)fwd_kernel, hipFuncAttributeMaxDynamicSharedMemorySize, LDS_BYTES) != hipSuccess) { grid = -1; return; }
        grid = cus;
    }
    if (grid < 0) return;
    (void)hipMemsetAsync((char*)d_ws + WS_CTL, 0, CTL_ZERO_BYTES, stream);
    Args a{};
    for (int i = 0; i < N_IN; ++i) a.in[i] = (const float*)d_in[i];
    a.out = (float*)d_out; a.ws = (unsigned char*)d_ws;
#if MK_PER_PHASE
    for (int p = 0; p < N_PHASES; ++p) { a.ph_lo = p; a.ph_hi = p + 1; hipLaunchKernelGGL(fwd_kernel, dim3(grid), dim3(NTHR), LDS_BYTES, stream, a); }
#else
    a.ph_lo = 0; a.ph_hi = N_PHASES;
    hipLaunchKernelGGL(fwd_kernel, dim3(grid), dim3(NTHR), LDS_BYTES, stream, a);
#endif
}
```

```cpp
#include <hip/hip_runtime.h>
#include <cstdint>
#include <cstdio>

#ifndef MK_PER_PHASE
#define MK_PER_PHASE 0
#endif

#define DI __device__ __forceinline__
#define GAS __attribute__((address_space(1)))
#define LAS __attribute__((address_space(3)))
typedef float f32x4 __attribute__((ext_vector_type(4)));
typedef unsigned u32x4 __attribute__((ext_vector_type(4)));
typedef unsigned u32x2 __attribute__((ext_vector_type(2)));
typedef unsigned short bf16_t;

constexpr int D = 1024, NB = 8, S = 2048, C = 256;
constexpr int MLAT = NB * S, MCTX = NB * C, MALL = MLAT + MCTX;
constexpr int E_IN = 3072, O_IN = 2816;
constexpr int NTHR = 512, NWAVES = 8;
constexpr float EPS = 1e-6f;
constexpr int LDS_BYTES = 147456;

enum { I_X = 0, I_C, I_CTX, I_CCTX, I_ADAW, I_ADAB, I_EWIN, I_EWOUT, I_HYCW, I_HYCB, I_HYW1, I_HYB1, I_HYW2, I_HYB2, I_HYW3, I_HYFREQ, I_HYBIAS,
       I_DAQN, I_DAKN, I_DALAM, I_DASUB, I_OWIN, I_OWOUT, I_RETDEC, I_RETGN, I_GQQN, I_GQKN, I_GQSINK, I_MWGRP, I_MBGRP, I_MWRT, I_MBRT, I_MWG, I_MWU, I_MWD, N_IN };

constexpr size_t MiB = 1u << 20;
constexpr size_t WS_CTL = 0, CTL_ZERO_BYTES = 64 * 1024;
constexpr size_t WS_MOD = 1 * MiB;
constexpr size_t WS_HFL = 2 * MiB;
constexpr size_t WS_HFC = WS_HFL + 16 * MiB;
constexpr size_t WS_HC = WS_HFC + 2 * MiB;
constexpr size_t WS_WEIN = WS_HC + 8 * MiB;
constexpr size_t WS_WEOUT = WS_WEIN + 6 * MiB;
constexpr size_t WS_WOIN = WS_WEOUT + 2 * MiB;
constexpr size_t WS_WOOUT = WS_WOIN + 6 * MiB;
constexpr size_t WS_XN = WS_WOOUT + 2 * MiB;
constexpr size_t WS_U = WS_XN + 36 * MiB;
constexpr size_t WS_UT = WS_U;
constexpr size_t WS_UA = WS_U + 54 * MiB;
constexpr size_t WS_MIX = WS_U + 108 * MiB;
constexpr size_t WS_MW1 = WS_MIX + 36 * MiB;
constexpr size_t WS_MW2 = WS_MW1 + 32 * MiB;
constexpr size_t WS_TOK = WS_MW2 + 16 * MiB;
constexpr size_t WS_ROWW = WS_TOK + 1 * MiB;
constexpr size_t WS_ATT = WS_ROWW + 1 * MiB;
constexpr size_t WS_TRIG = WS_ATT + 48 * MiB;
constexpr size_t WS_END = WS_TRIG + 2 * MiB;
static_assert((size_t)176 * 256 * 1024 * 2 <= 108 * MiB && (size_t)176 * 256 * 256 * 2 <= 36 * MiB && (size_t)8 * MALL * 4 <= 1 * MiB, "moe overlays");
static_assert((size_t)MALL * 3072 * 2 <= 108 * MiB && (size_t)MALL * D * 2 <= 36 * MiB, "ws map");

struct Args { const float* in[N_IN]; float* out; unsigned char* ws; int ph_lo, ph_hi; };

DI float wave_sum(float v) {
#pragma unroll
    for (int o = 32; o > 0; o >>= 1) v += __shfl_xor(v, o);
    return v;
}
DI float wave_max(float v) {
#pragma unroll
    for (int o = 32; o > 0; o >>= 1) v = fmaxf(v, __shfl_xor(v, o));
    return v;
}
DI float silu_f(float x) { return x / (1.f + expf(-x)); }
DI int otid() { int t = threadIdx.x; asm volatile("" : "+v"(t)); return t; }
DI float bf2f(bf16_t v) { return __uint_as_float((unsigned)v << 16); }
DI unsigned f2bf(float f) { unsigned u = __float_as_uint(f); return (u + 0x7fffu + ((u >> 16) & 1u)) >> 16; }
DI unsigned pk2(float lo, float hi) { return f2bf(lo) | (f2bf(hi) << 16); }
DI f32x4 ld4bf(const bf16_t* p) { const u32x2 w = *(const u32x2*)p; f32x4 r; r.x = __uint_as_float(w.x << 16); r.y = __uint_as_float(w.x & 0xffff0000u); r.z = __uint_as_float(w.y << 16); r.w = __uint_as_float(w.y & 0xffff0000u); return r; }

#define XB_TMO      128
#define XB_XCNT(j)  (256  + 64 * (j))
#define XB_XSUB(j)  (1280 + 64 * (j))
#define XB_XGEN(j)  (2304 + 64 * (j))
#define XB_TOP      3328
#define XB_TOPGEN   3392
#define XCD_BAR_WORDS 3456
#define XB_SPIN_CAP (1u << 22)
DI unsigned xb_ld(unsigned* p)              { return __hip_atomic_load(p, __ATOMIC_RELAXED, __HIP_MEMORY_SCOPE_AGENT); }
DI unsigned xb_add(unsigned* p, unsigned v) { return __hip_atomic_fetch_add(p, v, __ATOMIC_RELAXED, __HIP_MEMORY_SCOPE_AGENT); }
DI unsigned xb_xcc_id() { return (unsigned)__builtin_amdgcn_s_getreg((3 << 11) | 20) & 0xFu; }
#define XB_SPIN(cond, bar) do { unsigned _sp = 0; while (cond) { __builtin_amdgcn_s_sleep(1); \
    if ((++_sp & 255u) == 0u) { if (xb_ld(&(bar)[XB_TMO])) break; if (_sp > XB_SPIN_CAP) { atomicAdd(&(bar)[XB_TMO], 1u); break; } } } } while (0)
struct XcdBarrier { unsigned* bar; unsigned x; volatile LAS unsigned* st; };
DI XcdBarrier xcd_barrier_post(unsigned* bar, volatile LAS unsigned* st) {
    XcdBarrier b; b.bar = bar; b.x = xb_xcc_id(); b.st = st;
    if (threadIdx.x == 0) (void)xb_add(&bar[XB_XCNT(b.x)], 1u);
    return b;
}
DI void xcd_barrier_complete(unsigned* bar, unsigned x, unsigned& nloc, unsigned& nx) {
    const unsigned G = gridDim.x * gridDim.y * gridDim.z;
    unsigned sum, cnt, mine, sp = 0u;
    for (;;) {
        sum = 0u; cnt = 0u; mine = 0u;
#pragma unroll
        for (unsigned j = 0; j < 16; ++j) { const unsigned c = xb_ld(&bar[XB_XCNT(j)]); sum += c; cnt += (c > 0u) ? 1u : 0u; mine = (j == x) ? c : mine; }
        if (sum == G) break;
        __builtin_amdgcn_s_sleep(1);
        if ((++sp & 255u) == 0u) { if (xb_ld(&bar[XB_TMO])) break; if (sp > XB_SPIN_CAP) { atomicAdd(&bar[XB_TMO], 1u); break; } }
    }
    nloc = mine > 0u ? mine : 1u; nx = cnt > 0u ? cnt : 1u;
}
DI void xcd_barrier(const XcdBarrier& b) {
    asm volatile("s_waitcnt vmcnt(0)" ::: "memory");
    __syncthreads();
    if (threadIdx.x == 0) {
        unsigned* bar = b.bar;
        __builtin_amdgcn_s_waitcnt(0);
        unsigned nloc = b.st[0], nx = b.st[1];
        if (nloc == 0u) { xcd_barrier_complete(bar, b.x, nloc, nx); b.st[0] = nloc; b.st[1] = nx; }
        const unsigned old = xb_add(&bar[XB_XSUB(b.x)], 1u);
        const unsigned gen = old / nloc;
        if (old + 1u == (gen + 1u) * nloc) {
            __builtin_amdgcn_fence(__ATOMIC_RELEASE, "agent");
            asm volatile("s_waitcnt vmcnt(0)" ::: "memory");
            const unsigned og = xb_add(&bar[XB_TOP], 1u);
            const unsigned tg = og / nx;
            if (og + 1u == (tg + 1u) * nx) xb_add(&bar[XB_TOPGEN], 1u);
            else XB_SPIN(xb_ld(&bar[XB_TOPGEN]) == tg, bar);
            __builtin_amdgcn_fence(__ATOMIC_ACQUIRE, "agent");
            xb_add(&bar[XB_XGEN(b.x)], 1u);
            asm volatile("s_waitcnt vmcnt(0)" ::: "memory");
        } else {
            XB_SPIN(xb_ld(&bar[XB_XGEN(b.x)]) == gen, bar);
            __builtin_amdgcn_fence(__ATOMIC_ACQUIRE, "agent");
            asm volatile("s_waitcnt vmcnt(0)" ::: "memory");
        }
    }
    __syncthreads();
}

namespace pg8 {
#define PG8_LAS __attribute__((address_space(3)))
typedef unsigned short bf16_t;
typedef short bf16x8 __attribute__((ext_vector_type(8)));
typedef float f32x4 __attribute__((ext_vector_type(4)));
typedef unsigned u32x4 __attribute__((ext_vector_type(4)));
constexpr int BM = 256, BK = 64, HALF = 128, HTB = HALF * BK * 2  , STAGE_BYTES = 8 * HTB, NXCD = 8, WGM = 8;

__host__ __device__ __forceinline__ int lds_byte(int r, int c) { const int st = (r >> 4) * 2 + (c >> 5), rr = r & 15, cc = c & 31, ob = rr * 64 + cc * 2; return st * 1024 + (ob ^ (((ob >> 9) & 1) << 5)); }
__host__ __device__ __forceinline__ void stage_rc(int b, int& R, int& C) { const int st = b / 1024, sb = b % 1024, swz = sb ^ (((sb >> 9) & 1) << 5); R = (st >> 1) * 16 + swz / 64; C = (st & 1) * 32 + (swz % 64) / 2; }
__host__ __device__ __forceinline__ int perm32(int rho) { const int n = rho >> 4, i = rho & 15; return 8 * (i >> 2) + 4 * n + (i & 3); }

struct Unit { int pm, pn; };
struct Gemm { const bf16_t* A; const bf16_t* Bt; int M, N, K; };

struct StaticOrder {
    int nM, nN, nwg, G, c;
    __host__ __device__ void init(int M, int N, int G_, int c_) { nM = M / BM; nN = N / BM; nwg = nM * nN; G = G_; c = c_; }
    __host__ __device__ bool next(int i, Unit& u) const {
        const long L = (long)i * G + c; if (L >= nwg) return false;
        int wgid = (int)L; { const int q = nwg / NXCD, r = nwg % NXCD, xcd = wgid % NXCD, off = wgid / NXCD; wgid = (xcd < r ? xcd * (q + 1) : r * (q + 1) + (xcd - r) * q) + off; }
        const int nig = WGM * nN, gid = wgid / nig, fm = gid * WGM, gsz = (nM - fm) < WGM ? (nM - fm) : WGM;
        u.pm = fm + ((wgid % nig) % gsz); u.pn = (wgid % nig) / gsz; return true;
    }
    __device__ __forceinline__ void a_ready(const Unit&) const {}
    __device__ __forceinline__ void done(const Unit&) const {}
};

__device__ __forceinline__ unsigned cvt_pk_bf16(float lo, float hi) { unsigned r; asm volatile("v_cvt_pk_bf16_f32 %0, %1, %2" : "=v"(r) : "v"(lo), "v"(hi)); return r; }
template <class Epi, class Sched, bool ALIGN_EPI = false, bool SP2 = false>
__device__ __forceinline__ void gemm_phase(PG8_LAS unsigned char* lds, const Gemm g, const Sched& S, const Epi& E) {
    const int tid = threadIdx.x, wid = __builtin_amdgcn_readfirstlane(tid >> 6), lane = tid & 63, wr = wid >> 2, wc = wid & 3, fr = lane & 15, fq = lane >> 4;
    const int K = g.K, nt = K / BK;
    unsigned voffA[2], voffB[2];
#pragma unroll
    for (int i = 0; i < 2; ++i) { int R, C; stage_rc(tid * 16 + i * 8192, R, C); const int Rb = Epi::PERM ? ((R & ~31) + perm32(R & 31)) : R;
        voffA[i] = (unsigned)(R * K + C) * 2u; voffB[i] = (unsigned)(Rb * K + C) * 2u; }
    const size_t kstep = (size_t)(BK * 2);
    const size_t hstep = (size_t)HALF * K * 2;
    const size_t tstep = 2 * hstep;
    const unsigned ldsw = (unsigned)wid * 1024u;
    const int aoff = lds_byte(wr * 64 + fr, fq * 8), boff = lds_byte(wc * 32 + fr, fq * 8);
#define PG8_SA(b, h) (((b) * 2 + (h)) * HTB)
#define PG8_SB(b, h) ((4 + (b) * 2 + (h)) * HTB)
#define PG8_STAGE(bufoff, gbase, voff) do { _Pragma("unroll") for (int _i = 0; _i < 2; ++_i) \
        __builtin_amdgcn_global_load_lds((const unsigned*)((const char*)(gbase) + (voff)[_i]), (PG8_LAS unsigned*)(lds + (bufoff) + ldsw + _i * 8192), 16, 0, 0); } while (0)
#define PG8_LDA(dst, b, h) do { _Pragma("unroll") for (int m = 0; m < 4; ++m) _Pragma("unroll") for (int k = 0; k < 2; ++k) dst[m][k] = *(const PG8_LAS bf16x8*)(lds + PG8_SA(b, h) + aoff + m * 2048 + k * 1024); } while (0)
#define PG8_LDB(dst, b, h) do { _Pragma("unroll") for (int n = 0; n < 2; ++n) _Pragma("unroll") for (int k = 0; k < 2; ++k) dst[n][k] = *(const PG8_LAS bf16x8*)(lds + PG8_SB(b, h) + boff + n * 2048 + k * 1024); } while (0)
#define PG8_MMA(ai, bj, At, Bt) do { __builtin_amdgcn_s_setprio(1); _Pragma("unroll") for (int m = 0; m < 4; ++m) _Pragma("unroll") for (int n = 0; n < 2; ++n) _Pragma("unroll") for (int k = 0; k < 2; ++k) \
        acc[ai][bj][m][n] = __builtin_amdgcn_mfma_f32_16x16x32_bf16(Bt[n][k], At[m][k], acc[ai][bj][m][n], 0, 0, 0); __builtin_amdgcn_s_setprio(0); } while (0)
#define PG8_WAIT_V(n) asm volatile("s_waitcnt vmcnt(" #n ")" ::: "memory")
#define PG8_WAIT_L(n) asm volatile("s_waitcnt lgkmcnt(" #n ")" ::: "memory")
#define PG8_BAR __builtin_amdgcn_s_barrier()
#define PG8_SCHED __builtin_amdgcn_sched_barrier(0)
    Unit cur, nxt; int ui = 0;
    if (!S.next(0, cur)) return;
    f32x4 acc[2][2][4][2];
#pragma unroll
    for (int a = 0; a < 2; ++a)
#pragma unroll
        for (int b = 0; b < 2; ++b)
#pragma unroll
            for (int m = 0; m < 4; ++m)
#pragma unroll
                for (int n = 0; n < 2; ++n) acc[a][b][m][n] = (f32x4){0.f, 0.f, 0.f, 0.f};
    bf16x8 At[4][2], B0[2][2], B1[2][2];
    const char* cA = (const char*)g.A + (size_t)cur.pm * tstep; const char* cB = (const char*)g.Bt + (size_t)cur.pn * tstep;
    S.a_ready(cur);
    if constexpr (SP2) {
        PG8_STAGE(PG8_SB(0, 0), cB, voffB); PG8_STAGE(PG8_SB(0, 1), cB + hstep, voffB); PG8_STAGE(PG8_SA(0, 0), cA, voffA); PG8_STAGE(PG8_SA(0, 1), cA + hstep, voffA);
        if (wr == 1) PG8_BAR;
        PG8_WAIT_V(2); PG8_BAR;
        PG8_STAGE(PG8_SB(1, 0), cB + kstep, voffB); PG8_STAGE(PG8_SA(1, 0), cA + kstep, voffA); PG8_STAGE(PG8_SB(1, 1), cB + hstep + kstep, voffB);
        PG8_WAIT_V(6); PG8_BAR;
    } else {
        PG8_STAGE(PG8_SB(0, 0), cB, voffB); PG8_STAGE(PG8_SA(0, 0), cA, voffA); PG8_STAGE(PG8_SB(0, 1), cB + hstep, voffB); PG8_STAGE(PG8_SA(0, 1), cA + hstep, voffA);
        if (wr == 1) PG8_BAR;
        PG8_WAIT_V(4); PG8_BAR;
        PG8_STAGE(PG8_SB(1, 0), cB + kstep, voffB); PG8_STAGE(PG8_SA(1, 0), cA + kstep, voffA); PG8_STAGE(PG8_SB(1, 1), cB + hstep + kstep, voffB);
        PG8_WAIT_V(6); PG8_BAR;
    }
    for (;;) {
        const bool has_next = S.next(ui + 1, nxt);
        const char* nA = has_next ? (const char*)g.A + (size_t)nxt.pm * tstep : cA; const char* nB = has_next ? (const char*)g.Bt + (size_t)nxt.pn * tstep : cB;
        for (int t = 0; t < nt; t += 2) {
            const bool last = (t == nt - 2);
            const char* a1 = cA + (size_t)(t + 1) * kstep;
            const char* a2 = last ? nA : cA + (size_t)(t + 2) * kstep; const char* b2 = last ? nB : cB + (size_t)(t + 2) * kstep;
            const char* a3 = a2 + kstep; const char* b3 = b2 + kstep;
            if (last && has_next) S.a_ready(nxt);
            if constexpr (SP2) {
            PG8_LDB(B0, 0, 0); PG8_LDB(B1, 0, 1); PG8_SCHED; PG8_LDA(At, 0, 0); PG8_STAGE(PG8_SA(1, 1), a1 + hstep, voffA);
            PG8_WAIT_V(8); PG8_WAIT_L(0); PG8_BAR; PG8_MMA(0, 0, At, B0); PG8_MMA(0, 1, At, B1); PG8_BAR; PG8_SCHED;
            PG8_LDA(At, 0, 1); PG8_STAGE(PG8_SB(0, 0), b2, voffB); PG8_STAGE(PG8_SB(0, 1), b2 + hstep, voffB); PG8_STAGE(PG8_SA(0, 0), a2, voffA);
            PG8_WAIT_V(8); PG8_WAIT_L(0); PG8_BAR; PG8_MMA(1, 0, At, B0); PG8_MMA(1, 1, At, B1); PG8_BAR; PG8_SCHED;
            PG8_LDB(B0, 1, 0); PG8_LDB(B1, 1, 1); PG8_SCHED; PG8_LDA(At, 1, 0); PG8_STAGE(PG8_SA(0, 1), a2 + hstep, voffA);
            PG8_WAIT_V(8); PG8_WAIT_L(0); PG8_BAR; PG8_MMA(0, 0, At, B0); PG8_MMA(0, 1, At, B1); PG8_BAR; PG8_SCHED;
            PG8_LDA(At, 1, 1); PG8_STAGE(PG8_SB(1, 0), b3, voffB); PG8_STAGE(PG8_SB(1, 1), b3 + hstep, voffB); PG8_STAGE(PG8_SA(1, 0), a3, voffA);
            PG8_WAIT_V(8); PG8_WAIT_L(0); PG8_BAR; PG8_MMA(1, 0, At, B0); PG8_MMA(1, 1, At, B1); PG8_BAR; PG8_SCHED;
            } else {
            PG8_LDB(B0, 0, 0); PG8_SCHED; PG8_LDA(At, 0, 0); PG8_STAGE(PG8_SA(1, 1), a1 + hstep, voffA);
            PG8_WAIT_L(8); PG8_BAR; PG8_WAIT_L(0); PG8_MMA(0, 0, At, B0); PG8_BAR; PG8_SCHED;
            PG8_LDB(B1, 0, 1); PG8_STAGE(PG8_SB(0, 0), b2, voffB);
            PG8_BAR; PG8_WAIT_L(0); PG8_MMA(0, 1, At, B1); PG8_BAR;
            PG8_LDA(At, 0, 1); PG8_STAGE(PG8_SA(0, 0), a2, voffA);
            PG8_BAR; PG8_WAIT_L(0); PG8_MMA(1, 0, At, B0); PG8_BAR; PG8_SCHED;
            PG8_STAGE(PG8_SB(0, 1), b2 + hstep, voffB);
            PG8_WAIT_V(6); PG8_BAR; PG8_MMA(1, 1, At, B1); PG8_BAR;
            PG8_LDB(B0, 1, 0); PG8_SCHED; PG8_LDA(At, 1, 0); PG8_STAGE(PG8_SA(0, 1), a2 + hstep, voffA);
            PG8_WAIT_L(8); PG8_BAR; PG8_WAIT_L(0); PG8_MMA(0, 0, At, B0); PG8_BAR; PG8_SCHED;
            PG8_LDB(B1, 1, 1); PG8_STAGE(PG8_SB(1, 0), b3, voffB);
            PG8_BAR; PG8_WAIT_L(0); PG8_MMA(0, 1, At, B1); PG8_BAR;
            PG8_LDA(At, 1, 1); PG8_STAGE(PG8_SA(1, 0), a3, voffA);
            PG8_BAR; PG8_WAIT_L(0); PG8_MMA(1, 0, At, B0); PG8_BAR; PG8_SCHED;
            PG8_STAGE(PG8_SB(1, 1), b3 + hstep, voffB);
            PG8_WAIT_V(6); PG8_BAR; PG8_MMA(1, 1, At, B1); PG8_BAR;
            }
        }
        if constexpr (ALIGN_EPI) { if (wr == 0) PG8_BAR; }
        if constexpr (!Epi::AFTER_DRAIN) { E(acc, cur, wr, wc, fr, fq); S.done(cur); }
        if (!has_next) break;
#pragma unroll
        for (int a = 0; a < 2; ++a)
#pragma unroll
            for (int b = 0; b < 2; ++b)
#pragma unroll
                for (int m = 0; m < 4; ++m)
#pragma unroll
                    for (int n = 0; n < 2; ++n) acc[a][b][m][n] = (f32x4){0.f, 0.f, 0.f, 0.f};
        cur = nxt; cA = nA; cB = nB; ++ui;
        if constexpr (ALIGN_EPI) { if (wr == 1) PG8_BAR; }
    }
    PG8_WAIT_V(0);
    if constexpr (!ALIGN_EPI) { if (wr == 0) PG8_BAR; }
    PG8_BAR;
    if constexpr (Epi::AFTER_DRAIN) { E.fused(acc, cur, wr, wc, fr, fq, lds, wid, lane); S.done(cur); }
#undef PG8_SA
#undef PG8_SB
#undef PG8_STAGE
#undef PG8_LDA
#undef PG8_LDB
#undef PG8_MMA
#undef PG8_WAIT_V
#undef PG8_WAIT_L
#undef PG8_BAR
#undef PG8_SCHED
}
}
__device__ __forceinline__ unsigned cvt_pk(float lo, float hi) { return pg8::cvt_pk_bf16(lo, hi); }
struct EpiStoreBf16 {
    static constexpr bool PERM = true, AFTER_DRAIN = false;
    bf16_t* O; int ldc;
    __device__ __forceinline__ void operator()(const f32x4 (&acc)[2][2][4][2], const pg8::Unit& u, int wr, int wc, int fr, int fq) const {
        const int row0 = u.pm * 256 + wr * 64 + fr, col0 = u.pn * 256 + wc * 32 + 8 * fq;
#pragma unroll
        for (int ai = 0; ai < 2; ++ai)
#pragma unroll
            for (int m = 0; m < 4; ++m) { bf16_t* rowp = O + (size_t)(row0 + ai * 128 + m * 16) * ldc + col0;
#pragma unroll
                for (int bj = 0; bj < 2; ++bj) { const f32x4 v0 = acc[ai][bj][m][0], v1 = acc[ai][bj][m][1];
                    u32x4 w; w.x = cvt_pk(v0[0], v0[1]); w.y = cvt_pk(v0[2], v0[3]); w.z = cvt_pk(v1[0], v1[1]); w.w = cvt_pk(v1[2], v1[3]);
                    *(u32x4*)(rowp + bj * 128) = w; } }
    }
};
struct EpiStoreL0 {
    static constexpr bool PERM = true, AFTER_DRAIN = false;
    bf16_t* UT; bf16_t* UA;
    __device__ __forceinline__ void operator()(const f32x4 (&acc)[2][2][4][2], const pg8::Unit& u, int wr, int wc, int fr, int fq) const {
        const int row0 = u.pm * 256 + wr * 64 + fr, col0 = u.pn * 256 + wc * 32 + 8 * fq;
        if (u.pn < 6) {
#pragma unroll
            for (int bj = 0; bj < 2; ++bj)
#pragma unroll
                for (int n = 0; n < 2; ++n)
#pragma unroll
                    for (int j = 0; j < 4; ++j) { bf16_t* cp = UT + (size_t)(col0 + bj * 128 + 4 * n + j) * MALL + row0;
#pragma unroll
                        for (int ai = 0; ai < 2; ++ai)
#pragma unroll
                            for (int m = 0; m < 4; ++m) cp[ai * 128 + m * 16] = (bf16_t)(cvt_pk(acc[ai][bj][m][n][j], 0.f) & 0xffffu); }
        } else {
#pragma unroll
            for (int ai = 0; ai < 2; ++ai)
#pragma unroll
                for (int m = 0; m < 4; ++m) { bf16_t* rowp = UA + (size_t)(row0 + ai * 128 + m * 16) * 1536 + (col0 - 1536);
#pragma unroll
                    for (int bj = 0; bj < 2; ++bj) { const f32x4 v0 = acc[ai][bj][m][0], v1 = acc[ai][bj][m][1];
                        u32x4 w; w.x = cvt_pk(v0[0], v0[1]); w.y = cvt_pk(v0[2], v0[3]); w.z = cvt_pk(v1[0], v1[1]); w.w = cvt_pk(v1[2], v1[3]);
                        *(u32x4*)(rowp + bj * 128) = w; } }
        }
    }
};
struct EpiResid {
    static constexpr bool PERM = false, AFTER_DRAIN = false;
    const float* sl; const float* sc; float* hl; float* hc; const float* mod; int g_off;
    __device__ __forceinline__ void operator()(const f32x4 (&acc)[2][2][4][2], const pg8::Unit& u, int wr, int wc, int fr, int fq) const {
        const int rowt = u.pm * 256; const int col0 = u.pn * 256 + wc * 32 + 4 * fq;
        const size_t boff = rowt < MLAT ? (size_t)rowt * D : (size_t)(rowt - MLAT) * D;
        const float* sbase = (rowt < MLAT ? sl : sc) + boff; float* dbase = (rowt < MLAT ? hl : hc) + boff;
        const float* g = mod + (size_t)(rowt < MLAT ? rowt / S : 8) * 6144 + g_off + col0;
        f32x4 gv[2][2];
#pragma unroll
        for (int bj = 0; bj < 2; ++bj)
#pragma unroll
            for (int n = 0; n < 2; ++n) gv[bj][n] = *(const f32x4*)(g + bj * 128 + n * 16);
#pragma unroll
        for (int ai = 0; ai < 2; ++ai)
#pragma unroll
            for (int m = 0; m < 4; ++m) { const size_t ro = (size_t)(ai * 128 + wr * 64 + m * 16 + fr) * D + col0;
#pragma unroll
                for (int bj = 0; bj < 2; ++bj)
#pragma unroll
                    for (int n = 0; n < 2; ++n) { *(f32x4*)(dbase + ro + bj * 128 + n * 16) = *(const f32x4*)(sbase + ro + bj * 128 + n * 16) + gv[bj][n] * acc[ai][bj][m][n]; } }
    }
};

DI void p0_tr(const float* W, int N, int K, int k0, int n0, bf16_t* dst, float* scr, int lane) {
    float tmp[32];
#pragma unroll
    for (int i = 0; i < 32; ++i) tmp[i] = W[(size_t)(k0 + 2 * i + (lane >> 5)) * N + n0 + (lane & 31)];
#pragma unroll
    for (int i = 0; i < 32; ++i) scr[(2 * i + (lane >> 5)) * 33 + (lane & 31)] = tmp[i];
    __builtin_amdgcn_wave_barrier(); asm volatile("s_waitcnt lgkmcnt(0)" ::: "memory");
    const int c = lane & 7;
#pragma unroll
    for (int j = 0; j < 4; ++j) { const int n = (lane >> 3) + 8 * j; const float* s = scr + (8 * c) * 33 + n;
        u32x4 o; o.x = cvt_pk(s[0 * 33], s[1 * 33]); o.y = cvt_pk(s[2 * 33], s[3 * 33]); o.z = cvt_pk(s[4 * 33], s[5 * 33]); o.w = cvt_pk(s[6 * 33], s[7 * 33]);
        *(u32x4*)(dst + (size_t)n * K + k0 + 8 * c) = o; }
    __builtin_amdgcn_wave_barrier(); asm volatile("s_waitcnt lgkmcnt(0)" ::: "memory");
}
DI void p0_transpose_item(const float* W, int K, int N, bf16_t* WT, float* scr, int item, int lane) {
    const int nblk = N / 32, kb = item / nblk, nbk = item % nblk;
    p0_tr(W, N, K, 64 * kb, 32 * nbk, WT + (size_t)(32 * nbk) * K, scr, lane);
}
DI void ph_moe_convert(const Args& a, float* lds, int bid, int nb, int l) {
    const int tid = otid(); const int lane = tid & 63, wv = tid >> 6;
    float* scr = lds + wv * (64 * 33);
    __syncthreads();
    for (int it = bid * NWAVES + wv; it < 32 * 384; it += nb * NWAVES) {
        const int e = it / 384, r = it % 384, le = l * 32 + e;
        if (r < 256) { const int up = r >> 7, q = r & 127, kb = q >> 3, nbk = q & 7, n0 = 32 * nbk;
            const float* W = a.in[up ? I_MWU : I_MWG] + (size_t)le * D * 256;
            bf16_t* dst = (bf16_t*)(a.ws + WS_MW1) + ((size_t)e * 512 + (n0 >> 7) * 256 + up * 128 + (n0 & 127)) * D;
            p0_tr(W, 256, D, 64 * kb, n0, dst, scr, lane);
        } else { const int q = r - 256, kb = q >> 5, nbk = q & 31, n0 = 32 * nbk;
            const float* W = a.in[I_MWD] + (size_t)le * 256 * D;
            bf16_t* dst = (bf16_t*)(a.ws + WS_MW2) + ((size_t)e * 1024 + n0) * 256;
            p0_tr(W, D, 256, 64 * kb, n0, dst, scr, lane);
        }
    }
    __syncthreads();
}
DI void ph_init(const Args& a, float* lds, int bid, int nb) {
    const int tid = otid();
    float* mod = (float*)(a.ws + WS_MOD);
    float* sv = lds;
    float* red = lds + 9 * 1024;
    for (int i = tid; i < 9 * 1024; i += NTHR) { const int r = i >> 10, k = i & 1023; const float x = r < 8 ? a.in[I_C][r * D + k] : a.in[I_CCTX][k]; sv[i] = silu_f(x); }
    __syncthreads();
    for (int it = bid; it < 2 * 96; it += nb) {
        const int l = it / 96, n0 = (it % 96) * 64;
        const int cg = tid & 15, kr = tid >> 4;
        float acc[9][4];
#pragma unroll
        for (int r = 0; r < 9; ++r) { acc[r][0] = acc[r][1] = acc[r][2] = acc[r][3] = 0.f; }
        const float* W = a.in[I_ADAW] + (size_t)l * D * 6144 + n0 + cg * 4;
#pragma unroll 2
        for (int k = kr; k < D; k += 32) {
            const f32x4 w = *(const f32x4*)(W + (size_t)k * 6144);
#pragma unroll
            for (int r = 0; r < 9; ++r) { const float s = sv[r * 1024 + k]; acc[r][0] += s * w.x; acc[r][1] += s * w.y; acc[r][2] += s * w.z; acc[r][3] += s * w.w; }
        }
#pragma unroll
        for (int r = 0; r < 9; ++r)
#pragma unroll
            for (int j = 0; j < 4; ++j) red[(kr * 9 + r) * 64 + cg * 4 + j] = acc[r][j];
        __syncthreads();
        for (int o = tid; o < 9 * 64; o += NTHR) {
            const int r = o >> 6, c = o & 63; float s = 0.f;
#pragma unroll 4
            for (int q = 0; q < 32; ++q) s += red[(q * 9 + r) * 64 + c];
            mod[((size_t)l * 9 + r) * 6144 + n0 + c] = s + a.in[I_ADAB][l * 6144 + n0 + c];
        }
        __syncthreads();
    }
    {
        float* z = lds;
        float* h1 = lds + 64;
        float* h2 = lds + 128;
        const float* w1 = a.in[I_HYW1]; const float* b1 = a.in[I_HYB1]; const float* w2 = a.in[I_HYW2]; const float* b2 = a.in[I_HYB2];
        const float* w3 = a.in[I_HYW3]; const float* fr = a.in[I_HYFREQ];
        __syncthreads();
        for (int it = bid; it < S + C; it += nb) {
            const bool lat = it < S; const int L = lat ? S : C; const int lag = lat ? it : it - S;
            const float t = (float)lag / (float)(L - 1);
            const float w = (6.283185307179586f / (float)L) * (float)lag;
            if (tid < 33) {
                float v;
                if (tid == 0) v = t;
                else { const int i = (tid - 1) & 15; const float fb = 1e-4f + (float)i * ((15.f - 1e-4f) / 15.f); v = (tid <= 16) ? cosf(fb * w) : -sinf(fb * w); }
                z[tid] = v;
            }
            __syncthreads();
            if (tid < 64) { float s = b1[tid];
#pragma unroll 1
                for (int i = 0; i < 33; ++i) s += z[i] * w1[i * 64 + tid]; h1[tid] = sinf(fr[tid] * s); }
            __syncthreads();
            if (tid < 64) { float s = b2[tid];
#pragma unroll 4
                for (int i = 0; i < 64; ++i) s += h1[i] * w2[i * 64 + tid]; h2[tid] = sinf(fr[64 + tid] * s); }
            __syncthreads();
            for (int o = tid; o < 2048; o += NTHR) {
                float s = 0.f;
#pragma unroll 8
                for (int i = 0; i < 64; ++i) s += h2[i] * w3[i * 2048 + o];
                const int ord = o >> 10, dir = (o >> 9) & 1, ch = o & 511;
                const float dmin = -3.0701134573253945f, dmax = -15.350567286626973f;
                const float delta = fabsf(dmin + (dmax - dmin) * ((float)ch / 511.f));
                s *= expf(-t * delta);
                if (lat) { float* g = (float*)(a.ws + WS_HFL) + ((size_t)ord * 512 + ch) * 4096;
                    if (dir == 0) g[2047 + lag] = s; else if (lag > 0) g[2047 - lag] = s; }
                else { float* g = (float*)(a.ws + WS_HFC) + ((size_t)ord * 512 + ch) * 512;
                    if (dir == 0) g[255 + lag] = s; else if (lag > 0) g[255 - lag] = s; }
            }
            __syncthreads();
        }
    }
    { float* ax = (float*)(a.ws + WS_TRIG); float* r1 = ax + 2048;
      for (int i = bid * NTHR + tid; i < 1024 + S * 64; i += nb * NTHR) {
          if (i < 1024) { const int pos = i >> 4, f = i & 15; const float ang = (float)pos * exp2f(-(float)f * (13.287712379549449f / 16.f)); ax[i] = cosf(ang); ax[1024 + i] = sinf(ang); }
          else { const int q = i - 1024, t = q >> 6, f = q & 63; const float ang = (float)t * exp2f(-(float)f * (13.287712379549449f / 63.f)); r1[q] = cosf(ang); r1[S * 64 + q] = sinf(ang); } } }
    {
        __syncthreads();
        const int lane = tid & 63, wv = tid >> 6;
        float* scr = lds + wv * (64 * 33);
        constexpr int I_A = (D / 64) * (E_IN / 32), I_B = (D / 64) * (D / 32), I_C2 = (D / 64) * (O_IN / 32);
        constexpr int NIT = I_A + I_B + I_C2 + I_B;
        for (int it = bid * NWAVES + wv; it < NIT; it += nb * NWAVES) {
            int r = it;
            if (r < I_A) { p0_transpose_item(a.in[I_EWIN], D, E_IN, (bf16_t*)(a.ws + WS_WEIN), scr, r, lane); continue; } r -= I_A;
            if (r < I_B) { p0_transpose_item(a.in[I_EWOUT], D, D, (bf16_t*)(a.ws + WS_WEOUT), scr, r, lane); continue; } r -= I_B;
            if (r < I_C2) { p0_transpose_item(a.in[I_OWIN], D, O_IN, (bf16_t*)(a.ws + WS_WOIN), scr, r, lane); continue; } r -= I_C2;
            p0_transpose_item(a.in[I_OWOUT], D, D, (bf16_t*)(a.ws + WS_WOOUT), scr, r, lane);
        }
    }
    ph_moe_convert(a, lds, bid, nb, 0);
}

DI const float* row_ptr(const Args& a, int m) { return m < MLAT ? a.out + (size_t)m * D : (const float*)(a.ws + WS_HC) + (size_t)(m - MLAT) * D; }
DI float* row_ptr_w(const Args& a, int m) { return m < MLAT ? a.out + (size_t)m * D : (float*)(a.ws + WS_HC) + (size_t)(m - MLAT) * D; }
DI int mod_row(int m) { return m < MLAT ? m / S : 8; }
DI void ph_norm(const Args& a, int bid, int nb, int nrows, const float* mod, int sh_off, int sc_off, const float* srcl, const float* srcc) {
    const int tid = otid(); const int lane = tid & 63, wv = tid >> 6;
    bf16_t* XN = (bf16_t*)(a.ws + WS_XN);
    for (int m = bid * NWAVES + wv; m < nrows; m += nb * NWAVES) {
        const f32x4* r = (const f32x4*)(m < MLAT ? srcl + (size_t)m * D : srcc + (size_t)(m - MLAT) * D); f32x4 v[4]; float s = 0.f;
#pragma unroll
        for (int j = 0; j < 4; ++j) { v[j] = r[lane + 64 * j]; s += v[j].x * v[j].x + v[j].y * v[j].y + v[j].z * v[j].z + v[j].w * v[j].w; }
        s = wave_sum(s);
        const float rs = 1.f / sqrtf(s * (1.f / D) + EPS);
        const float* mr = mod + (size_t)mod_row(m) * 6144;
        u32x2* o = (u32x2*)(XN + (size_t)m * D);
#pragma unroll
        for (int j = 0; j < 4; ++j) { const f32x4 sh = *(const f32x4*)(mr + sh_off + 4 * (lane + 64 * j)), sc = *(const f32x4*)(mr + sc_off + 4 * (lane + 64 * j));
            u32x2 w; w.x = pk2(v[j].x * rs * (1.f + sc.x) + sh.x, v[j].y * rs * (1.f + sc.y) + sh.y); w.y = pk2(v[j].z * rs * (1.f + sc.z) + sh.z, v[j].w * rs * (1.f + sc.w) + sh.w);
            o[lane + 64 * j] = w; }
    }
}

DI void axial_rope64(float& v, int lane, int t, const float* ax) {
    const int axis = lane >> 5, half = (lane >> 4) & 1, f = lane & 15;
    const int pos = axis == 0 ? (t >> 6) : (t & 63);
    const float c = ax[pos * 16 + f], s = ax[1024 + pos * 16 + f];
    const float other = __shfl_xor(v, 16);
    v = half == 0 ? (v * c - other * s) : (v * c + other * s);
}
constexpr int NPOS = C + S;
DI int pos_row(int b, int p) { return p < C ? MLAT + b * C + p : b * S + (p - C); }
struct V8 { float v[8]; };
DI V8 ld8bf(const bf16_t* p) { const u32x4 w = *(const u32x4*)p; V8 r; r.v[0] = __uint_as_float(w.x << 16); r.v[1] = __uint_as_float(w.x & 0xffff0000u); r.v[2] = __uint_as_float(w.y << 16); r.v[3] = __uint_as_float(w.y & 0xffff0000u);
    r.v[4] = __uint_as_float(w.z << 16); r.v[5] = __uint_as_float(w.z & 0xffff0000u); r.v[6] = __uint_as_float(w.w << 16); r.v[7] = __uint_as_float(w.w & 0xffff0000u); return r; }
DI void st8bf(bf16_t* p, const V8& x) { u32x4 w; w.x = cvt_pk(x.v[0], x.v[1]); w.y = cvt_pk(x.v[2], x.v[3]); w.z = cvt_pk(x.v[4], x.v[5]); w.w = cvt_pk(x.v[6], x.v[7]); *(u32x4*)p = w; }
DI void chunk_norm_rope(V8& x, const float* gain8, int lane, int t, const float* ax, float scale) {
    float ss = 0.f;
#pragma unroll
    for (int i = 0; i < 8; ++i) ss += x.v[i] * x.v[i];
    ss += __shfl_xor(ss, 1); ss += __shfl_xor(ss, 2); ss += __shfl_xor(ss, 4);
    const float rs = (1.f / sqrtf(ss * (1.f / 64.f) + EPS)) * scale;
#pragma unroll
    for (int i = 0; i < 8; ++i) x.v[i] *= rs * gain8[i];
    if (t >= 0) {
        const int l7 = lane & 7, axis = l7 >> 2, half = (l7 >> 1) & 1, f0 = 8 * (l7 & 1); const int pos = axis == 0 ? (t >> 6) : (t & 63);
        const f32x4 c0 = *(const f32x4*)(ax + pos * 16 + f0), c1 = *(const f32x4*)(ax + pos * 16 + f0 + 4), s0 = *(const f32x4*)(ax + 1024 + pos * 16 + f0), s1 = *(const f32x4*)(ax + 1024 + pos * 16 + f0 + 4);
        const float cc[8] = {c0.x, c0.y, c0.z, c0.w, c1.x, c1.y, c1.z, c1.w}, sn[8] = {s0.x, s0.y, s0.z, s0.w, s1.x, s1.y, s1.z, s1.w};
#pragma unroll
        for (int i = 0; i < 8; ++i) { const float o = __shfl_xor(x.v[i], 2); x.v[i] = half == 0 ? (x.v[i] * cc[i] - o * sn[i]) : (x.v[i] * cc[i] + o * sn[i]); }
    }
}
DI void ph_prep0(const Args& a, float* lds, int bid, int nb) {
    const int tid = otid(); const int lane = tid & 63, wv = tid >> 6;
    const bf16_t* U = (const bf16_t*)(a.ws + WS_UA);
    bf16_t* QP = (bf16_t*)(a.ws + WS_XN); bf16_t* KP = (bf16_t*)(a.ws + WS_ATT); bf16_t* VT = KP + (size_t)32 * 2 * NPOS * 64;
    bf16_t* vs = (bf16_t*)lds;
    const float* axt = (const float*)(a.ws + WS_TRIG);
    float gq8[8], gk8[8];
#pragma unroll
    for (int i = 0; i < 8; ++i) { gq8[i] = a.in[I_DAQN][8 * (lane & 7) + i]; gk8[i] = a.in[I_DAKN][8 * (lane & 7) + i]; }
    const int hd = lane >> 4, map = (lane >> 3) & 1, e0 = 8 * (lane & 7);
    for (int it = bid; it < NB * 72; it += nb) {
        const int b = it / 72, ch = it % 72, p0 = ch * 32;
        __syncthreads();
#pragma unroll
        for (int i = 0; i < 4; ++i) { const int c = tid + 512 * i, pp = c >> 6, part = c & 63;
            const u32x4 w = *(const u32x4*)(U + (size_t)pos_row(b, p0 + pp) * 1536 + 1024 + part * 8);
            unsigned* d = (unsigned*)(vs + pp * 514 + part * 8); d[0] = w.x; d[1] = w.y; d[2] = w.z; d[3] = w.w; }
        V8 xq[4], xk[4];
#pragma unroll
        for (int q = 0; q < 4; ++q) { const bf16_t* ur = U + (size_t)pos_row(b, p0 + wv + 8 * q) * 1536 + 8 * lane; xq[q] = ld8bf(ur); xk[q] = ld8bf(ur + 512); }
#pragma unroll
        for (int q = 0; q < 4; ++q) { const int p = p0 + wv + 8 * q; const int t = p >= C ? p - C : -1;
            chunk_norm_rope(xq[q], gq8, lane, t, axt, 0.125f * 1.4426950408889634f); chunk_norm_rope(xk[q], gk8, lane, t, axt, 1.f);
            const size_t o = ((size_t)((b * 4 + hd) * 2 + map) * NPOS + p) * 64 + e0;
            st8bf(QP + o, xq[q]); st8bf(KP + o, xk[q]); }
        __syncthreads();
        { unsigned w[16];
#pragma unroll
          for (int i = 0; i < 16; ++i) { const unsigned lo = vs[(2 * i) * 514 + tid], hi = vs[(2 * i + 1) * 514 + tid]; w[i] = lo | (hi << 16); }
          u32x4* d = (u32x4*)(VT + ((size_t)(b * 4 + (tid >> 7)) * 128 + (tid & 127)) * NPOS + p0);
#pragma unroll
          for (int i = 0; i < 4; ++i) { u32x4 o = {w[4 * i], w[4 * i + 1], w[4 * i + 2], w[4 * i + 3]}; d[i] = o; } }
    }
}

typedef short bf16x8 __attribute__((ext_vector_type(8)));
typedef short s16x4 __attribute__((ext_vector_type(4)));
typedef float f32x16 __attribute__((ext_vector_type(16)));
#define MFMA32(a, b, c) __builtin_amdgcn_mfma_f32_32x32x16_bf16((a), (b), (c), 0, 0, 0)
DI int crow16(int i, int hh) { return (i & 3) + 8 * (i >> 2) + 4 * hh; }
DI bf16x8 pack8(const f32x16& x, int s) {
    u32x4 p; p.x = cvt_pk(x[8 * s], x[8 * s + 1]); p.y = cvt_pk(x[8 * s + 2], x[8 * s + 3]); p.z = cvt_pk(x[8 * s + 4], x[8 * s + 5]); p.w = cvt_pk(x[8 * s + 6], x[8 * s + 7]);
    return __builtin_bit_cast(bf16x8, p);
}
DI void ph_diffattn(const Args& a, unsigned char* lds, int bid, int nb) {
    const int tid = otid(); const int lane = tid & 63, wv = tid >> 6, q32 = lane & 31, hh = lane >> 5, qsub = wv >> 1, map = wv & 1;
    const bf16_t* QP = (const bf16_t*)(a.ws + WS_XN); const bf16_t* KP = (const bf16_t*)(a.ws + WS_ATT); const bf16_t* VT = KP + (size_t)32 * 2 * NPOS * 64;
    bf16_t* MIX = (bf16_t*)(a.ws + WS_MIX);
    constexpr int KBUF = 2 * 64 * 144, VBUF = 128 * 136, TBUF = KBUF + VBUF;
    unsigned char* xbuf = lds + 2 * TBUF;
    const float* lp = a.in[I_DALAM];
    const float lam_init = 0.2f;
    const float lam = expf(wave_sum(lp[lane] * lp[64 + lane])) - expf(wave_sum(lp[128 + lane] * lp[192 + lane])) + lam_init;
    const bool xg = (nb % 8) == 0 && nb >= 8; const int xq = xg ? bid & 7 : 0, xj = xg ? bid >> 3 : bid, xn = xg ? nb >> 3 : nb, nxu = xg ? 72 : 576;
    for (int ui = xj; ui < nxu; ui += xn) {
        int bh, qb;
        if (xg) { if (ui < 64) { bh = xq + 8 * (ui >> 4); qb = 2 + (ui & 15); } else { bh = xq + 8 * ((ui - 64) >> 1); qb = (ui - 64) & 1; } }
        else { if (ui < 512) { bh = ui >> 4; qb = 2 + (ui & 15); } else { bh = (ui - 512) >> 1; qb = (ui - 512) & 1; } }
        const int b = bh >> 2, h = bh & 3; const int nt = qb < 2 ? 4 : 36;
        bf16x8 qf[4];
        { const bf16_t* qg = QP + ((size_t)(bh * 2 + map) * NPOS + qb * 128 + qsub * 32 + q32) * 64 + 8 * hh;
#pragma unroll
          for (int ks = 0; ks < 4; ++ks) qf[ks] = *(const bf16x8*)(qg + 16 * ks); }
        const bf16_t* Kg = KP + (size_t)(bh * 2) * NPOS * 64; const bf16_t* Vg = VT + (size_t)bh * 128 * NPOS;
        u32x4 st[4];
        auto gload = [&](int t) {
#pragma unroll
            for (int i = 0; i < 2; ++i) { const int c = tid + 512 * i;
                st[i] = *(const u32x4*)(Kg + ((size_t)(c >> 9) * NPOS + t * 64 + ((c >> 3) & 63)) * 64 + (c & 7) * 8);
                st[2 + i] = *(const u32x4*)(Vg + (size_t)(c >> 3) * NPOS + t * 64 + (c & 7) * 8); } };
        auto lstore = [&](int buf) {
            unsigned char* kb = lds + buf * TBUF; unsigned char* vb = kb + KBUF;
#pragma unroll
            for (int i = 0; i < 2; ++i) { const int c = tid + 512 * i;
                *(u32x4*)(kb + (c >> 9) * (64 * 144) + ((c >> 3) & 63) * 144 + (c & 7) * 16) = st[i];
                u32x2* d = (u32x2*)(vb + (c >> 3) * 136 + (c & 7) * 16); u32x2 lo = {st[2 + i].x, st[2 + i].y}, hi = {st[2 + i].z, st[2 + i].w}; d[0] = lo; d[1] = hi; } };
        __syncthreads();
        gload(0); lstore(0);
        __syncthreads();
        f32x16 O[4];
#pragma unroll
        for (int d = 0; d < 4; ++d)
#pragma unroll
            for (int i = 0; i < 16; ++i) O[d][i] = 0.f;
        float m_run = -1e30f, l_run = 0.f;
        for (int t = 0; t < nt; ++t) {
            if (t + 1 < nt) gload(t + 1);
            const unsigned char* kb = lds + (t & 1) * TBUF + map * (64 * 144); const unsigned char* vb = lds + (t & 1) * TBUF + KBUF;
            f32x16 S0, S1;
#pragma unroll
            for (int i = 0; i < 16; ++i) { S0[i] = 0.f; S1[i] = 0.f; }
#pragma unroll
            for (int ks = 0; ks < 4; ++ks) {
                const bf16x8 k0 = *(const bf16x8*)(kb + q32 * 144 + 32 * ks + 16 * hh), k1 = *(const bf16x8*)(kb + (32 + q32) * 144 + 32 * ks + 16 * hh);
                S0 = MFMA32(k0, qf[ks], S0); S1 = MFMA32(k1, qf[ks], S1);
            }
            float mx = S0[0];
#pragma unroll
            for (int i = 1; i < 16; ++i) mx = fmaxf(mx, S0[i]);
#pragma unroll
            for (int i = 0; i < 16; ++i) mx = fmaxf(mx, S1[i]);
            mx = fmaxf(mx, __shfl_xor(mx, 32));
            const float m_new = fmaxf(m_run, mx); const float alpha = __builtin_amdgcn_exp2f(m_run - m_new); m_run = m_new;
            float rsum = 0.f;
#pragma unroll
            for (int i = 0; i < 16; ++i) { S0[i] = __builtin_amdgcn_exp2f(S0[i] - m_new); S1[i] = __builtin_amdgcn_exp2f(S1[i] - m_new); rsum += S0[i] + S1[i]; }
            rsum += __shfl_xor(rsum, 32);
            l_run = l_run * alpha + rsum;
            if (!__all(alpha == 1.f)) {
#pragma unroll
            for (int d = 0; d < 4; ++d)
#pragma unroll
                for (int i = 0; i < 16; ++i) O[d][i] *= alpha; }
            const bf16x8 p00 = pack8(S0, 0), p01 = pack8(S0, 1), p10 = pack8(S1, 0), p11 = pack8(S1, 1);
#pragma unroll
            for (int d = 0; d < 4; ++d) {
                const unsigned char* vr = vb + (32 * d + q32) * 136 + 8 * hh;
                auto vfrag = [&](int koff) { const s16x4 lo = *(const s16x4*)(vr + koff * 2), hi = *(const s16x4*)(vr + koff * 2 + 16); return __builtin_shufflevector(lo, hi, 0, 1, 2, 3, 4, 5, 6, 7); };
                O[d] = MFMA32(vfrag(0), p00, O[d]); O[d] = MFMA32(vfrag(16), p01, O[d]); O[d] = MFMA32(vfrag(32), p10, O[d]); O[d] = MFMA32(vfrag(48), p11, O[d]);
            }
            if (t + 1 < nt) lstore((t + 1) & 1);
            __syncthreads();
        }
        float* xb = (float*)xbuf + qsub * (128 * 32);
        if (map == 1) { const float sc = lam / l_run;
#pragma unroll
            for (int d = 0; d < 4; ++d)
#pragma unroll
                for (int i = 0; i < 16; ++i) xb[(32 * d + crow16(i, hh)) * 32 + q32] = O[d][i] * sc; }
        __syncthreads();
        bf16_t* ob = (bf16_t*)lds;
        if (map == 0) { const float sc = 1.f / l_run; float ss = 0.f;
#pragma unroll
            for (int d = 0; d < 4; ++d)
#pragma unroll
                for (int i = 0; i < 16; ++i) { const float o = O[d][i] * sc - xb[(32 * d + crow16(i, hh)) * 32 + q32]; O[d][i] = o; ss += o * o; }
            ss += __shfl_xor(ss, 32);
            const float rs = (1.f / sqrtf(ss * (1.f / 128.f) + EPS)) * (1.f - lam_init);
#pragma unroll
            for (int d = 0; d < 4; ++d)
#pragma unroll
                for (int i = 0; i < 16; ++i) { const int dv = 32 * d + crow16(i, hh); ob[(qsub * 32 + q32) * 136 + dv] = (bf16_t)f2bf(O[d][i] * rs * a.in[I_DASUB][dv]); } }
        __syncthreads();
#pragma unroll
        for (int i = 0; i < 4; ++i) { const int c = tid + 512 * i, qq = c >> 4, part = c & 15;
            const u32x2* s = (const u32x2*)(ob + qq * 136 + part * 8); const u32x2 lo = s[0], hi = s[1]; u32x4 w = {lo.x, lo.y, hi.x, hi.y};
            *(u32x4*)(MIX + (size_t)pos_row(b, qb * 128 + qq) * D + 512 + h * 128 + part * 8) = w; }
    }
}

template <int L>
DI void hyena_channel(unsigned char* lds, const bf16_t* uv, const bf16_t* ux1, const bf16_t* ux2, int bstride, const float* G0, const float* G1,
                      const float* cw, const float* cb, int ch, float bias0, float bias1, bf16_t* yout) {
    constexpr int NA = L / 32, RS = (L + 192) * 2 + 16, FL = 2 * L + 8, NP = NA / 8;
    unsigned char* bufA = lds; unsigned char* bufB = lds + 8 * RS; unsigned char* bufC = lds + 16 * RS; bf16_t* filt = (bf16_t*)(bufC + 8 * L * 2);
    const int tid = otid(); const int lane = tid & 63, wv = tid >> 6, q32 = lane & 31, hh = lane >> 5;
    __syncthreads();
    for (int c = tid; c < 2 * 8 * 25; c += NTHR) { const int bf = c / 200, r = (c % 200) / 25, k = c % 25;
        unsigned char* row = (bf ? bufB : bufA) + r * RS; u32x4 z = {0u, 0u, 0u, 0u};
        *(u32x4*)(row + (k < 12 ? k * 16 : 192 + L * 2 + (k - 12) * 16)) = z; }
#pragma unroll
    for (int q = 0; q < 3; ++q) {
        const bf16_t* src = q == 0 ? uv : q == 1 ? ux1 : ux2;
        const float w0 = cw[q * 512 + ch], w1 = cw[1536 + q * 512 + ch], w2 = cw[3072 + q * 512 + ch], bb = cb[q * 512 + ch];
        for (int c = tid; c < L; c += NTHR) { const int b = c / (L / 8), tc = (c % (L / 8)) * 8; const bf16_t* sp = src + (size_t)b * bstride + tc;
            const u32x4 w = *(const u32x4*)sp; float x[10];
            x[0] = tc > 0 ? bf2f(sp[-1]) : 0.f; x[9] = tc + 8 < L ? bf2f(sp[8]) : 0.f;
            x[1] = __uint_as_float(w.x << 16); x[2] = __uint_as_float(w.x & 0xffff0000u); x[3] = __uint_as_float(w.y << 16); x[4] = __uint_as_float(w.y & 0xffff0000u);
            x[5] = __uint_as_float(w.z << 16); x[6] = __uint_as_float(w.z & 0xffff0000u); x[7] = __uint_as_float(w.w << 16); x[8] = __uint_as_float(w.w & 0xffff0000u);
            u32x4 o; o.x = pk2(w0 * x[0] + w1 * x[1] + w2 * x[2] + bb, w0 * x[1] + w1 * x[2] + w2 * x[3] + bb); o.y = pk2(w0 * x[2] + w1 * x[3] + w2 * x[4] + bb, w0 * x[3] + w1 * x[4] + w2 * x[5] + bb);
            o.z = pk2(w0 * x[4] + w1 * x[5] + w2 * x[6] + bb, w0 * x[5] + w1 * x[6] + w2 * x[7] + bb); o.w = pk2(w0 * x[6] + w1 * x[7] + w2 * x[8] + bb, w0 * x[7] + w1 * x[8] + w2 * x[9] + bb);
            unsigned char* d = q == 2 ? bufC + (b * L + tc) * 2 : (q == 0 ? bufA : bufB) + b * RS + (96 + tc) * 2;
            *(u32x4*)d = o; }
    }
#pragma unroll 1
    for (int n = 0; n < 2; ++n) {
        __syncthreads();
        { const float* G = n == 0 ? G0 : G1;
          for (int idx = tid; idx < 4 * FL; idx += NTHR) { const int r = idx / FL, k = idx % FL, lag = L - k - r;
              filt[idx] = (bf16_t)((lag > -L && lag < L) ? f2bf(G[lag + L - 1]) : 0u); } }
        __syncthreads();
        const unsigned char* zin = n == 0 ? bufA : bufB;
        const float bias = n == 0 ? bias0 : bias1;
        for (int pr = wv; pr < NP; pr += NWAVES) {
            const int A0 = 8 * pr, bcol = q32 >> 2, al = q32 & 3;
            f32x16 acc0, acc1;
#pragma unroll
            for (int i = 0; i < 16; ++i) { acc0[i] = 0.f; acc1[i] = 0.f; }
            const unsigned char* zrow = zin + bcol * RS + (96 + 32 * al + 8 * hh) * 2;
#pragma unroll 2
            for (int d = A0 - (NA - 1); d <= A0 + 7; ++d) {
                const int X0 = 8 * hh - q32 - 32 * d + L, r = X0 & 3;
                const unsigned char* fp = (const unsigned char*)(filt + r * FL + (X0 - r));
                const s16x4 f0 = *(const s16x4*)fp, f1 = *(const s16x4*)(fp + 8), f2 = *(const s16x4*)(fp + 32), f3 = *(const s16x4*)(fp + 40);
                const bf16x8 a0 = __builtin_shufflevector(f0, f1, 0, 1, 2, 3, 4, 5, 6, 7), a1 = __builtin_shufflevector(f2, f3, 0, 1, 2, 3, 4, 5, 6, 7);
                const int ap0 = A0 - d, ap1 = ap0 + 4;
                if (ap0 >= -3 && ap0 <= NA - 1) { const unsigned char* zp = zrow + ap0 * 64; acc0 = MFMA32(a0, *(const bf16x8*)zp, acc0); acc0 = MFMA32(a1, *(const bf16x8*)(zp + 32), acc0); }
                if (ap1 >= -3 && ap1 <= NA - 1) { const unsigned char* zp = zrow + ap1 * 64; acc1 = MFMA32(a0, *(const bf16x8*)zp, acc1); acc1 = MFMA32(a1, *(const bf16x8*)(zp + 32), acc1); }
            }
#pragma unroll
            for (int hb = 0; hb < 2; ++hb)
#pragma unroll
                for (int i = 0; i < 16; ++i) { const int t = 32 * (A0 + 4 * hb + al) + crow16(i, hh);
                    const float zv = bf2f(*(const bf16_t*)(zin + bcol * RS + (96 + t) * 2));
                    bf16_t* gp = (bf16_t*)(n == 0 ? bufB + bcol * RS + (96 + t) * 2 : bufC + (bcol * L + t) * 2);
                    *gp = (bf16_t)f2bf(bf2f(*gp) * ((hb ? acc1[i] : acc0[i]) + bias * zv)); }
        }
    }
    __syncthreads();
    for (int c = tid; c < L; c += NTHR) { const int b = c / (L / 8), tc = (c % (L / 8)) * 8; *(u32x4*)(yout + (size_t)b * bstride + tc) = *(const u32x4*)(bufC + (b * L + tc) * 2); }
}
DI void ph_hyena(const Args& a, unsigned char* lds, int bid, int nb, bool dummy = false) {
    bf16_t* UT = (bf16_t*)(a.ws + WS_UT);
    const float* cw = a.in[I_HYCW]; const float* cb = a.in[I_HYCB];
    for (int ch = bid; ch < 512; ch += nb) {
        bf16_t* rv = UT + (size_t)ch * MALL; const bf16_t* r1 = UT + (size_t)(512 + ch) * MALL; const bf16_t* r2 = UT + (size_t)(1024 + ch) * MALL;
        const float b0 = a.in[I_HYBIAS][ch], b1 = a.in[I_HYBIAS][512 + ch];
        bf16_t* dm = (bf16_t*)(a.ws + WS_ATT + 38 * MiB) + (size_t)bid * MALL;
        hyena_channel<S>(lds, rv, r1, r2, S, (const float*)(a.ws + WS_HFL) + (size_t)ch * 4096, (const float*)(a.ws + WS_HFL) + (size_t)(512 + ch) * 4096, cw, cb, ch, b0, b1, dummy ? dm : rv);
        hyena_channel<C>(lds, rv + MLAT, r1 + MLAT, r2 + MLAT, C, (const float*)(a.ws + WS_HFC) + (size_t)ch * 512, (const float*)(a.ws + WS_HFC) + (size_t)(512 + ch) * 512, cw, cb, ch, b0, b1, dummy ? dm + MLAT : rv + MLAT);
    }
}
DI void ph_hy_transpose(const Args& a, float* lds, int bid, int nb) {
    const int tid = otid();
    const bf16_t* UT = (const bf16_t*)(a.ws + WS_UT); bf16_t* MIX = (bf16_t*)(a.ws + WS_MIX);
    bf16_t* ts = (bf16_t*)lds;
    for (int it = bid; it < (MALL / 64) * 8; it += nb) {
        const int mt = it >> 3, ct = it & 7, m0 = mt * 64, c0 = ct * 64;
        __syncthreads();
        { const int chl = tid >> 3, part = tid & 7; const u32x4 w = *(const u32x4*)(UT + (size_t)(c0 + chl) * MALL + m0 + part * 8);
          unsigned* d = (unsigned*)(ts + chl * 66 + part * 8); d[0] = w.x; d[1] = w.y; d[2] = w.z; d[3] = w.w; }
        __syncthreads();
        { const int ml = tid >> 3, part = tid & 7; unsigned w[4];
#pragma unroll
          for (int q = 0; q < 4; ++q) { const unsigned lo = ts[(part * 8 + 2 * q) * 66 + ml], hi = ts[(part * 8 + 2 * q + 1) * 66 + ml]; w[q] = lo | (hi << 16); }
          u32x4 o = {w[0], w[1], w[2], w[3]}; *(u32x4*)(MIX + (size_t)(m0 + ml) * D + c0 + part * 8) = o; }
    }
}

constexpr int CW_CNT = 8192;
constexpr int MOE_MAXT = 176;
typedef float f32x16v __attribute__((ext_vector_type(16)));
DI void ph_route(const Args& a, float* lds, int bid, int nb, int l, int nrows, bool dummy = false) {
    const int tid = otid(); const int lane = tid & 63, wv = tid >> 6, i32 = lane & 31, kh = lane >> 5;
    const float* mod = (const float*)(a.ws + WS_MOD) + (size_t)l * 9 * 6144;
    const float* wgrp = a.in[I_MWGRP] + (size_t)l * D * 4; const float* bgrp = a.in[I_MBGRP] + l * 4;
    const float* wrt = a.in[I_MWRT] + (size_t)l * D * 32; const float* brt = a.in[I_MBRT] + l * 32;
    bf16_t* XN = (bf16_t*)(a.ws + WS_XN);
    unsigned* cnt = (unsigned*)(a.ws + WS_CTL) + CW_CNT + (dummy ? 2 : l) * 32 * 64;
    int* tok_e = (int*)(a.ws + (dummy ? WS_ROWW + 256 * 1024 : WS_TOK)); int* tok_pos = tok_e + 2 * MALL; float* tok_w = (float*)(tok_pos + 2 * MALL);
    float* tile = lds + wv * (32 * 33);
    for (int tl = bid * NWAVES + wv; tl < nrows / 32; tl += nb * NWAVES) {
        const int m0 = tl * 32; const float* mr = mod + (size_t)mod_row(m0) * 6144;
        float my_rs = 0.f;
        if (!dummy) {
#pragma unroll 2
        for (int r = 0; r < 32; ++r) {
            const int m = m0 + r; const f32x4* rp = (const f32x4*)row_ptr(a, m); f32x4 v[4]; float s = 0.f;
#pragma unroll
            for (int j = 0; j < 4; ++j) { v[j] = rp[lane + 64 * j]; s += v[j].x * v[j].x + v[j].y * v[j].y + v[j].z * v[j].z + v[j].w * v[j].w; }
            s = wave_sum(s);
            const float rs = 1.f / sqrtf(s * (1.f / D) + EPS);
            if (i32 == r) my_rs = rs;
            u32x2* o = (u32x2*)(XN + (size_t)m * D);
#pragma unroll
            for (int j = 0; j < 4; ++j) { const f32x4 sh = *(const f32x4*)(mr + 3072 + 4 * (lane + 64 * j)), sc = *(const f32x4*)(mr + 4096 + 4 * (lane + 64 * j));
                u32x2 w; w.x = pk2(v[j].x * rs * (1.f + sc.x) + sh.x, v[j].y * rs * (1.f + sc.y) + sh.y); w.y = pk2(v[j].z * rs * (1.f + sc.z) + sh.z, v[j].w * rs * (1.f + sc.w) + sh.w); o[lane + 64 * j] = w; }
        } } else {
#pragma unroll 2
        for (int r = 0; r < 32; ++r) { const f32x4* rp = (const f32x4*)row_ptr(a, m0 + r); float s = 0.f;
#pragma unroll
            for (int j = 0; j < 4; ++j) { const f32x4 v = rp[lane + 64 * j]; s += v.x * v.x + v.y * v.y + v.z * v.z + v.w * v.w; }
            s = wave_sum(s); if (i32 == r) my_rs = 1.f / sqrtf(s * (1.f / D) + EPS); } }
        f32x16v acc;
#pragma unroll
        for (int i = 0; i < 16; ++i) acc[i] = 0.f;
        float g0 = 0.f, g1 = 0.f, g2 = 0.f, g3 = 0.f;
        const int srow = lane >> 3, sf4 = lane & 7;
        float rs_it[4];
#pragma unroll
        for (int it = 0; it < 4; ++it) rs_it[it] = __shfl(my_rs, srow + 8 * it);
#pragma unroll 1
        for (int kc = 0; kc < 32; ++kc) {
            const int k0 = kc * 32 + 4 * sf4;
            const f32x4 sh = *(const f32x4*)(mr + 3072 + k0), sc = *(const f32x4*)(mr + 4096 + k0);
            f32x4 xv[4];
#pragma unroll
            for (int it = 0; it < 4; ++it) xv[it] = *(const f32x4*)(row_ptr(a, m0 + srow + 8 * it) + k0);
            __builtin_amdgcn_wave_barrier();
#pragma unroll
            for (int it = 0; it < 4; ++it) { float* tp = tile + (srow + 8 * it) * 33 + 4 * sf4; const float rs = rs_it[it];
                tp[0] = xv[it].x * rs * (1.f + sc.x) + sh.x; tp[1] = xv[it].y * rs * (1.f + sc.y) + sh.y; tp[2] = xv[it].z * rs * (1.f + sc.z) + sh.z; tp[3] = xv[it].w * rs * (1.f + sc.w) + sh.w; }
            __builtin_amdgcn_wave_barrier();
#pragma unroll
            for (int s = 0; s < 16; ++s) { const int k = kc * 32 + 2 * s + kh;
                const float av = tile[i32 * 33 + 2 * s + kh]; const float bv = wrt[(size_t)k * 32 + i32];
                acc = __builtin_amdgcn_mfma_f32_32x32x2f32(av, bv, acc, 0, 0, 0);
                const f32x4 wg = *(const f32x4*)(wgrp + (size_t)k * 4);
                g0 += av * wg.x; g1 += av * wg.y; g2 += av * wg.z; g3 += av * wg.w; }
        }
        g0 += __shfl_xor(g0, 32); g1 += __shfl_xor(g1, 32); g2 += __shfl_xor(g2, 32); g3 += __shfl_xor(g3, 32);
        g0 += bgrp[0]; g1 += bgrp[1]; g2 += bgrp[2]; g3 += bgrp[3];
        __builtin_amdgcn_wave_barrier();
#pragma unroll
        for (int i = 0; i < 16; ++i) tile[crow16(i, kh) * 33 + i32] = acc[i];
        __builtin_amdgcn_wave_barrier();
        int g = 0; float gm = g0;
        if (g1 > gm) { gm = g1; g = 1; } if (g2 > gm) { gm = g2; g = 2; } if (g3 > gm) { gm = g3; g = 3; }
        const float pg = 1.f / (expf(g0 - gm) + expf(g1 - gm) + expf(g2 - gm) + expf(g3 - gm));
        float le[8];
#pragma unroll
        for (int i = 0; i < 8; ++i) le[i] = tile[i32 * 33 + 8 * g + i] + brt[8 * g + i];
        int e0 = 0; float v0 = le[0];
#pragma unroll
        for (int i = 1; i < 8; ++i) if (le[i] > v0) { v0 = le[i]; e0 = i; }
        int e1 = -1; float v1 = -3.4e38f;
#pragma unroll
        for (int i = 0; i < 8; ++i) if (i != e0 && le[i] > v1) { v1 = le[i]; e1 = i; }
        const float p1 = expf(v1 - v0); const float w0 = pg / (1.f + p1), w1 = pg * p1 / (1.f + p1);
        if (lane < 32) { const int m = m0 + lane;
            const int E0 = g * 8 + e0, E1 = g * 8 + e1;
            const unsigned q0 = __hip_atomic_fetch_add(cnt + E0 * 64, 1u, __ATOMIC_RELAXED, __HIP_MEMORY_SCOPE_AGENT);
            const unsigned q1 = __hip_atomic_fetch_add(cnt + E1 * 64, 1u, __ATOMIC_RELAXED, __HIP_MEMORY_SCOPE_AGENT);
            tok_e[2 * m] = E0; tok_e[2 * m + 1] = E1; tok_pos[2 * m] = (int)q0; tok_pos[2 * m + 1] = (int)q1; tok_w[2 * m] = w0; tok_w[2 * m + 1] = w1;
        }
        __builtin_amdgcn_wave_barrier();
    }
}
DI void moe_tables(const Args& a, int* tab, int l, int tid) {
    const unsigned* cnt = (const unsigned*)(a.ws + WS_CTL) + CW_CNT + l * 32 * 64;
    if (tid == 0) { int t = 0; for (int e = 0; e < 32; ++e) { tab[e] = t; const int c = (int)__hip_atomic_load(cnt + e * 64, __ATOMIC_RELAXED, __HIP_MEMORY_SCOPE_AGENT); const int nt = (c + 255) >> 8; for (int i = 0; i < nt; ++i) tab[33 + t + i] = e; t += nt; } tab[32] = t; }
    __syncthreads();
}
DI void ph_gather(const Args& a, float* lds, int bid, int nb, int l, int nrows) {
    const int tid = otid(); const int lane = tid & 63, wv = tid >> 6;
    int* tab = (int*)(lds + 32768);
    moe_tables(a, tab, l, tid);
    const bf16_t* XN = (const bf16_t*)(a.ws + WS_XN); bf16_t* XS = (bf16_t*)(a.ws + WS_U);
    const int* tok_e = (const int*)(a.ws + WS_TOK); const int* tok_pos = tok_e + 2 * MALL; const float* tok_w = (const float*)(tok_pos + 2 * MALL); int* tok_dst = (int*)(tok_w + 2 * MALL);
    float* roww = (float*)(a.ws + WS_ROWW);
    for (int m = bid * NWAVES + wv; m < nrows; m += nb * NWAVES) {
        const u32x4* src = (const u32x4*)(XN + (size_t)m * D);
        const u32x4 x0 = src[lane], x1 = src[64 + lane];
#pragma unroll
        for (int k = 0; k < 2; ++k) {
            const int e = tok_e[2 * m + k]; const int dst = tab[e] * 256 + tok_pos[2 * m + k];
            u32x4* d = (u32x4*)(XS + (size_t)dst * D); d[lane] = x0; d[64 + lane] = x1;
            if (lane == 0) { roww[dst] = tok_w[2 * m + k]; tok_dst[2 * m + k] = dst; }
        }
    }
}
template <int NPN> struct MoeOrder {
    const int* tab; int G, c;
    __device__ bool next(int i, pg8::Unit& u) const { const int L = i * G + c; if (L >= tab[32] * NPN) return false; u.pm = L / NPN; u.pn = tab[33 + u.pm] * NPN + (L % NPN); return true; }
    __device__ __forceinline__ void a_ready(const pg8::Unit&) const {}
    __device__ __forceinline__ void done(const pg8::Unit&) const {}
};
struct EpiSwiGLU {
    static constexpr bool PERM = true, AFTER_DRAIN = false;
    bf16_t* H; const float* roww;
    __device__ __forceinline__ void operator()(const f32x4 (&acc)[2][2][4][2], const pg8::Unit& u, int wr, int wc, int fr, int fq) const {
        const int row0 = u.pm * 256 + wr * 64 + fr, col0 = (u.pn & 1) * 128 + wc * 32 + 8 * fq;
#pragma unroll
        for (int ai = 0; ai < 2; ++ai)
#pragma unroll
            for (int m = 0; m < 4; ++m) { const int r = row0 + ai * 128 + m * 16; const float w = roww[r];
                float hv[8];
#pragma unroll
                for (int n = 0; n < 2; ++n)
#pragma unroll
                    for (int j = 0; j < 4; ++j) { const float g = acc[ai][0][m][n][j], up = acc[ai][1][m][n][j]; hv[4 * n + j] = g / (1.f + __expf(-g)) * up * w; }
                u32x4 o; o.x = cvt_pk(hv[0], hv[1]); o.y = cvt_pk(hv[2], hv[3]); o.z = cvt_pk(hv[4], hv[5]); o.w = cvt_pk(hv[6], hv[7]);
                *(u32x4*)(H + (size_t)r * 256 + col0) = o; }
    }
};
struct EpiStoreY {
    static constexpr bool PERM = true, AFTER_DRAIN = false;
    bf16_t* O;
    __device__ __forceinline__ void operator()(const f32x4 (&acc)[2][2][4][2], const pg8::Unit& u, int wr, int wc, int fr, int fq) const {
        const int row0 = u.pm * 256 + wr * 64 + fr, col0 = (u.pn & 3) * 256 + wc * 32 + 8 * fq;
#pragma unroll
        for (int ai = 0; ai < 2; ++ai)
#pragma unroll
            for (int m = 0; m < 4; ++m) { bf16_t* rowp = O + (size_t)(row0 + ai * 128 + m * 16) * D + col0;
#pragma unroll
                for (int bj = 0; bj < 2; ++bj) { const f32x4 v0 = acc[ai][bj][m][0], v1 = acc[ai][bj][m][1];
                    u32x4 w; w.x = cvt_pk(v0[0], v0[1]); w.y = cvt_pk(v0[2], v0[3]); w.z = cvt_pk(v1[0], v1[1]); w.w = cvt_pk(v1[2], v1[3]);
                    *(u32x4*)(rowp + bj * 128) = w; } }
    }
};
DI void ph_combine(const Args& a, int bid, int nb, int l, int nrows, bool next_norm) {
    const int tid = otid(); const int lane = tid & 63, wv = tid >> 6;
    const float* mod = (const float*)(a.ws + WS_MOD) + (size_t)l * 9 * 6144; const float* modn = (const float*)(a.ws + WS_MOD) + (size_t)(l + 1) * 9 * 6144;
    const bf16_t* Y = (const bf16_t*)(a.ws + WS_U); bf16_t* XN = (bf16_t*)(a.ws + WS_XN);
    const int* tok_dst = (const int*)(a.ws + WS_TOK) + 6 * MALL;
    for (int m = bid * NWAVES + wv; m < nrows; m += nb * NWAVES) {
        f32x4* r = (f32x4*)row_ptr_w(a, m); const float* mr = mod + (size_t)mod_row(m) * 6144 + 5120;
        const bf16_t* y0 = Y + (size_t)tok_dst[2 * m] * D; const bf16_t* y1 = Y + (size_t)tok_dst[2 * m + 1] * D;
        f32x4 v[4]; float s = 0.f;
#pragma unroll
        for (int j = 0; j < 4; ++j) { const int c4 = lane + 64 * j; const f32x4 g = *(const f32x4*)(mr + 4 * c4); const f32x4 ya = ld4bf(y0 + 4 * c4), yb = ld4bf(y1 + 4 * c4);
            v[j] = r[c4] + g * (ya + yb); r[c4] = v[j]; s += v[j].x * v[j].x + v[j].y * v[j].y + v[j].z * v[j].z + v[j].w * v[j].w; }
        if (next_norm) {
            s = wave_sum(s); const float rs = 1.f / sqrtf(s * (1.f / D) + EPS);
            const float* mn = modn + (size_t)mod_row(m) * 6144; u32x2* o = (u32x2*)(XN + (size_t)m * D);
#pragma unroll
            for (int j = 0; j < 4; ++j) { const f32x4 sh = *(const f32x4*)(mn + 4 * (lane + 64 * j)), sc = *(const f32x4*)(mn + 1024 + 4 * (lane + 64 * j));
                u32x2 w; w.x = pk2(v[j].x * rs * (1.f + sc.x) + sh.x, v[j].y * rs * (1.f + sc.y) + sh.y); w.y = pk2(v[j].z * rs * (1.f + sc.z) + sh.z, v[j].w * rs * (1.f + sc.w) + sh.w);
                o[lane + 64 * j] = w; }
        }
    }
}

constexpr size_t ATT_KR = 0, ATT_VRT = (size_t)32 * NPOS * 128, ATT_GK = 2 * ATT_VRT, ATT_GVT = ATT_GK + (size_t)16 * NPOS * 64;
constexpr size_t XN_QR = 0, XN_GQ = (size_t)32 * S * 128;
DI void rope1d_8(V8& x, int lane, int t, const float* r1t, float scale) {
    const int d0 = 8 * (lane & 15), f0 = d0 & 63; const bool lo = d0 < 64;
    const f32x4 c0 = *(const f32x4*)(r1t + t * 64 + f0), c1 = *(const f32x4*)(r1t + t * 64 + f0 + 4), s0 = *(const f32x4*)(r1t + S * 64 + t * 64 + f0), s1 = *(const f32x4*)(r1t + S * 64 + t * 64 + f0 + 4);
    const float cc[8] = {c0.x, c0.y, c0.z, c0.w, c1.x, c1.y, c1.z, c1.w}, sn[8] = {s0.x, s0.y, s0.z, s0.w, s1.x, s1.y, s1.z, s1.w};
#pragma unroll
    for (int i = 0; i < 8; ++i) { const float o = __shfl_xor(x.v[i], 8); x.v[i] = (lo ? (x.v[i] * cc[i] - o * sn[i]) : (x.v[i] * cc[i] + o * sn[i])) * scale; }
}
DI void ph_prep1(const Args& a, float* lds, int bid, int nb) {
    const int tid = otid(); const int lane = tid & 63, wv = tid >> 6;
    const bf16_t* U = (const bf16_t*)(a.ws + WS_U);
    bf16_t* XNb = (bf16_t*)(a.ws + WS_XN); bf16_t* ATb = (bf16_t*)(a.ws + WS_ATT);
    bf16_t* vs = (bf16_t*)lds;
    const float* axt = (const float*)(a.ws + WS_TRIG); const float* r1t = axt + 2048;
    float gq8[8], gk8[8];
#pragma unroll
    for (int i = 0; i < 8; ++i) { gq8[i] = a.in[I_GQQN][8 * (lane & 7) + i]; gk8[i] = a.in[I_GQKN][8 * (lane & 7) + i]; }
    const float rscale = 0.08838834764831845f;
    for (int it = bid; it < NB * 72; it += nb) {
        const int b = it / 72, ch = it % 72, p0 = ch * 32; const bool lat = p0 >= C;
        __syncthreads();
#pragma unroll
        for (int i = 0; i < 5; ++i) { const int c = tid + 512 * i, pp = c / 80, part = c % 80;
            const u32x4 w = *(const u32x4*)(U + (size_t)pos_row(b, p0 + pp) * O_IN + (part < 64 ? 1024 + part * 8 : 2688 + (part - 64) * 8));
            unsigned* d = (unsigned*)(vs + pp * 642 + part * 8); d[0] = w.x; d[1] = w.y; d[2] = w.z; d[3] = w.w; }
        V8 xq[4], xk[4], xg[4];
#pragma unroll
        for (int q = 0; q < 4; ++q) { const bf16_t* ur = U + (size_t)pos_row(b, p0 + wv + 8 * q) * O_IN + 8 * lane; xk[q] = ld8bf(ur + 512); if (lat) { xq[q] = ld8bf(ur); xg[q] = ld8bf(ur + 2048); } }
        const int pgk = p0 + 4 * wv + (lane >> 4);
        V8 xgk = ld8bf(U + (size_t)pos_row(b, pgk) * O_IN + 2560 + 8 * (lane & 15));
#pragma unroll
        for (int q = 0; q < 4; ++q) { const int p = p0 + wv + 8 * q; const int t = p - C; const int hd = lane >> 4, d0 = 8 * (lane & 15);
            if (lat) { rope1d_8(xk[q], lane, t, r1t, rscale); rope1d_8(xq[q], lane, t, r1t, 1.f);
                st8bf(XNb + XN_QR + ((size_t)(b * 4 + hd) * S + t) * 128 + d0, xq[q]);
                chunk_norm_rope(xg[q], gq8, lane, t, axt, 0.125f * 1.4426950408889634f);
                st8bf(XNb + XN_GQ + ((size_t)(b * 8 + (lane >> 3)) * S + t) * 64 + 8 * (lane & 7), xg[q]); }
            else {
#pragma unroll
                for (int i = 0; i < 8; ++i) xk[q].v[i] *= rscale; }
            st8bf(ATb + ATT_KR + ((size_t)(b * 4 + hd) * NPOS + p) * 128 + d0, xk[q]); }
        chunk_norm_rope(xgk, gk8, lane, lat ? pgk - C : -1, axt, 1.f);
        st8bf(ATb + ATT_GK + ((size_t)(b * 2 + ((lane >> 3) & 1)) * NPOS + pgk) * 64 + 8 * (lane & 7), xgk);
        __syncthreads();
#pragma unroll
        for (int rr = 0; rr < 2; ++rr) { const int r = tid + 512 * rr;
            if (r < 640) { unsigned w[16];
#pragma unroll
                for (int i = 0; i < 16; ++i) { const unsigned lo = vs[(2 * i) * 642 + r], hi = vs[(2 * i + 1) * 642 + r]; w[i] = lo | (hi << 16); }
                bf16_t* dr = r < 512 ? ATb + ATT_VRT + ((size_t)(b * 4 + (r >> 7)) * 128 + (r & 127)) * NPOS : ATb + ATT_GVT + ((size_t)(b * 2 + ((r - 512) >> 6)) * 64 + ((r - 512) & 63)) * NPOS;
                u32x4* d = (u32x4*)(dr + p0);
#pragma unroll
                for (int i = 0; i < 4; ++i) { u32x4 o = {w[4 * i], w[4 * i + 1], w[4 * i + 2], w[4 * i + 3]}; d[i] = o; } } }
    }
}

DI void ph_retention(const Args& a, unsigned char* lds, int bid, int nb) {
    const int tid = otid(); const int lane = tid & 63, wv = tid >> 6, q32 = lane & 31, hh = lane >> 5;
    const bf16_t* XNb = (const bf16_t*)(a.ws + WS_XN); const bf16_t* ATb = (const bf16_t*)(a.ws + WS_ATT);
    const bf16_t* U = (const bf16_t*)(a.ws + WS_U); bf16_t* MIX = (bf16_t*)(a.ws + WS_MIX);
    constexpr int KBUF = 64 * 272, VBUF = 128 * 136, TBUF = KBUF + VBUF;
    const bool xg = (nb % 8) == 0 && nb >= 8; const int xq = xg ? bid & 7 : 0, xj = xg ? bid >> 3 : bid, xn = xg ? nb >> 3 : nb, nxu = xg ? 32 : 256;
    for (int ui = xj; ui < nxu; ui += xn) {
        const int bh = xg ? xq + 8 * (ui >> 3) : ui >> 3, qb = ui & 7, b = bh >> 2, h = bh & 3, T0 = qb * 256;
        const int t = T0 + wv * 32 + q32;
        const float df = a.in[I_RETDEC][h], db = a.in[I_RETDEC][4 + h];
        const float lf = (fminf(df, 0.f) - log1pf(expf(-fabsf(df)))) * 1.4426950408889634f, lb = (fminf(db, 0.f) - log1pf(expf(-fabsf(db)))) * 1.4426950408889634f;
        bf16x8 qf[8];
        { const bf16_t* qg = XNb + XN_QR + ((size_t)bh * S + t) * 128 + 8 * hh;
#pragma unroll
          for (int ks = 0; ks < 8; ++ks) qf[ks] = *(const bf16x8*)(qg + 16 * ks); }
        const bf16_t* Kg = ATb + ATT_KR + (size_t)bh * NPOS * 128; const bf16_t* Vg = ATb + ATT_VRT + (size_t)bh * 128 * NPOS;
        float* tab = (float*)(lds + 2 * TBUF); const f32x4* tabf = (const f32x4*)tab; const f32x4* tabb = (const f32x4*)(tab + 64);
        __syncthreads();
        if (tid < 64) { tab[tid] = __builtin_amdgcn_exp2f(-(float)tid * lf); tab[64 + tid] = __builtin_amdgcn_exp2f((float)tid * lb); }
        u32x4 st[4];
        auto gload = [&](int tt) {
#pragma unroll
            for (int i = 0; i < 2; ++i) { const int c = tid + 512 * i;
                st[i] = *(const u32x4*)(Kg + ((size_t)tt * 64 + (c >> 4)) * 128 + (c & 15) * 8);
                st[2 + i] = *(const u32x4*)(Vg + (size_t)(c >> 3) * NPOS + tt * 64 + (c & 7) * 8); } };
        auto lstore = [&](int buf) {
            unsigned char* kb = lds + buf * TBUF; unsigned char* vb = kb + KBUF;
#pragma unroll
            for (int i = 0; i < 2; ++i) { const int c = tid + 512 * i;
                *(u32x4*)(kb + (c >> 4) * 272 + (c & 15) * 16) = st[i];
                u32x2* d = (u32x2*)(vb + (c >> 3) * 136 + (c & 7) * 16); u32x2 lo = {st[2 + i].x, st[2 + i].y}, hi = {st[2 + i].z, st[2 + i].w}; d[0] = lo; d[1] = hi; } };
        __syncthreads();
        gload(0); lstore(0);
        __syncthreads();
        f32x16 O[4];
#pragma unroll
        for (int d = 0; d < 4; ++d)
#pragma unroll
            for (int i = 0; i < 16; ++i) O[d][i] = 0.f;
        for (int tt = 0; tt < 36; ++tt) {
            if (tt + 1 < 36) gload(tt + 1);
            const unsigned char* kb = lds + (tt & 1) * TBUF; const unsigned char* vb = kb + KBUF;
            f32x16 S0, S1;
#pragma unroll
            for (int i = 0; i < 16; ++i) { S0[i] = 0.f; S1[i] = 0.f; }
#pragma unroll
            for (int ks = 0; ks < 8; ++ks) {
                const bf16x8 k0 = *(const bf16x8*)(kb + q32 * 272 + 32 * ks + 16 * hh), k1 = *(const bf16x8*)(kb + (32 + q32) * 272 + 32 * ks + 16 * hh);
                S0 = MFMA32(k0, qf[ks], S0); S1 = MFMA32(k1, qf[ks], S1);
                if (ks & 1) __builtin_amdgcn_sched_barrier(0);
            }
            const int p0 = tt * 64; const int s0 = p0 - C;
            const int type = tt < 4 ? 0 : (s0 + 64 <= T0 ? 1 : (s0 >= T0 + 256 ? 2 : 3));
            const float bf0 = (float)(t + C - p0 - 4 * hh) * lf;
            const float bb0 = (float)((tt < 4 ? p0 + S : s0) + 4 * hh - t) * lb;
            const float basef = __builtin_amdgcn_exp2f(bf0), baseb = __builtin_amdgcn_exp2f(bb0);
            const int dfl = t - (tt < 4 ? 0 : s0) - 4 * hh;
#pragma unroll
            for (int k = 0; k < 4; ++k) {
                const f32x4 f0 = tabf[2 * k], f1 = tabf[8 + 2 * k], g0 = tabb[2 * k], g1 = tabb[8 + 2 * k];
#pragma unroll
                for (int j = 0; j < 4; ++j) {
                    float w0, w1;
                    if (type == 1) { w0 = basef * f0[j]; w1 = basef * f1[j]; }
                    else if (type == 2) { w0 = baseb * g0[j]; w1 = baseb * g1[j]; }
                    else if (type == 0) { w0 = basef * f0[j] + baseb * g0[j]; w1 = basef * f1[j] + baseb * g1[j]; }
                    else { const int d0 = dfl - (8 * k + j), d1 = d0 - 32;
                        w0 = (d0 >= 0 ? basef * f0[j] : 0.f) + (d0 <= 0 ? baseb * g0[j] : 0.f); w1 = (d1 >= 0 ? basef * f1[j] : 0.f) + (d1 <= 0 ? baseb * g1[j] : 0.f); }
                    S0[4 * k + j] *= w0; S1[4 * k + j] *= w1;
                }
                __builtin_amdgcn_sched_barrier(0);
            }
            __builtin_amdgcn_sched_barrier(0);
            const bf16x8 p00 = pack8(S0, 0), p01 = pack8(S0, 1), p10 = pack8(S1, 0), p11 = pack8(S1, 1);
#pragma unroll
            for (int d = 0; d < 4; ++d) {
                const unsigned char* vr = vb + (32 * d + q32) * 136 + 8 * hh;
                auto vfrag = [&](int koff) { const s16x4 lo = *(const s16x4*)(vr + koff * 2), hi = *(const s16x4*)(vr + koff * 2 + 16); return __builtin_shufflevector(lo, hi, 0, 1, 2, 3, 4, 5, 6, 7); };
                O[d] = MFMA32(vfrag(0), p00, O[d]); O[d] = MFMA32(vfrag(16), p01, O[d]); O[d] = MFMA32(vfrag(32), p10, O[d]); O[d] = MFMA32(vfrag(48), p11, O[d]);
                __builtin_amdgcn_sched_barrier(0);
            }
            if (tt + 1 < 36) lstore((tt + 1) & 1);
            __syncthreads();
        }
        const int tid2 = otid(), q32e = tid2 & 31, hhe = (tid2 >> 5) & 1, wve = tid2 >> 6;
        float sm = 0.f;
#pragma unroll
        for (int d = 0; d < 4; ++d)
#pragma unroll
            for (int i = 0; i < 16; ++i) sm += O[d][i];
        sm += __shfl_xor(sm, 32); const float mu = sm * (1.f / 128.f); float sq = 0.f;
#pragma unroll
        for (int d = 0; d < 4; ++d)
#pragma unroll
            for (int i = 0; i < 16; ++i) { O[d][i] -= mu; sq += O[d][i] * O[d][i]; }
        sq += __shfl_xor(sq, 32); const float rs = 1.f / sqrtf(sq * (1.f / 128.f) + EPS);
        bf16_t* ob = (bf16_t*)lds;
#pragma unroll
        for (int d = 0; d < 4; ++d)
#pragma unroll
            for (int i = 0; i < 16; ++i) ob[(wve * 32 + q32e) * 136 + 32 * d + crow16(i, hhe)] = (bf16_t)f2bf(O[d][i] * rs);
        __syncthreads();
#pragma unroll
        for (int i = 0; i < 8; ++i) { const int c = tid2 + 512 * i, qq = c >> 4, part = c & 15; const int m = b * S + T0 + qq;
            const u32x2* s = (const u32x2*)(ob + qq * 136 + part * 8); const u32x2 lo = s[0], hi = s[1];
            const u32x4 gw = *(const u32x4*)(U + (size_t)m * O_IN + 1536 + h * 128 + part * 8);
            const float* gn = a.in[I_RETGN] + h * 128 + part * 8;
            const unsigned ow[4] = {lo.x, lo.y, hi.x, hi.y}; const unsigned gww[4] = {gw.x, gw.y, gw.z, gw.w}; unsigned r[4];
#pragma unroll
            for (int q = 0; q < 4; ++q) { const float o0 = __uint_as_float(ow[q] << 16), o1 = __uint_as_float(ow[q] & 0xffff0000u), g0 = __uint_as_float(gww[q] << 16), g1 = __uint_as_float(gww[q] & 0xffff0000u);
                r[q] = pk2(o0 * gn[2 * q] * silu_f(g0), o1 * gn[2 * q + 1] * silu_f(g1)); }
            u32x4 w = {r[0], r[1], r[2], r[3]};
            *(u32x4*)(MIX + (size_t)m * D + h * 128 + part * 8) = w; }
    }
}

DI void ph_gqa(const Args& a, unsigned char* lds, int bid, int nb) {
    const int tid = otid(); const int lane = tid & 63, wv = tid >> 6, q32 = lane & 31, hh = lane >> 5, g = wv >> 1, qsub = wv & 1;
    const bf16_t* XNb = (const bf16_t*)(a.ws + WS_XN); const bf16_t* ATb = (const bf16_t*)(a.ws + WS_ATT); bf16_t* MIX = (bf16_t*)(a.ws + WS_MIX);
    constexpr int KBUF = 64 * 144, VBUF = 64 * 136, TBUF = KBUF + VBUF;
    const bool xg = (nb % 8) == 0 && nb >= 8; const int xq = xg ? bid & 7 : 0, xj = xg ? bid >> 3 : bid, xn = xg ? nb >> 3 : nb, nxu = xg ? 64 : 512;
    for (int ui = xj; ui < nxu; ui += xn) {
        const int u = xg ? xq * 64 + ui : ui;
        const int b = u >> 6, kv = (u >> 5) & 1, qblk = u & 31, T0 = qblk * 64; const int hd = kv * 4 + g; const int t = T0 + qsub * 32 + q32;
        const float sink2 = a.in[I_GQSINK][hd] * 1.4426950408889634f;
        bf16x8 qf[4];
        { const bf16_t* qg = XNb + XN_GQ + ((size_t)(b * 8 + hd) * S + t) * 64 + 8 * hh;
#pragma unroll
          for (int ks = 0; ks < 4; ++ks) qf[ks] = *(const bf16x8*)(qg + 16 * ks); }
        const bf16_t* Kg = ATb + ATT_GK + (size_t)(b * 2 + kv) * NPOS * 64; const bf16_t* Vg = ATb + ATT_GVT + (size_t)(b * 2 + kv) * 64 * NPOS;
        auto tile_p = [&](int i) { return i < 4 ? 64 * i : C + T0 - 128 + 64 * (i - 4); };
        auto tile_ok = [&](int i) { if (i < 4) return true; const int s0 = T0 - 128 + 64 * (i - 4); return s0 >= 0 && s0 < S; };
        u32x4 st[2];
        auto gload = [&](int i) { const int p = tile_p(i);
            st[0] = *(const u32x4*)(Kg + ((size_t)p + (tid >> 3)) * 64 + (tid & 7) * 8);
            st[1] = *(const u32x4*)(Vg + (size_t)(tid >> 3) * NPOS + p + (tid & 7) * 8); };
        auto lstore = [&](int buf) {
            unsigned char* kb = lds + buf * TBUF; unsigned char* vb = kb + KBUF;
            *(u32x4*)(kb + (tid >> 3) * 144 + (tid & 7) * 16) = st[0];
            u32x2* d = (u32x2*)(vb + (tid >> 3) * 136 + (tid & 7) * 16); u32x2 lo = {st[1].x, st[1].y}, hi = {st[1].z, st[1].w}; d[0] = lo; d[1] = hi; };
        __syncthreads();
        gload(0); lstore(0);
        __syncthreads();
        f32x16 O[2];
#pragma unroll
        for (int d = 0; d < 2; ++d)
#pragma unroll
            for (int i = 0; i < 16; ++i) O[d][i] = 0.f;
        float m_run = -1e30f, l_run = 0.f;
        int buf = 0;
        for (int ti = 0; ti < 9; ++ti) {
            if (!tile_ok(ti)) continue;
            int nx = ti + 1; while (nx < 9 && !tile_ok(nx)) ++nx;
            if (nx < 9) gload(nx);
            const unsigned char* kb = lds + buf * TBUF; const unsigned char* vb = kb + KBUF;
            f32x16 S0, S1;
#pragma unroll
            for (int i = 0; i < 16; ++i) { S0[i] = 0.f; S1[i] = 0.f; }
#pragma unroll
            for (int ks = 0; ks < 4; ++ks) {
                const bf16x8 k0 = *(const bf16x8*)(kb + q32 * 144 + 32 * ks + 16 * hh), k1 = *(const bf16x8*)(kb + (32 + q32) * 144 + 32 * ks + 16 * hh);
                S0 = MFMA32(k0, qf[ks], S0); S1 = MFMA32(k1, qf[ks], S1);
            }
            if (ti >= 4) {
                const int dl = T0 - 128 + 64 * (ti - 4) + 4 * hh - t;
#pragma unroll
                for (int i = 0; i < 16; ++i) { const int d0 = dl + (i & 3) + 8 * (i >> 2), d1 = d0 + 32;
                    if (d0 < -128 || d0 > 128) S0[i] = -1e30f; if (d1 < -128 || d1 > 128) S1[i] = -1e30f; }
            }
            float mx = S0[0];
#pragma unroll
            for (int i = 1; i < 16; ++i) mx = fmaxf(mx, S0[i]);
#pragma unroll
            for (int i = 0; i < 16; ++i) mx = fmaxf(mx, S1[i]);
            mx = fmaxf(mx, __shfl_xor(mx, 32));
            const float m_new = fmaxf(m_run, mx); const float alpha = __builtin_amdgcn_exp2f(m_run - m_new); m_run = m_new;
            float rsum = 0.f;
#pragma unroll
            for (int i = 0; i < 16; ++i) { S0[i] = __builtin_amdgcn_exp2f(S0[i] - m_new); S1[i] = __builtin_amdgcn_exp2f(S1[i] - m_new); rsum += S0[i] + S1[i]; }
            rsum += __shfl_xor(rsum, 32);
            l_run = l_run * alpha + rsum;
            if (!__all(alpha == 1.f)) {
#pragma unroll
            for (int d = 0; d < 2; ++d)
#pragma unroll
                for (int i = 0; i < 16; ++i) O[d][i] *= alpha; }
            const bf16x8 p00 = pack8(S0, 0), p01 = pack8(S0, 1), p10 = pack8(S1, 0), p11 = pack8(S1, 1);
#pragma unroll
            for (int d = 0; d < 2; ++d) {
                const unsigned char* vr = vb + (32 * d + q32) * 136 + 8 * hh;
                auto vfrag = [&](int koff) { const s16x4 lo = *(const s16x4*)(vr + koff * 2), hi = *(const s16x4*)(vr + koff * 2 + 16); return __builtin_shufflevector(lo, hi, 0, 1, 2, 3, 4, 5, 6, 7); };
                O[d] = MFMA32(vfrag(0), p00, O[d]); O[d] = MFMA32(vfrag(16), p01, O[d]); O[d] = MFMA32(vfrag(32), p10, O[d]); O[d] = MFMA32(vfrag(48), p11, O[d]);
            }
            if (nx < 9) lstore(buf ^ 1);
            buf ^= 1;
            __syncthreads();
        }
        const float il = 1.f / (l_run + __builtin_amdgcn_exp2f(sink2 - m_run));
        bf16_t* ob = (bf16_t*)(lds + 2 * TBUF);
#pragma unroll
        for (int d = 0; d < 2; ++d)
#pragma unroll
            for (int i = 0; i < 16; ++i) ob[(qsub * 32 + q32) * 264 + g * 64 + 32 * d + crow16(i, hh)] = (bf16_t)f2bf(O[d][i] * il);
        __syncthreads();
#pragma unroll
        for (int i = 0; i < 4; ++i) { const int c = tid + 512 * i, qq = c >> 5, part = c & 31;
            const u32x4 w = *(const u32x4*)(ob + qq * 264 + part * 8);
            *(u32x4*)(MIX + (size_t)(b * S + T0 + qq) * D + 512 + kv * 256 + part * 8) = w; }
    }
}

constexpr int N_PHASES = 20;
#ifndef DUPMASK
#define DUPMASK 0u
#endif
#define DUP(k) (((DUPMASK) >> (k)) & 1u)
DI int opq(int v) { asm volatile("" : "+s"(v)); return v; }
template <class Epi> DI void run_gemm(LAS unsigned char* lds, const bf16_t* A, const bf16_t* Bt, int M, int N, int K, const Epi& E) {
    pg8::Gemm g{A, Bt, M, N, opq(K)}; pg8::StaticOrder So; So.init(M, N, (int)gridDim.x, (int)blockIdx.x);
    pg8::gemm_phase<Epi, pg8::StaticOrder, true, true>(lds, g, So, E);
}
DI void moe_gemm1(const Args& a, float* lds, LAS unsigned char* ldsl, int l) {
    int* tab = (int*)(lds + 33792); moe_tables(a, tab, l, otid());
    pg8::Gemm g{(const bf16_t*)(a.ws + WS_U), (const bf16_t*)(a.ws + WS_MW1), MOE_MAXT * 256, 32 * 512, opq(D)};
    MoeOrder<2> So{tab, (int)gridDim.x, (int)blockIdx.x}; EpiSwiGLU E{(bf16_t*)(a.ws + WS_MIX), (const float*)(a.ws + WS_ROWW)};
    pg8::gemm_phase<EpiSwiGLU, MoeOrder<2>, true, true>(ldsl, g, So, E);
}
DI void moe_gemm2(const Args& a, float* lds, LAS unsigned char* ldsl, int l) {
    int* tab = (int*)(lds + 33792); moe_tables(a, tab, l, otid());
    pg8::Gemm g{(const bf16_t*)(a.ws + WS_MIX), (const bf16_t*)(a.ws + WS_MW2), MOE_MAXT * 256, 32 * 1024, opq(256)};
    MoeOrder<4> So{tab, (int)gridDim.x, (int)blockIdx.x}; EpiStoreY E{(bf16_t*)(a.ws + WS_U)};
    pg8::gemm_phase<EpiStoreY, MoeOrder<4>, true, true>(ldsl, g, So, E);
}
__global__ void __launch_bounds__(NTHR, 2) fwd_kernel(Args a) {
    extern __shared__ __attribute__((aligned(16))) unsigned char lds_raw[];
    float* lds = (float*)lds_raw;
    LAS unsigned char* ldsl = (LAS unsigned char*)lds_raw;
    volatile LAS unsigned* MISC = (volatile LAS unsigned*)(ldsl + LDS_BYTES - 64);
    const int bid = blockIdx.x, nb = gridDim.x;
    if (threadIdx.x < 16) MISC[threadIdx.x] = 0u;
    __syncthreads();
    XcdBarrier bar; bar.bar = (unsigned*)(a.ws + WS_CTL); bar.x = 0; bar.st = nullptr;
    const bool multi = (a.ph_hi - a.ph_lo) > 1;
    if (multi) bar = xcd_barrier_post((unsigned*)(a.ws + WS_CTL), MISC);
    const float* modb = (const float*)(a.ws + WS_MOD);
    bf16_t* U = (bf16_t*)(a.ws + WS_U); bf16_t* MIX = (bf16_t*)(a.ws + WS_MIX); bf16_t* XN = (bf16_t*)(a.ws + WS_XN); float* HC = (float*)(a.ws + WS_HC);
    const int lo = a.ph_lo, hi = a.ph_hi;
#define IN(k) (lo <= (k) && (k) < hi)
#define SEAM(k) do { if (IN(k) && IN((k) + 1)) xcd_barrier(bar); } while (0)
    if (IN(0)) { ph_init(a, lds, bid, nb); if (DUP(0)) { __syncthreads(); ph_init(a, lds, bid, nb); } } SEAM(0);
    if (IN(1)) { ph_norm(a, bid, nb, MALL, modb, 0, 1024, a.in[I_X], a.in[I_CTX]); if (DUP(1)) ph_norm(a, bid, nb, MALL, modb, 0, 1024, a.in[I_X], a.in[I_CTX]); } SEAM(1);
    if (IN(2)) { EpiStoreL0 E{(bf16_t*)(a.ws + WS_UT), (bf16_t*)(a.ws + WS_UA)}; run_gemm(ldsl, XN, (const bf16_t*)(a.ws + WS_WEIN), MALL, E_IN, D, E); if (DUP(2)) run_gemm(ldsl, XN, (const bf16_t*)(a.ws + WS_WEIN), MALL, E_IN, D, E); } SEAM(2);
    if (IN(3)) { ph_prep0(a, lds, bid, nb); if (DUP(3)) ph_prep0(a, lds, bid, nb); } SEAM(3);
    if (IN(4)) { ph_diffattn(a, lds_raw, bid, nb); __syncthreads(); if (DUP(20)) { ph_diffattn(a, lds_raw, bid, nb); __syncthreads(); } if (DUP(23)) { ph_hyena(a, lds_raw, bid, nb, true); __syncthreads(); } ph_hyena(a, lds_raw, bid, nb); xcd_barrier(bar); ph_hy_transpose(a, lds, bid, nb); if (DUP(24)) ph_hy_transpose(a, lds, bid, nb); } SEAM(4);
    if (IN(5)) { EpiResid E{a.in[I_X], a.in[I_CTX], a.out, HC, modb, 2048}; run_gemm(ldsl, MIX, (const bf16_t*)(a.ws + WS_WEOUT), MALL, D, D, E); if (DUP(5)) run_gemm(ldsl, MIX, (const bf16_t*)(a.ws + WS_WEOUT), MALL, D, D, E); } SEAM(5);
    if (IN(6)) { ph_route(a, lds, bid, nb, 0, MALL); if (DUP(6)) ph_route(a, lds, bid, nb, 0, MALL, true); } SEAM(6);
    if (IN(7)) { ph_gather(a, lds, bid, nb, 0, MALL); if (DUP(7)) ph_gather(a, lds, bid, nb, 0, MALL); } SEAM(7);
    if (IN(8)) { moe_gemm1(a, lds, ldsl, 0); if (DUP(8)) moe_gemm1(a, lds, ldsl, 0); } SEAM(8);
    if (IN(9)) { moe_gemm2(a, lds, ldsl, 0); if (DUP(9)) moe_gemm2(a, lds, ldsl, 0); } SEAM(9);
    if (IN(10)) { ph_combine(a, bid, nb, 0, MALL, true); } SEAM(10);
    if (IN(11)) { EpiStoreBf16 E{U, O_IN}; run_gemm(ldsl, XN, (const bf16_t*)(a.ws + WS_WOIN), MALL, O_IN, D, E); } SEAM(11);
    if (IN(12)) { ph_prep1(a, lds, bid, nb); ph_moe_convert(a, lds, bid, nb, 1); if (DUP(12)) { ph_prep1(a, lds, bid, nb); } if (DUP(25)) { ph_moe_convert(a, lds, bid, nb, 1); } } SEAM(12);
    if (IN(13)) { ph_retention(a, lds_raw, bid, nb); __syncthreads(); if (DUP(21)) { ph_retention(a, lds_raw, bid, nb); __syncthreads(); } ph_gqa(a, lds_raw, bid, nb); if (DUP(22)) { __syncthreads(); ph_gqa(a, lds_raw, bid, nb); } } SEAM(13);
    if (IN(14)) { EpiResid E{a.out, HC, a.out, HC, modb + 9 * 6144, 2048}; run_gemm(ldsl, MIX, (const bf16_t*)(a.ws + WS_WOOUT), MLAT, D, D, E); } SEAM(14);
    if (IN(15)) { ph_route(a, lds, bid, nb, 1, MLAT); } SEAM(15);
    if (IN(16)) { ph_gather(a, lds, bid, nb, 1, MLAT); } SEAM(16);
    if (IN(17)) { moe_gemm1(a, lds, ldsl, 1); } SEAM(17);
    if (IN(18)) { moe_gemm2(a, lds, ldsl, 1); } SEAM(18);
    if (IN(19)) { ph_combine(a, bid, nb, 1, MLAT, false); }
#undef IN
#undef SEAM
}

extern "C" void kernel_launch(void* const* d_in, const int* in_sizes, int n_in, void* d_out, int out_size, void* d_ws, size_t ws_size, hipStream_t stream) {
    static int grid = 0;
    if (grid == 0) {
        if (n_in != N_IN || out_size != MLAT * D || ws_size < WS_END) { fprintf(stderr, "kernel_launch: unexpected shapes (n_in %d out %d ws %zu)\n", n_in, out_size, ws_size); grid = -1; return; }
        int dev = 0, cus = 0;
        if (hipGetDevice(&dev) != hipSuccess || hipDeviceGetAttribute(&cus, hipDeviceAttributeMultiprocessorCount, dev) != hipSuccess) { grid = -1; return; }
        if (hipFuncSetAttribute((const void*)fwd_kernel, hipFuncAttributeMaxDynamicSharedMemorySize, LDS_BYTES) != hipSuccess) { grid = -1; return; }
        grid = cus;
    }
    if (grid < 0) return;
    (void)hipMemsetAsync((char*)d_ws + WS_CTL, 0, CTL_ZERO_BYTES, stream);
    Args a{};
    for (int i = 0; i < N_IN; ++i) a.in[i] = (const float*)d_in[i];
    a.out = (float*)d_out; a.ws = (unsigned char*)d_ws;
#if MK_PER_PHASE
    for (int p = 0; p < N_PHASES; ++p) { a.ph_lo = p; a.ph_hi = p + 1; hipLaunchKernelGGL(fwd_kernel, dim3(grid), dim3(NTHR), LDS_BYTES, stream, a); }
#else
    a.ph_lo = 0; a.ph_hi = N_PHASES;
    hipLaunchKernelGGL(fwd_kernel, dim3(grid), dim3(NTHR), LDS_BYTES, stream, a);
#endif
}
```

```cpp
#include <hip/hip_runtime.h>
#include <cstdint>
#include <cstdio>

#ifndef MK_PER_PHASE
#define MK_PER_PHASE 0
#endif

#define DI __device__ __forceinline__
#define GAS __attribute__((address_space(1)))
#define LAS __attribute__((address_space(3)))
typedef float f32x4 __attribute__((ext_vector_type(4)));
typedef unsigned u32x4 __attribute__((ext_vector_type(4)));
typedef unsigned u32x2 __attribute__((ext_vector_type(2)));
typedef unsigned short bf16_t;

constexpr int D = 1024, NB = 8, S = 2048, C = 256;
constexpr int MLAT = NB * S, MCTX = NB * C, MALL = MLAT + MCTX;
constexpr int E_IN = 3072, O_IN = 2816;
constexpr int NTHR = 512, NWAVES = 8;
constexpr float EPS = 1e-6f;
constexpr int LDS_BYTES = 147456;

enum { I_X = 0, I_C, I_CTX, I_CCTX, I_ADAW, I_ADAB, I_EWIN, I_EWOUT, I_HYCW, I_HYCB, I_HYW1, I_HYB1, I_HYW2, I_HYB2, I_HYW3, I_HYFREQ, I_HYBIAS,
       I_DAQN, I_DAKN, I_DALAM, I_DASUB, I_OWIN, I_OWOUT, I_RETDEC, I_RETGN, I_GQQN, I_GQKN, I_GQSINK, I_MWGRP, I_MBGRP, I_MWRT, I_MBRT, I_MWG, I_MWU, I_MWD, N_IN };

constexpr size_t MiB = 1u << 20;
constexpr size_t WS_CTL = 0, CTL_ZERO_BYTES = 64 * 1024;
constexpr size_t WS_MOD = 1 * MiB;
constexpr size_t WS_HFL = 2 * MiB;
constexpr size_t WS_HFC = WS_HFL + 16 * MiB;
constexpr size_t WS_HC = WS_HFC + 2 * MiB;
constexpr size_t WS_WEIN = WS_HC + 8 * MiB;
constexpr size_t WS_WEOUT = WS_WEIN + 6 * MiB;
constexpr size_t WS_WOIN = WS_WEOUT + 2 * MiB;
constexpr size_t WS_WOOUT = WS_WOIN + 6 * MiB;
constexpr size_t WS_XN = WS_WOOUT + 2 * MiB;
constexpr size_t WS_U = WS_XN + 36 * MiB;
constexpr size_t WS_UT = WS_U;
constexpr size_t WS_UA = WS_U + 54 * MiB;
constexpr size_t WS_MIX = WS_U + 108 * MiB;
constexpr size_t WS_MW1 = WS_MIX + 36 * MiB;
constexpr size_t WS_MW2 = WS_MW1 + 32 * MiB;
constexpr size_t WS_TOK = WS_MW2 + 16 * MiB;
constexpr size_t WS_ROWW = WS_TOK + 1 * MiB;
constexpr size_t WS_ATT = WS_ROWW + 1 * MiB;
constexpr size_t WS_TRIG = WS_ATT + 48 * MiB;
constexpr size_t WS_ELIST = WS_TRIG + 2 * MiB;
constexpr size_t WS_END = WS_ELIST + 10 * MiB;
static_assert((size_t)176 * 256 * 1024 * 2 <= 108 * MiB && (size_t)176 * 256 * 256 * 2 <= 36 * MiB && (size_t)8 * MALL * 4 <= 1 * MiB, "moe overlays");
static_assert((size_t)MALL * 3072 * 2 <= 108 * MiB && (size_t)MALL * D * 2 <= 36 * MiB, "ws map");

struct Args { const float* in[N_IN]; float* out; unsigned char* ws; int ph_lo, ph_hi; };

DI float wave_sum(float v) {
#pragma unroll
    for (int o = 32; o > 0; o >>= 1) v += __shfl_xor(v, o);
    return v;
}
DI float wave_max(float v) {
#pragma unroll
    for (int o = 32; o > 0; o >>= 1) v = fmaxf(v, __shfl_xor(v, o));
    return v;
}
DI float silu_f(float x) { return x / (1.f + expf(-x)); }
DI int otid() { int t = threadIdx.x; asm volatile("" : "+v"(t)); return t; }
DI float bf2f(bf16_t v) { return __uint_as_float((unsigned)v << 16); }
DI unsigned f2bf(float f) { unsigned u = __float_as_uint(f); return (u + 0x7fffu + ((u >> 16) & 1u)) >> 16; }
DI unsigned pk2(float lo, float hi) { return f2bf(lo) | (f2bf(hi) << 16); }
DI f32x4 ld4bf(const bf16_t* p) { const u32x2 w = *(const u32x2*)p; f32x4 r; r.x = __uint_as_float(w.x << 16); r.y = __uint_as_float(w.x & 0xffff0000u); r.z = __uint_as_float(w.y << 16); r.w = __uint_as_float(w.y & 0xffff0000u); return r; }

#define XB_TMO      128
#define XB_XCNT(j)  (256  + 64 * (j))
#define XB_XSUB(j)  (1280 + 64 * (j))
#define XB_XGEN(j)  (2304 + 64 * (j))
#define XB_TOP      3328
#define XB_TOPGEN   3392
#define XCD_BAR_WORDS 3456
#define XB_SPIN_CAP (1u << 22)
DI unsigned xb_ld(unsigned* p)              { return __hip_atomic_load(p, __ATOMIC_RELAXED, __HIP_MEMORY_SCOPE_AGENT); }
DI unsigned xb_add(unsigned* p, unsigned v) { return __hip_atomic_fetch_add(p, v, __ATOMIC_RELAXED, __HIP_MEMORY_SCOPE_AGENT); }
DI unsigned xb_xcc_id() { return (unsigned)__builtin_amdgcn_s_getreg((3 << 11) | 20) & 0xFu; }
#define XB_SPIN(cond, bar) do { unsigned _sp = 0; while (cond) { __builtin_amdgcn_s_sleep(1); \
    if ((++_sp & 255u) == 0u) { if (xb_ld(&(bar)[XB_TMO])) break; if (_sp > XB_SPIN_CAP) { atomicAdd(&(bar)[XB_TMO], 1u); break; } } } } while (0)
struct XcdBarrier { unsigned* bar; unsigned x; volatile LAS unsigned* st; };
DI XcdBarrier xcd_barrier_post(unsigned* bar, volatile LAS unsigned* st) {
    XcdBarrier b; b.bar = bar; b.x = xb_xcc_id(); b.st = st;
    if (threadIdx.x == 0) (void)xb_add(&bar[XB_XCNT(b.x)], 1u);
    return b;
}
DI void xcd_barrier_complete(unsigned* bar, unsigned x, unsigned& nloc, unsigned& nx) {
    const unsigned G = gridDim.x * gridDim.y * gridDim.z;
    unsigned sum, cnt, mine, sp = 0u;
    for (;;) {
        sum = 0u; cnt = 0u; mine = 0u;
#pragma unroll
        for (unsigned j = 0; j < 16; ++j) { const unsigned c = xb_ld(&bar[XB_XCNT(j)]); sum += c; cnt += (c > 0u) ? 1u : 0u; mine = (j == x) ? c : mine; }
        if (sum == G) break;
        __builtin_amdgcn_s_sleep(1);
        if ((++sp & 255u) == 0u) { if (xb_ld(&bar[XB_TMO])) break; if (sp > XB_SPIN_CAP) { atomicAdd(&bar[XB_TMO], 1u); break; } }
    }
    nloc = mine > 0u ? mine : 1u; nx = cnt > 0u ? cnt : 1u;
}
DI void xcd_barrier(const XcdBarrier& b) {
    asm volatile("s_waitcnt vmcnt(0)" ::: "memory");
    __syncthreads();
    if (threadIdx.x == 0) {
        unsigned* bar = b.bar;
        __builtin_amdgcn_s_waitcnt(0);
        unsigned nloc = b.st[0], nx = b.st[1];
        if (nloc == 0u) { xcd_barrier_complete(bar, b.x, nloc, nx); b.st[0] = nloc; b.st[1] = nx; }
        const unsigned old = xb_add(&bar[XB_XSUB(b.x)], 1u);
        const unsigned gen = old / nloc;
        if (old + 1u == (gen + 1u) * nloc) {
            __builtin_amdgcn_fence(__ATOMIC_RELEASE, "agent");
            asm volatile("s_waitcnt vmcnt(0)" ::: "memory");
            const unsigned og = xb_add(&bar[XB_TOP], 1u);
            const unsigned tg = og / nx;
            if (og + 1u == (tg + 1u) * nx) xb_add(&bar[XB_TOPGEN], 1u);
            else XB_SPIN(xb_ld(&bar[XB_TOPGEN]) == tg, bar);
            __builtin_amdgcn_fence(__ATOMIC_ACQUIRE, "agent");
            xb_add(&bar[XB_XGEN(b.x)], 1u);
            asm volatile("s_waitcnt vmcnt(0)" ::: "memory");
        } else {
            XB_SPIN(xb_ld(&bar[XB_XGEN(b.x)]) == gen, bar);
            __builtin_amdgcn_fence(__ATOMIC_ACQUIRE, "agent");
            asm volatile("s_waitcnt vmcnt(0)" ::: "memory");
        }
    }
    __syncthreads();
}

namespace pg8 {
#define PG8_LAS __attribute__((address_space(3)))
typedef unsigned short bf16_t;
typedef short bf16x8 __attribute__((ext_vector_type(8)));
typedef float f32x4 __attribute__((ext_vector_type(4)));
typedef unsigned u32x4 __attribute__((ext_vector_type(4)));
constexpr int BM = 256, BK = 64, HALF = 128, HTB = HALF * BK * 2  , STAGE_BYTES = 8 * HTB, NXCD = 8, WGM = 8;

__host__ __device__ __forceinline__ int lds_byte(int r, int c) { const int st = (r >> 4) * 2 + (c >> 5), rr = r & 15, cc = c & 31, ob = rr * 64 + cc * 2; return st * 1024 + (ob ^ (((ob >> 9) & 1) << 5)); }
__host__ __device__ __forceinline__ void stage_rc(int b, int& R, int& C) { const int st = b / 1024, sb = b % 1024, swz = sb ^ (((sb >> 9) & 1) << 5); R = (st >> 1) * 16 + swz / 64; C = (st & 1) * 32 + (swz % 64) / 2; }
__host__ __device__ __forceinline__ int perm32(int rho) { const int n = rho >> 4, i = rho & 15; return 8 * (i >> 2) + 4 * n + (i & 3); }

struct Unit { int pm, pn; };
struct Gemm { const bf16_t* A; const bf16_t* Bt; int M, N, K; };

struct StaticOrder {
    int nM, nN, nwg, G, c;
    __host__ __device__ void init(int M, int N, int G_, int c_) { nM = M / BM; nN = N / BM; nwg = nM * nN; G = G_; c = c_; }
    __host__ __device__ bool next(int i, Unit& u) const {
        const long L = (long)i * G + c; if (L >= nwg) return false;
        int wgid = (int)L; { const int q = nwg / NXCD, r = nwg % NXCD, xcd = wgid % NXCD, off = wgid / NXCD; wgid = (xcd < r ? xcd * (q + 1) : r * (q + 1) + (xcd - r) * q) + off; }
        const int nig = WGM * nN, gid = wgid / nig, fm = gid * WGM, gsz = (nM - fm) < WGM ? (nM - fm) : WGM;
        u.pm = fm + ((wgid % nig) % gsz); u.pn = (wgid % nig) / gsz; return true;
    }
    __device__ __forceinline__ void a_ready(const Unit&) const {}
    __device__ __forceinline__ void done(const Unit&) const {}
};

__device__ __forceinline__ unsigned cvt_pk_bf16(float lo, float hi) { unsigned r; asm volatile("v_cvt_pk_bf16_f32 %0, %1, %2" : "=v"(r) : "v"(lo), "v"(hi)); return r; }
template <class Epi, class Sched, bool ALIGN_EPI = false, bool SP2 = false, bool GATHER = false>
__device__ __forceinline__ void gemm_phase(PG8_LAS unsigned char* lds, const Gemm g, const Sched& S, const Epi& E) {
    static_assert(!GATHER || SP2, "GATHER is wired into the SP2 loop only");
    const int tid = threadIdx.x, wid = __builtin_amdgcn_readfirstlane(tid >> 6), lane = tid & 63, wr = wid >> 2, wc = wid & 3, fr = lane & 15, fq = lane >> 4;
    const int K = g.K, nt = K / BK;
    unsigned voffA[2], voffB[2];
#pragma unroll
    for (int i = 0; i < 2; ++i) { int R, C; stage_rc(tid * 16 + i * 8192, R, C); const int Rb = Epi::PERM ? ((R & ~31) + perm32(R & 31)) : R;
        voffA[i] = (unsigned)(R * K + C) * 2u; voffB[i] = (unsigned)(Rb * K + C) * 2u; }
    const size_t kstep = (size_t)(BK * 2);
    const size_t hstep = (size_t)HALF * K * 2;
    const size_t tstep = 2 * hstep;
    const unsigned ldsw = (unsigned)wid * 1024u;
    const int aoff = lds_byte(wr * 64 + fr, fq * 8), boff = lds_byte(wc * 32 + fr, fq * 8);
#define PG8_SA(b, h) (((b) * 2 + (h)) * HTB)
#define PG8_SB(b, h) ((4 + (b) * 2 + (h)) * HTB)
#define PG8_STAGE(bufoff, gbase, voff) do { _Pragma("unroll") for (int _i = 0; _i < 2; ++_i) \
        __builtin_amdgcn_global_load_lds((const unsigned*)((const char*)(gbase) + (voff)[_i]), (PG8_LAS unsigned*)(lds + (bufoff) + ldsw + _i * 8192), 16, 0, 0); } while (0)
#define PG8_LDA(dst, b, h) do { _Pragma("unroll") for (int m = 0; m < 4; ++m) _Pragma("unroll") for (int k = 0; k < 2; ++k) dst[m][k] = *(const PG8_LAS bf16x8*)(lds + PG8_SA(b, h) + aoff + m * 2048 + k * 1024); } while (0)
#define PG8_LDB(dst, b, h) do { _Pragma("unroll") for (int n = 0; n < 2; ++n) _Pragma("unroll") for (int k = 0; k < 2; ++k) dst[n][k] = *(const PG8_LAS bf16x8*)(lds + PG8_SB(b, h) + boff + n * 2048 + k * 1024); } while (0)
#define PG8_MMA(ai, bj, At, Bt) do { __builtin_amdgcn_s_setprio(1); _Pragma("unroll") for (int m = 0; m < 4; ++m) _Pragma("unroll") for (int n = 0; n < 2; ++n) _Pragma("unroll") for (int k = 0; k < 2; ++k) \
        acc[ai][bj][m][n] = __builtin_amdgcn_mfma_f32_16x16x32_bf16(Bt[n][k], At[m][k], acc[ai][bj][m][n], 0, 0, 0); __builtin_amdgcn_s_setprio(0); } while (0)
#define PG8_WAIT_V(n) asm volatile("s_waitcnt vmcnt(" #n ")" ::: "memory")
#define PG8_WAIT_L(n) asm volatile("s_waitcnt lgkmcnt(" #n ")" ::: "memory")
#define PG8_BAR __builtin_amdgcn_s_barrier()
#define PG8_SCHED __builtin_amdgcn_sched_barrier(0)
    Unit cur, nxt; int ui = 0;
    if (!S.next(0, cur)) return;
    f32x4 acc[2][2][4][2];
#pragma unroll
    for (int a = 0; a < 2; ++a)
#pragma unroll
        for (int b = 0; b < 2; ++b)
#pragma unroll
            for (int m = 0; m < 4; ++m)
#pragma unroll
                for (int n = 0; n < 2; ++n) acc[a][b][m][n] = (f32x4){0.f, 0.f, 0.f, 0.f};
    bf16x8 At[4][2], B0[2][2], B1[2][2];
    const char* cA = GATHER ? (const char*)g.A : (const char*)g.A + (size_t)cur.pm * tstep; const char* cB = (const char*)g.Bt + (size_t)cur.pn * tstep;
    const size_t hstepA = GATHER ? 0 : hstep;
    unsigned vc0[2], vc1[2], vn0[2], vn1[2];
#pragma unroll
    for (int i = 0; i < 2; ++i) { vc0[i] = voffA[i]; vc1[i] = voffA[i]; vn0[i] = voffA[i]; vn1[i] = voffA[i]; }
    if constexpr (GATHER) {
#pragma unroll
        for (int i = 0; i < 2; ++i) { int R, C; stage_rc(tid * 16 + i * 8192, R, C); vc0[i] = S.rowoff(cur, R) + (unsigned)C * 2u; vc1[i] = S.rowoff(cur, 128 + R) + (unsigned)C * 2u; }
    }
    S.a_ready(cur);
    if constexpr (SP2) {
        PG8_STAGE(PG8_SB(0, 0), cB, voffB); PG8_STAGE(PG8_SB(0, 1), cB + hstep, voffB); PG8_STAGE(PG8_SA(0, 0), cA, vc0); PG8_STAGE(PG8_SA(0, 1), cA + hstepA, vc1);
        if (wr == 1) PG8_BAR;
        PG8_WAIT_V(2); PG8_BAR;
        PG8_STAGE(PG8_SB(1, 0), cB + kstep, voffB); PG8_STAGE(PG8_SA(1, 0), cA + kstep, vc0); PG8_STAGE(PG8_SB(1, 1), cB + hstep + kstep, voffB);
        PG8_WAIT_V(6); PG8_BAR;
    } else {
        PG8_STAGE(PG8_SB(0, 0), cB, voffB); PG8_STAGE(PG8_SA(0, 0), cA, voffA); PG8_STAGE(PG8_SB(0, 1), cB + hstep, voffB); PG8_STAGE(PG8_SA(0, 1), cA + hstep, voffA);
        if (wr == 1) PG8_BAR;
        PG8_WAIT_V(4); PG8_BAR;
        PG8_STAGE(PG8_SB(1, 0), cB + kstep, voffB); PG8_STAGE(PG8_SA(1, 0), cA + kstep, voffA); PG8_STAGE(PG8_SB(1, 1), cB + hstep + kstep, voffB);
        PG8_WAIT_V(6); PG8_BAR;
    }
    for (;;) {
        const bool has_next = S.next(ui + 1, nxt);
        const char* nA = GATHER ? cA : (has_next ? (const char*)g.A + (size_t)nxt.pm * tstep : cA); const char* nB = has_next ? (const char*)g.Bt + (size_t)nxt.pn * tstep : cB;
        if constexpr (GATHER) {
#pragma unroll
            for (int i = 0; i < 2; ++i) { vn0[i] = vc0[i]; vn1[i] = vc1[i]; }
            if (has_next) {
#pragma unroll
                for (int i = 0; i < 2; ++i) { int R, C; stage_rc(tid * 16 + i * 8192, R, C); vn0[i] = S.rowoff(nxt, R) + (unsigned)C * 2u; vn1[i] = S.rowoff(nxt, 128 + R) + (unsigned)C * 2u; }
            }
        }
        for (int t = 0; t < nt; t += 2) {
            const bool last = (t == nt - 2);
            const char* a1 = cA + (size_t)(t + 1) * kstep;
            const char* a2 = last ? nA : cA + (size_t)(t + 2) * kstep; const char* b2 = last ? nB : cB + (size_t)(t + 2) * kstep;
            const char* a3 = a2 + kstep; const char* b3 = b2 + kstep;
            if (last && has_next) S.a_ready(nxt);
            if constexpr (SP2) {
            PG8_LDB(B0, 0, 0); PG8_LDB(B1, 0, 1); PG8_SCHED; PG8_LDA(At, 0, 0); PG8_STAGE(PG8_SA(1, 1), a1 + hstepA, vc1);
            PG8_WAIT_V(8); PG8_WAIT_L(0); PG8_BAR; PG8_MMA(0, 0, At, B0); PG8_MMA(0, 1, At, B1); PG8_BAR; PG8_SCHED;
            PG8_LDA(At, 0, 1); PG8_STAGE(PG8_SB(0, 0), b2, voffB); PG8_STAGE(PG8_SB(0, 1), b2 + hstep, voffB); if (GATHER && last) { PG8_STAGE(PG8_SA(0, 0), a2, vn0); } else { PG8_STAGE(PG8_SA(0, 0), a2, vc0); }
            PG8_WAIT_V(8); PG8_WAIT_L(0); PG8_BAR; PG8_MMA(1, 0, At, B0); PG8_MMA(1, 1, At, B1); PG8_BAR; PG8_SCHED;
            PG8_LDB(B0, 1, 0); PG8_LDB(B1, 1, 1); PG8_SCHED; PG8_LDA(At, 1, 0); if (GATHER && last) { PG8_STAGE(PG8_SA(0, 1), a2 + hstepA, vn1); } else { PG8_STAGE(PG8_SA(0, 1), a2 + hstepA, vc1); }
            PG8_WAIT_V(8); PG8_WAIT_L(0); PG8_BAR; PG8_MMA(0, 0, At, B0); PG8_MMA(0, 1, At, B1); PG8_BAR; PG8_SCHED;
            PG8_LDA(At, 1, 1); PG8_STAGE(PG8_SB(1, 0), b3, voffB); PG8_STAGE(PG8_SB(1, 1), b3 + hstep, voffB); if (GATHER && last) { PG8_STAGE(PG8_SA(1, 0), a3, vn0); } else { PG8_STAGE(PG8_SA(1, 0), a3, vc0); }
            PG8_WAIT_V(8); PG8_WAIT_L(0); PG8_BAR; PG8_MMA(1, 0, At, B0); PG8_MMA(1, 1, At, B1); PG8_BAR; PG8_SCHED;
            } else {
            PG8_LDB(B0, 0, 0); PG8_SCHED; PG8_LDA(At, 0, 0); PG8_STAGE(PG8_SA(1, 1), a1 + hstep, voffA);
            PG8_WAIT_L(8); PG8_BAR; PG8_WAIT_L(0); PG8_MMA(0, 0, At, B0); PG8_BAR; PG8_SCHED;
            PG8_LDB(B1, 0, 1); PG8_STAGE(PG8_SB(0, 0), b2, voffB);
            PG8_BAR; PG8_WAIT_L(0); PG8_MMA(0, 1, At, B1); PG8_BAR;
            PG8_LDA(At, 0, 1); PG8_STAGE(PG8_SA(0, 0), a2, voffA);
            PG8_BAR; PG8_WAIT_L(0); PG8_MMA(1, 0, At, B0); PG8_BAR; PG8_SCHED;
            PG8_STAGE(PG8_SB(0, 1), b2 + hstep, voffB);
            PG8_WAIT_V(6); PG8_BAR; PG8_MMA(1, 1, At, B1); PG8_BAR;
            PG8_LDB(B0, 1, 0); PG8_SCHED; PG8_LDA(At, 1, 0); PG8_STAGE(PG8_SA(0, 1), a2 + hstep, voffA);
            PG8_WAIT_L(8); PG8_BAR; PG8_WAIT_L(0); PG8_MMA(0, 0, At, B0); PG8_BAR; PG8_SCHED;
            PG8_LDB(B1, 1, 1); PG8_STAGE(PG8_SB(1, 0), b3, voffB);
            PG8_BAR; PG8_WAIT_L(0); PG8_MMA(0, 1, At, B1); PG8_BAR;
            PG8_LDA(At, 1, 1); PG8_STAGE(PG8_SA(1, 0), a3, voffA);
            PG8_BAR; PG8_WAIT_L(0); PG8_MMA(1, 0, At, B0); PG8_BAR; PG8_SCHED;
            PG8_STAGE(PG8_SB(1, 1), b3 + hstep, voffB);
            PG8_WAIT_V(6); PG8_BAR; PG8_MMA(1, 1, At, B1); PG8_BAR;
            }
        }
        if constexpr (ALIGN_EPI) { if (wr == 0) PG8_BAR; }
        if constexpr (!Epi::AFTER_DRAIN) { E(acc, cur, wr, wc, fr, fq); S.done(cur); }
        if (!has_next) break;
#pragma unroll
        for (int a = 0; a < 2; ++a)
#pragma unroll
            for (int b = 0; b < 2; ++b)
#pragma unroll
                for (int m = 0; m < 4; ++m)
#pragma unroll
                    for (int n = 0; n < 2; ++n) acc[a][b][m][n] = (f32x4){0.f, 0.f, 0.f, 0.f};
        cur = nxt; cA = nA; cB = nB; ++ui;
        if constexpr (GATHER) {
#pragma unroll
            for (int i = 0; i < 2; ++i) { vc0[i] = vn0[i]; vc1[i] = vn1[i]; }
        }
        if constexpr (ALIGN_EPI) { if (wr == 1) PG8_BAR; }
    }
    PG8_WAIT_V(0);
    if constexpr (!ALIGN_EPI) { if (wr == 0) PG8_BAR; }
    PG8_BAR;
    if constexpr (Epi::AFTER_DRAIN) { E.fused(acc, cur, wr, wc, fr, fq, lds, wid, lane); S.done(cur); }
#undef PG8_SA
#undef PG8_SB
#undef PG8_STAGE
#undef PG8_LDA
#undef PG8_LDB
#undef PG8_MMA
#undef PG8_WAIT_V
#undef PG8_WAIT_L
#undef PG8_BAR
#undef PG8_SCHED
}
}
__device__ __forceinline__ unsigned cvt_pk(float lo, float hi) { return pg8::cvt_pk_bf16(lo, hi); }
struct EpiStoreBf16 {
    static constexpr bool PERM = true, AFTER_DRAIN = false;
    bf16_t* O; int ldc;
    __device__ __forceinline__ void operator()(const f32x4 (&acc)[2][2][4][2], const pg8::Unit& u, int wr, int wc, int fr, int fq) const {
        const int row0 = u.pm * 256 + wr * 64 + fr, col0 = u.pn * 256 + wc * 32 + 8 * fq;
#pragma unroll
        for (int ai = 0; ai < 2; ++ai)
#pragma unroll
            for (int m = 0; m < 4; ++m) { bf16_t* rowp = O + (size_t)(row0 + ai * 128 + m * 16) * ldc + col0;
#pragma unroll
                for (int bj = 0; bj < 2; ++bj) { const f32x4 v0 = acc[ai][bj][m][0], v1 = acc[ai][bj][m][1];
                    u32x4 w; w.x = cvt_pk(v0[0], v0[1]); w.y = cvt_pk(v0[2], v0[3]); w.z = cvt_pk(v1[0], v1[1]); w.w = cvt_pk(v1[2], v1[3]);
                    *(u32x4*)(rowp + bj * 128) = w; } }
    }
};
struct EpiStoreL0 {
    static constexpr bool PERM = true, AFTER_DRAIN = false;
    bf16_t* UT; bf16_t* UA;
    __device__ __forceinline__ void operator()(const f32x4 (&acc)[2][2][4][2], const pg8::Unit& u, int wr, int wc, int fr, int fq) const {
        const int row0 = u.pm * 256 + wr * 64 + fr, col0 = u.pn * 256 + wc * 32 + 8 * fq;
        if (u.pn < 6) {
#pragma unroll
            for (int bj = 0; bj < 2; ++bj)
#pragma unroll
                for (int n = 0; n < 2; ++n)
#pragma unroll
                    for (int j = 0; j < 4; ++j) { bf16_t* cp = UT + (size_t)(col0 + bj * 128 + 4 * n + j) * MALL + row0;
#pragma unroll
                        for (int ai = 0; ai < 2; ++ai)
#pragma unroll
                            for (int m = 0; m < 4; ++m) cp[ai * 128 + m * 16] = (bf16_t)(cvt_pk(acc[ai][bj][m][n][j], 0.f) & 0xffffu); }
        } else {
#pragma unroll
            for (int ai = 0; ai < 2; ++ai)
#pragma unroll
                for (int m = 0; m < 4; ++m) { bf16_t* rowp = UA + (size_t)(row0 + ai * 128 + m * 16) * 1536 + (col0 - 1536);
#pragma unroll
                    for (int bj = 0; bj < 2; ++bj) { const f32x4 v0 = acc[ai][bj][m][0], v1 = acc[ai][bj][m][1];
                        u32x4 w; w.x = cvt_pk(v0[0], v0[1]); w.y = cvt_pk(v0[2], v0[3]); w.z = cvt_pk(v1[0], v1[1]); w.w = cvt_pk(v1[2], v1[3]);
                        *(u32x4*)(rowp + bj * 128) = w; } }
        }
    }
};
struct EpiResid {
    static constexpr bool PERM = false, AFTER_DRAIN = false;
    const float* sl; const float* sc; float* hl; float* hc; const float* mod; int g_off;
    __device__ __forceinline__ void operator()(const f32x4 (&acc)[2][2][4][2], const pg8::Unit& u, int wr, int wc, int fr, int fq) const {
        const int rowt = u.pm * 256; const int col0 = u.pn * 256 + wc * 32 + 4 * fq;
        const size_t boff = rowt < MLAT ? (size_t)rowt * D : (size_t)(rowt - MLAT) * D;
        const float* sbase = (rowt < MLAT ? sl : sc) + boff; float* dbase = (rowt < MLAT ? hl : hc) + boff;
        const float* g = mod + (size_t)(rowt < MLAT ? rowt / S : 8) * 6144 + g_off + col0;
        f32x4 gv[2][2];
#pragma unroll
        for (int bj = 0; bj < 2; ++bj)
#pragma unroll
            for (int n = 0; n < 2; ++n) gv[bj][n] = *(const f32x4*)(g + bj * 128 + n * 16);
#pragma unroll
        for (int ai = 0; ai < 2; ++ai)
#pragma unroll
            for (int m = 0; m < 4; ++m) { const size_t ro = (size_t)(ai * 128 + wr * 64 + m * 16 + fr) * D + col0;
#pragma unroll
                for (int bj = 0; bj < 2; ++bj)
#pragma unroll
                    for (int n = 0; n < 2; ++n) { *(f32x4*)(dbase + ro + bj * 128 + n * 16) = *(const f32x4*)(sbase + ro + bj * 128 + n * 16) + gv[bj][n] * acc[ai][bj][m][n]; } }
    }
};

DI void p0_tr(const float* W, int N, int K, int k0, int n0, bf16_t* dst, float* scr, int lane) {
    float tmp[32];
#pragma unroll
    for (int i = 0; i < 32; ++i) tmp[i] = W[(size_t)(k0 + 2 * i + (lane >> 5)) * N + n0 + (lane & 31)];
#pragma unroll
    for (int i = 0; i < 32; ++i) scr[(2 * i + (lane >> 5)) * 33 + (lane & 31)] = tmp[i];
    __builtin_amdgcn_wave_barrier(); asm volatile("s_waitcnt lgkmcnt(0)" ::: "memory");
    const int c = lane & 7;
#pragma unroll
    for (int j = 0; j < 4; ++j) { const int n = (lane >> 3) + 8 * j; const float* s = scr + (8 * c) * 33 + n;
        u32x4 o; o.x = cvt_pk(s[0 * 33], s[1 * 33]); o.y = cvt_pk(s[2 * 33], s[3 * 33]); o.z = cvt_pk(s[4 * 33], s[5 * 33]); o.w = cvt_pk(s[6 * 33], s[7 * 33]);
        *(u32x4*)(dst + (size_t)n * K + k0 + 8 * c) = o; }
    __builtin_amdgcn_wave_barrier(); asm volatile("s_waitcnt lgkmcnt(0)" ::: "memory");
}
DI void p0_transpose_item(const float* W, int K, int N, bf16_t* WT, float* scr, int item, int lane) {
    const int nblk = N / 32, kb = item / nblk, nbk = item % nblk;
    p0_tr(W, N, K, 64 * kb, 32 * nbk, WT + (size_t)(32 * nbk) * K, scr, lane);
}
DI void ph_moe_convert(const Args& a, float* lds, int bid, int nb, int l) {
    const int tid = otid(); const int lane = tid & 63, wv = tid >> 6;
    float* scr = lds + wv * (64 * 33);
    __syncthreads();
    for (int it = bid * NWAVES + wv; it < 32 * 384; it += nb * NWAVES) {
        const int e = it / 384, r = it % 384, le = l * 32 + e;
        if (r < 256) { const int up = r >> 7, q = r & 127, kb = q >> 3, nbk = q & 7, n0 = 32 * nbk;
            const float* W = a.in[up ? I_MWU : I_MWG] + (size_t)le * D * 256;
            bf16_t* dst = (bf16_t*)(a.ws + WS_MW1) + ((size_t)e * 512 + (n0 >> 7) * 256 + up * 128 + (n0 & 127)) * D;
            p0_tr(W, 256, D, 64 * kb, n0, dst, scr, lane);
        } else { const int q = r - 256, kb = q >> 5, nbk = q & 31, n0 = 32 * nbk;
            const float* W = a.in[I_MWD] + (size_t)le * 256 * D;
            bf16_t* dst = (bf16_t*)(a.ws + WS_MW2) + ((size_t)e * 1024 + n0) * 256;
            p0_tr(W, D, 256, 64 * kb, n0, dst, scr, lane);
        }
    }
    __syncthreads();
}
DI void ph_init(const Args& a, float* lds, int bid, int nb) {
    const int tid = otid();
    float* mod = (float*)(a.ws + WS_MOD);
    float* sv = lds;
    float* red = lds + 9 * 1024;
    for (int i = tid; i < 9 * 1024; i += NTHR) { const int r = i >> 10, k = i & 1023; const float x = r < 8 ? a.in[I_C][r * D + k] : a.in[I_CCTX][k]; sv[i] = silu_f(x); }
    __syncthreads();
    for (int it = bid; it < 2 * 96; it += nb) {
        const int l = it / 96, n0 = (it % 96) * 64;
        const int cg = tid & 15, kr = tid >> 4;
        float acc[9][4];
#pragma unroll
        for (int r = 0; r < 9; ++r) { acc[r][0] = acc[r][1] = acc[r][2] = acc[r][3] = 0.f; }
        const float* W = a.in[I_ADAW] + (size_t)l * D * 6144 + n0 + cg * 4;
#pragma unroll 2
        for (int k = kr; k < D; k += 32) {
            const f32x4 w = *(const f32x4*)(W + (size_t)k * 6144);
#pragma unroll
            for (int r = 0; r < 9; ++r) { const float s = sv[r * 1024 + k]; acc[r][0] += s * w.x; acc[r][1] += s * w.y; acc[r][2] += s * w.z; acc[r][3] += s * w.w; }
        }
#pragma unroll
        for (int r = 0; r < 9; ++r)
#pragma unroll
            for (int j = 0; j < 4; ++j) red[(kr * 9 + r) * 64 + cg * 4 + j] = acc[r][j];
        __syncthreads();
        for (int o = tid; o < 9 * 64; o += NTHR) {
            const int r = o >> 6, c = o & 63; float s = 0.f;
#pragma unroll 4
            for (int q = 0; q < 32; ++q) s += red[(q * 9 + r) * 64 + c];
            mod[((size_t)l * 9 + r) * 6144 + n0 + c] = s + a.in[I_ADAB][l * 6144 + n0 + c];
        }
        __syncthreads();
    }
    {
        float* zf = lds;
        float* h1 = lds + 64 * 33;
        float* h2 = h1 + 64 * 65;
        const float* w1 = a.in[I_HYW1]; const float* b1 = a.in[I_HYB1]; const float* w2 = a.in[I_HYW2]; const float* b2 = a.in[I_HYB2];
        const float* w3 = a.in[I_HYW3]; const float* fr = a.in[I_HYFREQ];
        for (int it = bid; it < 36 * 8; it += nb) {
            const int lc = it >> 3, oc = it & 7; const bool lat = lc < 32; const int L = lat ? S : C; const int lag0 = lat ? lc * 64 : (lc - 32) * 64;
            __syncthreads();
            for (int i = tid; i < 64 * 33; i += NTHR) { const int lg = i / 33, f = i % 33; const int lag = lag0 + lg;
                const float t = (float)lag / (float)(L - 1), w = (6.283185307179586f / (float)L) * (float)lag; float v;
                if (f == 0) v = t; else { const int q = (f - 1) & 15; const float fb = 1e-4f + (float)q * ((15.f - 1e-4f) / 15.f); v = (f <= 16) ? cosf(fb * w) : -sinf(fb * w); }
                zf[lg * 33 + f] = v; }
            __syncthreads();
            for (int i = tid; i < 64 * 64; i += NTHR) { const int lg = i >> 6, j = i & 63; float s = b1[j];
#pragma unroll 3
                for (int q = 0; q < 33; ++q) s += zf[lg * 33 + q] * w1[q * 64 + j];
                h1[lg * 65 + j] = sinf(fr[j] * s); }
            __syncthreads();
            for (int i = tid; i < 64 * 64; i += NTHR) { const int lg = i >> 6, j = i & 63; float s = b2[j];
#pragma unroll 4
                for (int q = 0; q < 64; ++q) s += h1[lg * 65 + q] * w2[q * 64 + j];
                h2[lg * 65 + j] = sinf(fr[64 + j] * s); }
            __syncthreads();
            { const int o = oc * 256 + (tid & 255), hf = tid >> 8; float acc[32];
#pragma unroll
              for (int q = 0; q < 32; ++q) acc[q] = 0.f;
#pragma unroll 2
              for (int i = 0; i < 64; ++i) { const float w = w3[i * 2048 + o];
#pragma unroll
                  for (int q = 0; q < 32; ++q) acc[q] += h2[(hf * 32 + q) * 65 + i] * w; }
              const int ch = o & 511;
              const float dmin = -3.0701134573253945f, dmax = -15.350567286626973f;
              const float delta = fabsf(dmin + (dmax - dmin) * ((float)ch / 511.f));
              bf16_t* dst = (bf16_t*)(a.ws + (lat ? WS_HFL : WS_HFC)) + (size_t)o * L + lag0 + hf * 32;
#pragma unroll
              for (int q4 = 0; q4 < 4; ++q4) { unsigned w[4];
#pragma unroll
                  for (int q = 0; q < 4; ++q) { const int l0 = lag0 + hf * 32 + q4 * 8 + 2 * q; const float t0 = (float)l0 / (float)(L - 1), t1 = (float)(l0 + 1) / (float)(L - 1);
                      w[q] = pk2(acc[q4 * 8 + 2 * q] * expf(-t0 * delta), acc[q4 * 8 + 2 * q + 1] * expf(-t1 * delta)); }
                  u32x4 ov = {w[0], w[1], w[2], w[3]}; *(u32x4*)(dst + q4 * 8) = ov; } }
        }
        __syncthreads();
    }
    { float* ax = (float*)(a.ws + WS_TRIG); float* r1 = ax + 2048;
      for (int i = bid * NTHR + tid; i < 1024 + S * 64; i += nb * NTHR) {
          if (i < 1024) { const int pos = i >> 4, f = i & 15; const float ang = (float)pos * exp2f(-(float)f * (13.287712379549449f / 16.f)); ax[i] = cosf(ang); ax[1024 + i] = sinf(ang); }
          else { const int q = i - 1024, t = q >> 6, f = q & 63; const float ang = (float)t * exp2f(-(float)f * (13.287712379549449f / 63.f)); r1[q] = cosf(ang); r1[S * 64 + q] = sinf(ang); } } }
    {
        __syncthreads();
        const int lane = tid & 63, wv = tid >> 6;
        float* scr = lds + wv * (64 * 33);
        constexpr int I_A = (D / 64) * (E_IN / 32), I_B = (D / 64) * (D / 32), I_C2 = (D / 64) * (O_IN / 32);
        constexpr int NIT = I_A + I_B + I_C2 + I_B;
        for (int it = bid * NWAVES + wv; it < NIT; it += nb * NWAVES) {
            int r = it;
            if (r < I_A) { p0_transpose_item(a.in[I_EWIN], D, E_IN, (bf16_t*)(a.ws + WS_WEIN), scr, r, lane); continue; } r -= I_A;
            if (r < I_B) { p0_transpose_item(a.in[I_EWOUT], D, D, (bf16_t*)(a.ws + WS_WEOUT), scr, r, lane); continue; } r -= I_B;
            if (r < I_C2) { p0_transpose_item(a.in[I_OWIN], D, O_IN, (bf16_t*)(a.ws + WS_WOIN), scr, r, lane); continue; } r -= I_C2;
            p0_transpose_item(a.in[I_OWOUT], D, D, (bf16_t*)(a.ws + WS_WOOUT), scr, r, lane);
        }
    }
    ph_moe_convert(a, lds, bid, nb, 0);
}

DI const float* row_ptr(const Args& a, int m) { return m < MLAT ? a.out + (size_t)m * D : (const float*)(a.ws + WS_HC) + (size_t)(m - MLAT) * D; }
DI float* row_ptr_w(const Args& a, int m) { return m < MLAT ? a.out + (size_t)m * D : (float*)(a.ws + WS_HC) + (size_t)(m - MLAT) * D; }
DI int mod_row(int m) { return m < MLAT ? m / S : 8; }
DI void ph_norm(const Args& a, int bid, int nb, int nrows, const float* mod, int sh_off, int sc_off, const float* srcl, const float* srcc) {
    const int tid = otid(); const int lane = tid & 63, wv = tid >> 6;
    bf16_t* XN = (bf16_t*)(a.ws + WS_XN);
    for (int m = bid * NWAVES + wv; m < nrows; m += nb * NWAVES) {
        const f32x4* r = (const f32x4*)(m < MLAT ? srcl + (size_t)m * D : srcc + (size_t)(m - MLAT) * D); f32x4 v[4]; float s = 0.f;
#pragma unroll
        for (int j = 0; j < 4; ++j) { v[j] = r[lane + 64 * j]; s += v[j].x * v[j].x + v[j].y * v[j].y + v[j].z * v[j].z + v[j].w * v[j].w; }
        s = wave_sum(s);
        const float rs = 1.f / sqrtf(s * (1.f / D) + EPS);
        const float* mr = mod + (size_t)mod_row(m) * 6144;
        u32x2* o = (u32x2*)(XN + (size_t)m * D);
#pragma unroll
        for (int j = 0; j < 4; ++j) { const f32x4 sh = *(const f32x4*)(mr + sh_off + 4 * (lane + 64 * j)), sc = *(const f32x4*)(mr + sc_off + 4 * (lane + 64 * j));
            u32x2 w; w.x = pk2(v[j].x * rs * (1.f + sc.x) + sh.x, v[j].y * rs * (1.f + sc.y) + sh.y); w.y = pk2(v[j].z * rs * (1.f + sc.z) + sh.z, v[j].w * rs * (1.f + sc.w) + sh.w);
            o[lane + 64 * j] = w; }
    }
}

DI void axial_rope64(float& v, int lane, int t, const float* ax) {
    const int axis = lane >> 5, half = (lane >> 4) & 1, f = lane & 15;
    const int pos = axis == 0 ? (t >> 6) : (t & 63);
    const float c = ax[pos * 16 + f], s = ax[1024 + pos * 16 + f];
    const float other = __shfl_xor(v, 16);
    v = half == 0 ? (v * c - other * s) : (v * c + other * s);
}
constexpr int NPOS = C + S;
DI int pos_row(int b, int p) { return p < C ? MLAT + b * C + p : b * S + (p - C); }
struct V8 { float v[8]; };
DI V8 ld8bf(const bf16_t* p) { const u32x4 w = *(const u32x4*)p; V8 r; r.v[0] = __uint_as_float(w.x << 16); r.v[1] = __uint_as_float(w.x & 0xffff0000u); r.v[2] = __uint_as_float(w.y << 16); r.v[3] = __uint_as_float(w.y & 0xffff0000u);
    r.v[4] = __uint_as_float(w.z << 16); r.v[5] = __uint_as_float(w.z & 0xffff0000u); r.v[6] = __uint_as_float(w.w << 16); r.v[7] = __uint_as_float(w.w & 0xffff0000u); return r; }
DI void st8bf(bf16_t* p, const V8& x) { u32x4 w; w.x = cvt_pk(x.v[0], x.v[1]); w.y = cvt_pk(x.v[2], x.v[3]); w.z = cvt_pk(x.v[4], x.v[5]); w.w = cvt_pk(x.v[6], x.v[7]); *(u32x4*)p = w; }
DI void chunk_norm_rope(V8& x, const float* gain8, int lane, int t, const float* ax, float scale) {
    float ss = 0.f;
#pragma unroll
    for (int i = 0; i < 8; ++i) ss += x.v[i] * x.v[i];
    ss += __shfl_xor(ss, 1); ss += __shfl_xor(ss, 2); ss += __shfl_xor(ss, 4);
    const float rs = (1.f / sqrtf(ss * (1.f / 64.f) + EPS)) * scale;
#pragma unroll
    for (int i = 0; i < 8; ++i) x.v[i] *= rs * gain8[i];
    if (t >= 0) {
        const int l7 = lane & 7, axis = l7 >> 2, half = (l7 >> 1) & 1, f0 = 8 * (l7 & 1); const int pos = axis == 0 ? (t >> 6) : (t & 63);
        const f32x4 c0 = *(const f32x4*)(ax + pos * 16 + f0), c1 = *(const f32x4*)(ax + pos * 16 + f0 + 4), s0 = *(const f32x4*)(ax + 1024 + pos * 16 + f0), s1 = *(const f32x4*)(ax + 1024 + pos * 16 + f0 + 4);
        const float cc[8] = {c0.x, c0.y, c0.z, c0.w, c1.x, c1.y, c1.z, c1.w}, sn[8] = {s0.x, s0.y, s0.z, s0.w, s1.x, s1.y, s1.z, s1.w};
#pragma unroll
        for (int i = 0; i < 8; ++i) { const float o = __shfl_xor(x.v[i], 2); x.v[i] = half == 0 ? (x.v[i] * cc[i] - o * sn[i]) : (x.v[i] * cc[i] + o * sn[i]); }
    }
}
DI void ph_prep0(const Args& a, float* lds, int bid, int nb) {
    const int tid = otid(); const int lane = tid & 63, wv = tid >> 6;
    const bf16_t* U = (const bf16_t*)(a.ws + WS_UA);
    bf16_t* QP = (bf16_t*)(a.ws + WS_XN); bf16_t* KP = (bf16_t*)(a.ws + WS_ATT); bf16_t* VT = KP + (size_t)32 * 2 * NPOS * 64;
    bf16_t* vs = (bf16_t*)lds;
    const float* axt = (const float*)(a.ws + WS_TRIG);
    float gq8[8], gk8[8];
#pragma unroll
    for (int i = 0; i < 8; ++i) { gq8[i] = a.in[I_DAQN][8 * (lane & 7) + i]; gk8[i] = a.in[I_DAKN][8 * (lane & 7) + i]; }
    const int hd = lane >> 4, map = (lane >> 3) & 1, e0 = 8 * (lane & 7);
    for (int it = bid; it < NB * 72; it += nb) {
        const int b = it / 72, ch = it % 72, p0 = ch * 32;
        __syncthreads();
#pragma unroll
        for (int i = 0; i < 4; ++i) { const int c = tid + 512 * i, pp = c >> 6, part = c & 63;
            const u32x4 w = *(const u32x4*)(U + (size_t)pos_row(b, p0 + pp) * 1536 + 1024 + part * 8);
            unsigned* d = (unsigned*)(vs + pp * 514 + part * 8); d[0] = w.x; d[1] = w.y; d[2] = w.z; d[3] = w.w; }
        V8 xq[4], xk[4];
#pragma unroll
        for (int q = 0; q < 4; ++q) { const bf16_t* ur = U + (size_t)pos_row(b, p0 + wv + 8 * q) * 1536 + 8 * lane; xq[q] = ld8bf(ur); xk[q] = ld8bf(ur + 512); }
#pragma unroll
        for (int q = 0; q < 4; ++q) { const int p = p0 + wv + 8 * q; const int t = p >= C ? p - C : -1;
            chunk_norm_rope(xq[q], gq8, lane, t, axt, 0.125f * 1.4426950408889634f); chunk_norm_rope(xk[q], gk8, lane, t, axt, 1.f);
            const size_t o = ((size_t)((b * 4 + hd) * 2 + map) * NPOS + p) * 64 + e0;
            st8bf(QP + o, xq[q]); st8bf(KP + o, xk[q]); }
        __syncthreads();
        { unsigned w[16];
#pragma unroll
          for (int i = 0; i < 16; ++i) { const unsigned lo = vs[(2 * i) * 514 + tid], hi = vs[(2 * i + 1) * 514 + tid]; w[i] = lo | (hi << 16); }
          u32x4* d = (u32x4*)(VT + ((size_t)(b * 4 + (tid >> 7)) * 128 + (tid & 127)) * NPOS + p0);
#pragma unroll
          for (int i = 0; i < 4; ++i) { u32x4 o = {w[4 * i], w[4 * i + 1], w[4 * i + 2], w[4 * i + 3]}; d[i] = o; } }
    }
}

typedef short bf16x8 __attribute__((ext_vector_type(8)));
typedef short s16x4 __attribute__((ext_vector_type(4)));
typedef float f32x16 __attribute__((ext_vector_type(16)));
#define MFMA32(a, b, c) __builtin_amdgcn_mfma_f32_32x32x16_bf16((a), (b), (c), 0, 0, 0)
DI int crow16(int i, int hh) { return (i & 3) + 8 * (i >> 2) + 4 * hh; }
DI bf16x8 pack8(const f32x16& x, int s) {
    u32x4 p; p.x = cvt_pk(x[8 * s], x[8 * s + 1]); p.y = cvt_pk(x[8 * s + 2], x[8 * s + 3]); p.z = cvt_pk(x[8 * s + 4], x[8 * s + 5]); p.w = cvt_pk(x[8 * s + 6], x[8 * s + 7]);
    return __builtin_bit_cast(bf16x8, p);
}
#define LDS_READ8_B128(addr, r, o0, o1, o2, o3, o4, o5, o6, o7) asm volatile( \
    "ds_read_b128 %0, %8 offset:" #o0 "\n\tds_read_b128 %1, %8 offset:" #o1 "\n\tds_read_b128 %2, %8 offset:" #o2 "\n\tds_read_b128 %3, %8 offset:" #o3 "\n\t" \
    "ds_read_b128 %4, %8 offset:" #o4 "\n\tds_read_b128 %5, %8 offset:" #o5 "\n\tds_read_b128 %6, %8 offset:" #o6 "\n\tds_read_b128 %7, %8 offset:" #o7 \
    : "=&v"(r[0]), "=&v"(r[1]), "=&v"(r[2]), "=&v"(r[3]), "=&v"(r[4]), "=&v"(r[5]), "=&v"(r[6]), "=&v"(r[7]) : "v"(addr) : "memory")
#define LDS_READ8_B64(addr, r, o0, o1, o2, o3, o4, o5, o6, o7) asm volatile( \
    "ds_read_b64 %0, %8 offset:" #o0 "\n\tds_read_b64 %1, %8 offset:" #o1 "\n\tds_read_b64 %2, %8 offset:" #o2 "\n\tds_read_b64 %3, %8 offset:" #o3 "\n\t" \
    "ds_read_b64 %4, %8 offset:" #o4 "\n\tds_read_b64 %5, %8 offset:" #o5 "\n\tds_read_b64 %6, %8 offset:" #o6 "\n\tds_read_b64 %7, %8 offset:" #o7 \
    : "=&v"(r[0]), "=&v"(r[1]), "=&v"(r[2]), "=&v"(r[3]), "=&v"(r[4]), "=&v"(r[5]), "=&v"(r[6]), "=&v"(r[7]) : "v"(addr) : "memory")
#define LDS_WAIT8(r) asm volatile("s_waitcnt lgkmcnt(0)" : "+v"(r[0]), "+v"(r[1]), "+v"(r[2]), "+v"(r[3]), "+v"(r[4]), "+v"(r[5]), "+v"(r[6]), "+v"(r[7]) :: "memory")
DI void ph_diffattn(const Args& a, unsigned char* lds, int bid, int nb) {
    const int tid = otid(); const int lane = tid & 63, wv = tid >> 6, q32 = lane & 31, hh = lane >> 5, qsub = wv >> 1, map = wv & 1;
    const bf16_t* QP = (const bf16_t*)(a.ws + WS_XN); const bf16_t* KP = (const bf16_t*)(a.ws + WS_ATT); const bf16_t* VT = KP + (size_t)32 * 2 * NPOS * 64;
    bf16_t* MIX = (bf16_t*)(a.ws + WS_MIX);
    constexpr int KBUF = 2 * 64 * 144, VBUF = 128 * 136, TBUF = KBUF + VBUF;
    unsigned char* xbuf = lds + 36864;
    static_assert(2 * KBUF + 3 * VBUF <= 36864 + 65536, "lds");
    const float* lp = a.in[I_DALAM];
    const float lam_init = 0.2f;
    const float lam = expf(wave_sum(lp[lane] * lp[64 + lane])) - expf(wave_sum(lp[128 + lane] * lp[192 + lane])) + lam_init;
    const bool xg = (nb % 8) == 0 && nb >= 8; const int xq = xg ? bid & 7 : 0, xj = xg ? bid >> 3 : bid, xn = xg ? nb >> 3 : nb, nxu = xg ? 72 : 576;
    for (int ui = xj; ui < nxu; ui += xn) {
        int bh, qb;
        if (xg) { if (ui < 64) { bh = xq + 8 * (ui >> 4); qb = 2 + (ui & 15); } else { bh = xq + 8 * ((ui - 64) >> 1); qb = (ui - 64) & 1; } }
        else { if (ui < 512) { bh = ui >> 4; qb = 2 + (ui & 15); } else { bh = (ui - 512) >> 1; qb = (ui - 512) & 1; } }
        const int b = bh >> 2, h = bh & 3; const int nt = qb < 2 ? 4 : 36;
        bf16x8 qf[4];
        { const bf16_t* qg = QP + ((size_t)(bh * 2 + map) * NPOS + qb * 128 + qsub * 32 + q32) * 64 + 8 * hh;
#pragma unroll
          for (int ks = 0; ks < 4; ++ks) qf[ks] = *(const bf16x8*)(qg + 16 * ks); }
        const bf16_t* Kg = KP + (size_t)(bh * 2) * NPOS * 64; const bf16_t* Vg = VT + (size_t)bh * 128 * NPOS;
        u32x4 st[4];
        auto gloadk = [&](int t) {
#pragma unroll
            for (int i = 0; i < 2; ++i) { const int c = tid + 512 * i; st[i] = *(const u32x4*)(Kg + ((size_t)(c >> 9) * NPOS + t * 64 + ((c >> 3) & 63)) * 64 + (c & 7) * 8); } };
        auto gloadv = [&](int t) {
#pragma unroll
            for (int i = 0; i < 2; ++i) { const int c = tid + 512 * i; st[2 + i] = *(const u32x4*)(Vg + (size_t)(c >> 3) * NPOS + t * 64 + (c & 7) * 8); } };
        auto lstorek = [&](int kbuf) { unsigned char* kb = lds + kbuf * KBUF;
#pragma unroll
            for (int i = 0; i < 2; ++i) { const int c = tid + 512 * i; *(u32x4*)(kb + (c >> 9) * (64 * 144) + ((c >> 3) & 63) * 144 + (c & 7) * 16) = st[i]; } };
        auto lstorev = [&](int vbuf_) { unsigned char* vb = lds + 2 * KBUF + vbuf_ * VBUF;
#pragma unroll
            for (int i = 0; i < 2; ++i) { const int c = tid + 512 * i; u32x2* d = (u32x2*)(vb + (c >> 3) * 136 + (c & 7) * 16); u32x2 lo = {st[2 + i].x, st[2 + i].y}, hi = {st[2 + i].z, st[2 + i].w}; d[0] = lo; d[1] = hi; } };
        auto gload = [&](int t) { gloadk(t); gloadv(t); };
        auto lstore = [&](int kbuf, int vbuf_) { lstorek(kbuf); lstorev(vbuf_); };
        __syncthreads();
        gload(0); lstore(0, 0);
        __syncthreads();
        f32x16 O[4];
#pragma unroll
        for (int d = 0; d < 4; ++d)
#pragma unroll
            for (int i = 0; i < 16; ++i) O[d][i] = 0.f;
        float m_run = -1e30f, l_run = 0.f;
        const unsigned lds0 = (unsigned)(size_t)lds;
        for (int t = 0; t < nt; ++t) {
            if (t + 1 < nt) gload(t + 1);
            const unsigned kaddr = lds0 + (t & 1) * KBUF + map * (64 * 144) + q32 * 144 + 16 * hh;
            const unsigned vaddr = lds0 + 2 * KBUF + (t & 1) * VBUF + q32 * 136 + 8 * hh;
            bf16x8 kf[8];
            LDS_READ8_B128(kaddr, kf, 0, 32, 64, 96, 4608, 4640, 4672, 4704);
            LDS_WAIT8(kf);
            f32x16 S0, S1;
#pragma unroll
            for (int i = 0; i < 16; ++i) { S0[i] = 0.f; S1[i] = 0.f; }
#pragma unroll
            for (int ks = 0; ks < 4; ++ks) { S0 = MFMA32(kf[ks], qf[ks], S0); S1 = MFMA32(kf[4 + ks], qf[ks], S1); }
            s16x4 va[8], vb2[8];
            LDS_READ8_B64(vaddr, va, 0, 16, 32, 48, 64, 80, 96, 112);
            float mx = S0[0];
#pragma unroll
            for (int i = 1; i < 16; ++i) mx = fmaxf(mx, S0[i]);
#pragma unroll
            for (int i = 0; i < 16; ++i) mx = fmaxf(mx, S1[i]);
            mx = fmaxf(mx, __shfl_xor(mx, 32));
            const float m_new = fmaxf(m_run, mx); const float alpha = __builtin_amdgcn_exp2f(m_run - m_new); m_run = m_new;
            float rsum = 0.f;
#pragma unroll
            for (int i = 0; i < 16; ++i) { S0[i] = __builtin_amdgcn_exp2f(S0[i] - m_new); S1[i] = __builtin_amdgcn_exp2f(S1[i] - m_new); rsum += S0[i] + S1[i]; }
            rsum += __shfl_xor(rsum, 32);
            l_run = l_run * alpha + rsum;
            if (!__all(alpha == 1.f)) {
#pragma unroll
            for (int d = 0; d < 4; ++d)
#pragma unroll
                for (int i = 0; i < 16; ++i) O[d][i] *= alpha; }
            const bf16x8 p00 = pack8(S0, 0), p01 = pack8(S0, 1), p10 = pack8(S1, 0), p11 = pack8(S1, 1);
#define PV_BLOCK(d, cur, nxt, has_next) do { LDS_WAIT8(cur); if (has_next) { LDS_READ8_B64(vaddr + ((d) + 1) * (32 * 136), nxt, 0, 16, 32, 48, 64, 80, 96, 112); } \
            O[d] = MFMA32(__builtin_shufflevector(cur[0], cur[1], 0, 1, 2, 3, 4, 5, 6, 7), p00, O[d]); O[d] = MFMA32(__builtin_shufflevector(cur[2], cur[3], 0, 1, 2, 3, 4, 5, 6, 7), p01, O[d]); \
            O[d] = MFMA32(__builtin_shufflevector(cur[4], cur[5], 0, 1, 2, 3, 4, 5, 6, 7), p10, O[d]); O[d] = MFMA32(__builtin_shufflevector(cur[6], cur[7], 0, 1, 2, 3, 4, 5, 6, 7), p11, O[d]); } while (0)
            PV_BLOCK(0, va, vb2, true); PV_BLOCK(1, vb2, va, true); PV_BLOCK(2, va, vb2, true); PV_BLOCK(3, vb2, va, false);
#undef PV_BLOCK
            if (t + 1 < nt) lstore((t + 1) & 1, (t + 1) & 1);
            __syncthreads();
        }
        float* xb = (float*)xbuf + qsub * (128 * 32);
        if (map == 1) { const float sc = lam / l_run;
#pragma unroll
            for (int d = 0; d < 4; ++d)
#pragma unroll
                for (int i = 0; i < 16; ++i) xb[(32 * d + crow16(i, hh)) * 32 + q32] = O[d][i] * sc; }
        __syncthreads();
        bf16_t* ob = (bf16_t*)lds;
        if (map == 0) { const float sc = 1.f / l_run; float ss = 0.f;
#pragma unroll
            for (int d = 0; d < 4; ++d)
#pragma unroll
                for (int i = 0; i < 16; ++i) { const float o = O[d][i] * sc - xb[(32 * d + crow16(i, hh)) * 32 + q32]; O[d][i] = o; ss += o * o; }
            ss += __shfl_xor(ss, 32);
            const float rs = (1.f / sqrtf(ss * (1.f / 128.f) + EPS)) * (1.f - lam_init);
#pragma unroll
            for (int d = 0; d < 4; ++d)
#pragma unroll
                for (int i = 0; i < 16; ++i) { const int dv = 32 * d + crow16(i, hh); ob[(qsub * 32 + q32) * 136 + dv] = (bf16_t)f2bf(O[d][i] * rs * a.in[I_DASUB][dv]); } }
        __syncthreads();
#pragma unroll
        for (int i = 0; i < 4; ++i) { const int c = tid + 512 * i, qq = c >> 4, part = c & 15;
            const u32x2* s = (const u32x2*)(ob + qq * 136 + part * 8); const u32x2 lo = s[0], hi = s[1]; u32x4 w = {lo.x, lo.y, hi.x, hi.y};
            *(u32x4*)(MIX + (size_t)pos_row(b, qb * 128 + qq) * D + 512 + h * 128 + part * 8) = w; }
    }
}

template <int L>
DI void hyena_channel(unsigned char* lds, const bf16_t* uv, const bf16_t* ux1, const bf16_t* ux2, int bstride, const bf16_t* G0, const bf16_t* G1,
                      const float* cw, const float* cb, int ch, float bias0, float bias1, bf16_t* yout) {
    constexpr int NA = L / 32, RS = (L + 192) * 2 + 16, FL = 2 * L + 8, NP = NA / 8;
    unsigned char* bufA = lds; unsigned char* bufB = lds + 8 * RS; unsigned char* bufC = lds + 16 * RS; bf16_t* filt = (bf16_t*)(bufC + 8 * L * 2);
    const int tid = otid(); const int lane = tid & 63, wv = tid >> 6, q32 = lane & 31, hh = lane >> 5;
    __syncthreads();
    for (int c = tid; c < 2 * 8 * 25; c += NTHR) { const int bf = c / 200, r = (c % 200) / 25, k = c % 25;
        unsigned char* row = (bf ? bufB : bufA) + r * RS; u32x4 z = {0u, 0u, 0u, 0u};
        *(u32x4*)(row + (k < 12 ? k * 16 : 192 + L * 2 + (k - 12) * 16)) = z; }
#pragma unroll
    for (int q = 0; q < 3; ++q) {
        const bf16_t* src = q == 0 ? uv : q == 1 ? ux1 : ux2;
        const float w0 = cw[q * 512 + ch], w1 = cw[1536 + q * 512 + ch], w2 = cw[3072 + q * 512 + ch], bb = cb[q * 512 + ch];
        for (int c = tid; c < L; c += NTHR) { const int b = c / (L / 8), tc = (c % (L / 8)) * 8; const bf16_t* sp = src + (size_t)b * bstride + tc;
            const u32x4 w = *(const u32x4*)sp; float x[10];
            x[0] = tc > 0 ? bf2f(sp[-1]) : 0.f; x[9] = tc + 8 < L ? bf2f(sp[8]) : 0.f;
            x[1] = __uint_as_float(w.x << 16); x[2] = __uint_as_float(w.x & 0xffff0000u); x[3] = __uint_as_float(w.y << 16); x[4] = __uint_as_float(w.y & 0xffff0000u);
            x[5] = __uint_as_float(w.z << 16); x[6] = __uint_as_float(w.z & 0xffff0000u); x[7] = __uint_as_float(w.w << 16); x[8] = __uint_as_float(w.w & 0xffff0000u);
            u32x4 o; o.x = pk2(w0 * x[0] + w1 * x[1] + w2 * x[2] + bb, w0 * x[1] + w1 * x[2] + w2 * x[3] + bb); o.y = pk2(w0 * x[2] + w1 * x[3] + w2 * x[4] + bb, w0 * x[3] + w1 * x[4] + w2 * x[5] + bb);
            o.z = pk2(w0 * x[4] + w1 * x[5] + w2 * x[6] + bb, w0 * x[5] + w1 * x[6] + w2 * x[7] + bb); o.w = pk2(w0 * x[6] + w1 * x[7] + w2 * x[8] + bb, w0 * x[7] + w1 * x[8] + w2 * x[9] + bb);
            unsigned char* d = q == 2 ? bufC + (b * L + tc) * 2 : (q == 0 ? bufA : bufB) + b * RS + (96 + tc) * 2;
            *(u32x4*)d = o; }
    }
#pragma unroll 1
    for (int n = 0; n < 2; ++n) {
        __syncthreads();
        { const bf16_t* G = n == 0 ? G0 : G1;
          for (int c = tid; c < 2 * (L / 8); c += NTHR) { const int dir = c / (L / 8), l0 = (c % (L / 8)) * 8;
              const u32x4 w = *(const u32x4*)(G + (size_t)dir * 512 * L + l0); const unsigned ww[4] = {w.x, w.y, w.z, w.w};
#pragma unroll
              for (int e = 0; e < 8; ++e) { const bf16_t val = (bf16_t)(e & 1 ? ww[e >> 1] >> 16 : ww[e >> 1] & 0xffffu); const int lag = l0 + e;
                  if (dir == 0 || lag > 0) { const int kb = dir == 0 ? L - lag : L + lag;
#pragma unroll
                      for (int r = 0; r < 4; ++r) { const int k = kb - r; if (k >= 0) filt[r * FL + k] = val; } } } }
          for (int c = tid; c < 4 * 16; c += NTHR) { const int r = c >> 4, q = c & 15; const int k = q < 12 ? 2 * L - r + q : 0; if (q < 12 ? k < FL : r == 0) filt[r * FL + k] = 0; } }
        __syncthreads();
        const unsigned char* zin = n == 0 ? bufA : bufB;
        const float bias = n == 0 ? bias0 : bias1;
        for (int pr = wv; pr < NP; pr += NWAVES) {
            const int A0 = 8 * pr, bcol = q32 >> 2, al = q32 & 3;
            f32x16 acc0, acc1;
#pragma unroll
            for (int i = 0; i < 16; ++i) { acc0[i] = 0.f; acc1[i] = 0.f; }
            const unsigned char* zrow = zin + bcol * RS + (96 + 32 * al + 8 * hh) * 2;
#pragma unroll 2
            for (int d = A0 - (NA - 1); d <= A0 + 7; ++d) {
                const int X0 = 8 * hh - q32 - 32 * d + L, r = X0 & 3;
                const unsigned char* fp = (const unsigned char*)(filt + r * FL + (X0 - r));
                const s16x4 f0 = *(const s16x4*)fp, f1 = *(const s16x4*)(fp + 8), f2 = *(const s16x4*)(fp + 32), f3 = *(const s16x4*)(fp + 40);
                const bf16x8 a0 = __builtin_shufflevector(f0, f1, 0, 1, 2, 3, 4, 5, 6, 7), a1 = __builtin_shufflevector(f2, f3, 0, 1, 2, 3, 4, 5, 6, 7);
                const int ap0 = A0 - d, ap1 = ap0 + 4;
                if (ap0 >= -3 && ap0 <= NA - 1) { const unsigned char* zp = zrow + ap0 * 64; acc0 = MFMA32(a0, *(const bf16x8*)zp, acc0); acc0 = MFMA32(a1, *(const bf16x8*)(zp + 32), acc0); }
                if (ap1 >= -3 && ap1 <= NA - 1) { const unsigned char* zp = zrow + ap1 * 64; acc1 = MFMA32(a0, *(const bf16x8*)zp, acc1); acc1 = MFMA32(a1, *(const bf16x8*)(zp + 32), acc1); }
            }
#pragma unroll
            for (int hb = 0; hb < 2; ++hb)
#pragma unroll
                for (int i = 0; i < 16; ++i) { const int t = 32 * (A0 + 4 * hb + al) + crow16(i, hh);
                    const float zv = bf2f(*(const bf16_t*)(zin + bcol * RS + (96 + t) * 2));
                    bf16_t* gp = (bf16_t*)(n == 0 ? bufB + bcol * RS + (96 + t) * 2 : bufC + (bcol * L + t) * 2);
                    *gp = (bf16_t)f2bf(bf2f(*gp) * ((hb ? acc1[i] : acc0[i]) + bias * zv)); }
        }
    }
    __syncthreads();
    for (int c = tid; c < L; c += NTHR) { const int b = c / (L / 8), tc = (c % (L / 8)) * 8; *(u32x4*)(yout + (size_t)b * bstride + tc) = *(const u32x4*)(bufC + (b * L + tc) * 2); }
}
DI void ph_hyena(const Args& a, unsigned char* lds, int bid, int nb, bool dummy = false) {
    bf16_t* UT = (bf16_t*)(a.ws + WS_UT);
    const float* cw = a.in[I_HYCW]; const float* cb = a.in[I_HYCB];
    for (int ch = bid; ch < 512; ch += nb) {
        bf16_t* rv = UT + (size_t)ch * MALL; const bf16_t* r1 = UT + (size_t)(512 + ch) * MALL; const bf16_t* r2 = UT + (size_t)(1024 + ch) * MALL;
        const float b0 = a.in[I_HYBIAS][ch], b1 = a.in[I_HYBIAS][512 + ch];
        bf16_t* dm = (bf16_t*)(a.ws + WS_ATT + 38 * MiB) + (size_t)bid * MALL;
        hyena_channel<S>(lds, rv, r1, r2, S, (const bf16_t*)(a.ws + WS_HFL) + (size_t)ch * S, (const bf16_t*)(a.ws + WS_HFL) + (size_t)(1024 + ch) * S, cw, cb, ch, b0, b1, dummy ? dm : rv);
        hyena_channel<C>(lds, rv + MLAT, r1 + MLAT, r2 + MLAT, C, (const bf16_t*)(a.ws + WS_HFC) + (size_t)ch * C, (const bf16_t*)(a.ws + WS_HFC) + (size_t)(1024 + ch) * C, cw, cb, ch, b0, b1, dummy ? dm + MLAT : rv + MLAT);
    }
}
DI void ph_hy_transpose(const Args& a, float* lds, int bid, int nb) {
    const int tid = otid();
    const bf16_t* UT = (const bf16_t*)(a.ws + WS_UT); bf16_t* MIX = (bf16_t*)(a.ws + WS_MIX);
    bf16_t* ts = (bf16_t*)lds;
    for (int it = bid; it < (MALL / 64) * 8; it += nb) {
        const int mt = it >> 3, ct = it & 7, m0 = mt * 64, c0 = ct * 64;
        __syncthreads();
        { const int chl = tid >> 3, part = tid & 7; const u32x4 w = *(const u32x4*)(UT + (size_t)(c0 + chl) * MALL + m0 + part * 8);
          unsigned* d = (unsigned*)(ts + chl * 66 + part * 8); d[0] = w.x; d[1] = w.y; d[2] = w.z; d[3] = w.w; }
        __syncthreads();
        { const int ml = tid >> 3, part = tid & 7; unsigned w[4];
#pragma unroll
          for (int q = 0; q < 4; ++q) { const unsigned lo = ts[(part * 8 + 2 * q) * 66 + ml], hi = ts[(part * 8 + 2 * q + 1) * 66 + ml]; w[q] = lo | (hi << 16); }
          u32x4 o = {w[0], w[1], w[2], w[3]}; *(u32x4*)(MIX + (size_t)(m0 + ml) * D + c0 + part * 8) = o; }
    }
}

constexpr int CW_CNT = 8192;
constexpr int MOE_MAXT = 176;
typedef float f32x16v __attribute__((ext_vector_type(16)));
DI void ph_route(const Args& a, float* lds, int bid, int nb, int l, int nrows, bool dummy = false) {
    const int tid = otid(); const int lane = tid & 63, wv = tid >> 6, i32 = lane & 31, kh = lane >> 5;
    const float* mod = (const float*)(a.ws + WS_MOD) + (size_t)l * 9 * 6144;
    const float* wgrp = a.in[I_MWGRP] + (size_t)l * D * 4; const float* bgrp = a.in[I_MBGRP] + l * 4;
    const float* wrt = a.in[I_MWRT] + (size_t)l * D * 32; const float* brt = a.in[I_MBRT] + l * 32;
    bf16_t* XN = (bf16_t*)(a.ws + WS_XN);
    unsigned* cnt = (unsigned*)(a.ws + WS_CTL) + CW_CNT + (dummy ? 2 : l) * 32 * 64;
    int* tok_e = (int*)(a.ws + (dummy ? WS_ROWW + 256 * 1024 : WS_TOK)); int* tok_pos = tok_e + 2 * MALL;
    int* elist = (int*)(a.ws + WS_ELIST) + (dummy ? (size_t)64 * MALL : 0); float* wlist = (float*)(a.ws + WS_ELIST) + (size_t)32 * MALL + (dummy ? (size_t)64 * MALL : 0);
    float* tile = lds + wv * (32 * 33);
    float* red = lds + 8 * (32 * 33);
    float* rsl = red + 8 * 32 * 37;
    for (int tl = bid; tl < nrows / 32; tl += nb) {
        const int m0 = tl * 32; const float* mr = mod + (size_t)mod_row(m0) * 6144;
        __syncthreads();
        { f32x4 v[4][4];
#pragma unroll
          for (int q = 0; q < 4; ++q) { const f32x4* rp = (const f32x4*)row_ptr(a, m0 + 4 * wv + q);
#pragma unroll
              for (int j = 0; j < 4; ++j) v[q][j] = rp[lane + 64 * j]; }
#pragma unroll
          for (int q = 0; q < 4; ++q) { const int m = m0 + 4 * wv + q; float s = 0.f;
#pragma unroll
              for (int j = 0; j < 4; ++j) s += v[q][j].x * v[q][j].x + v[q][j].y * v[q][j].y + v[q][j].z * v[q][j].z + v[q][j].w * v[q][j].w;
              s = wave_sum(s);
              const float rs = 1.f / sqrtf(s * (1.f / D) + EPS);
              if (lane == 0) rsl[4 * wv + q] = rs;
              if (!dummy) { u32x2* o = (u32x2*)(XN + (size_t)m * D);
#pragma unroll
                  for (int j = 0; j < 4; ++j) { const f32x4 sh = *(const f32x4*)(mr + 3072 + 4 * (lane + 64 * j)), sc = *(const f32x4*)(mr + 4096 + 4 * (lane + 64 * j));
                      u32x2 w; w.x = pk2(v[q][j].x * rs * (1.f + sc.x) + sh.x, v[q][j].y * rs * (1.f + sc.y) + sh.y); w.y = pk2(v[q][j].z * rs * (1.f + sc.z) + sh.z, v[q][j].w * rs * (1.f + sc.w) + sh.w); o[lane + 64 * j] = w; } } } }
        __syncthreads();
        f32x16v acc;
#pragma unroll
        for (int i = 0; i < 16; ++i) acc[i] = 0.f;
        float g0 = 0.f, g1 = 0.f, g2 = 0.f, g3 = 0.f;
        const int srow = lane >> 3, sf4 = lane & 7;
        float rs_it[4];
#pragma unroll
        for (int it = 0; it < 4; ++it) rs_it[it] = rsl[srow + 8 * it];
#pragma unroll 1
        for (int kc = 0; kc < 4; ++kc) {
            const int k0 = wv * 128 + kc * 32 + 4 * sf4;
            const f32x4 sh = *(const f32x4*)(mr + 3072 + k0), sc = *(const f32x4*)(mr + 4096 + k0);
            f32x4 xv[4];
#pragma unroll
            for (int it = 0; it < 4; ++it) xv[it] = *(const f32x4*)(row_ptr(a, m0 + srow + 8 * it) + k0);
            __builtin_amdgcn_wave_barrier();
#pragma unroll
            for (int it = 0; it < 4; ++it) { float* tp = tile + (srow + 8 * it) * 33 + 4 * sf4; const float rs = rs_it[it]; const f32x4 x = xv[it];
                tp[0] = x.x * rs * (1.f + sc.x) + sh.x; tp[1] = x.y * rs * (1.f + sc.y) + sh.y; tp[2] = x.z * rs * (1.f + sc.z) + sh.z; tp[3] = x.w * rs * (1.f + sc.w) + sh.w; }
            __builtin_amdgcn_wave_barrier();
#pragma unroll 4
            for (int s = 0; s < 16; ++s) { const int k = wv * 128 + kc * 32 + 2 * s + kh;
                const float av = tile[i32 * 33 + 2 * s + kh]; const float bv = wrt[(size_t)k * 32 + i32];
                acc = __builtin_amdgcn_mfma_f32_32x32x2f32(av, bv, acc, 0, 0, 0);
                const f32x4 wg = *(const f32x4*)(wgrp + (size_t)k * 4);
                g0 += av * wg.x; g1 += av * wg.y; g2 += av * wg.z; g3 += av * wg.w; }
        }
        g0 += __shfl_xor(g0, 32); g1 += __shfl_xor(g1, 32); g2 += __shfl_xor(g2, 32); g3 += __shfl_xor(g3, 32);
        float* rw = red + wv * (32 * 37);
#pragma unroll
        for (int i = 0; i < 16; ++i) rw[crow16(i, kh) * 37 + i32] = acc[i];
        if (lane < 32) { rw[lane * 37 + 32] = g0; rw[lane * 37 + 33] = g1; rw[lane * 37 + 34] = g2; rw[lane * 37 + 35] = g3; }
        __syncthreads();
        if (tid < 32) {
            float gl[4];
#pragma unroll
            for (int q = 0; q < 4; ++q) { float s = bgrp[q];
#pragma unroll
                for (int w = 0; w < 8; ++w) s += red[w * (32 * 37) + tid * 37 + 32 + q]; gl[q] = s; }
            int g = 0; float gm = gl[0];
            if (gl[1] > gm) { gm = gl[1]; g = 1; } if (gl[2] > gm) { gm = gl[2]; g = 2; } if (gl[3] > gm) { gm = gl[3]; g = 3; }
            const float pg = 1.f / (expf(gl[0] - gm) + expf(gl[1] - gm) + expf(gl[2] - gm) + expf(gl[3] - gm));
            float le[8];
#pragma unroll
            for (int i = 0; i < 8; ++i) { float s = brt[8 * g + i];
#pragma unroll
                for (int w = 0; w < 8; ++w) s += red[w * (32 * 37) + tid * 37 + 8 * g + i]; le[i] = s; }
            int e0 = 0; float v0 = le[0];
#pragma unroll
            for (int i = 1; i < 8; ++i) if (le[i] > v0) { v0 = le[i]; e0 = i; }
            int e1 = -1; float v1 = -3.4e38f;
#pragma unroll
            for (int i = 0; i < 8; ++i) if (i != e0 && le[i] > v1) { v1 = le[i]; e1 = i; }
            const float p1 = expf(v1 - v0); const float w0 = pg / (1.f + p1), w1 = pg * p1 / (1.f + p1);
            const int m = m0 + tid; const int E0 = g * 8 + e0, E1 = g * 8 + e1;
            const unsigned q0 = __hip_atomic_fetch_add(cnt + E0 * 64, 1u, __ATOMIC_RELAXED, __HIP_MEMORY_SCOPE_AGENT);
            const unsigned q1 = __hip_atomic_fetch_add(cnt + E1 * 64, 1u, __ATOMIC_RELAXED, __HIP_MEMORY_SCOPE_AGENT);
            tok_e[2 * m] = E0; tok_e[2 * m + 1] = E1; tok_pos[2 * m] = (int)q0; tok_pos[2 * m + 1] = (int)q1;
            elist[(size_t)E0 * MALL + q0] = m; elist[(size_t)E1 * MALL + q1] = m; wlist[(size_t)E0 * MALL + q0] = w0; wlist[(size_t)E1 * MALL + q1] = w1;
        }
    }
}
DI void moe_tables(const Args& a, int* tab, int l, int tid) {
    const unsigned* cnt = (const unsigned*)(a.ws + WS_CTL) + CW_CNT + l * 32 * 64;
    if (tid == 0) { int t = 0; for (int e = 0; e < 32; ++e) { tab[e] = t; const int c = (int)__hip_atomic_load(cnt + e * 64, __ATOMIC_RELAXED, __HIP_MEMORY_SCOPE_AGENT); tab[33 + MOE_MAXT + e] = c; const int nt = (c + 255) >> 8; for (int i = 0; i < nt; ++i) tab[33 + t + i] = e; t += nt; } tab[32] = t; }
    __syncthreads();
}
template <int NPN> struct MoeOrder {
    const int* tab; int G, c; const int* elist;
    __device__ __forceinline__ unsigned rowoff(const pg8::Unit& u, int r) const { const int e = tab[33 + u.pm], s = (u.pm - tab[e]) * 256 + r; const int tok = s < tab[33 + MOE_MAXT + e] ? elist[(size_t)e * MALL + s] : 0; return (unsigned)tok * (unsigned)(D * 2); }
    __device__ bool next(int i, pg8::Unit& u) const { const int L = i * G + c; if (L >= tab[32] * NPN) return false; u.pm = L / NPN; u.pn = tab[33 + u.pm] * NPN + (L % NPN); return true; }
    __device__ __forceinline__ void a_ready(const pg8::Unit&) const {}
    __device__ __forceinline__ void done(const pg8::Unit&) const {}
};
struct EpiSwiGLU {
    static constexpr bool PERM = true, AFTER_DRAIN = false;
    bf16_t* H; const float* wlist; const int* tab;
    __device__ __forceinline__ void operator()(const f32x4 (&acc)[2][2][4][2], const pg8::Unit& u, int wr, int wc, int fr, int fq) const {
        const int row0 = u.pm * 256 + wr * 64 + fr, col0 = (u.pn & 1) * 128 + wc * 32 + 8 * fq; const int e_ = u.pn >> 1;
#pragma unroll
        for (int ai = 0; ai < 2; ++ai)
#pragma unroll
            for (int m = 0; m < 4; ++m) { const int r = row0 + ai * 128 + m * 16; const int s = r - tab[e_] * 256; const float w = s < tab[33 + MOE_MAXT + e_] ? wlist[(size_t)e_ * MALL + s] : 0.f;
                float hv[8];
#pragma unroll
                for (int n = 0; n < 2; ++n)
#pragma unroll
                    for (int j = 0; j < 4; ++j) { const float g = acc[ai][0][m][n][j], up = acc[ai][1][m][n][j]; hv[4 * n + j] = g / (1.f + __expf(-g)) * up * w; }
                u32x4 o; o.x = cvt_pk(hv[0], hv[1]); o.y = cvt_pk(hv[2], hv[3]); o.z = cvt_pk(hv[4], hv[5]); o.w = cvt_pk(hv[6], hv[7]);
                *(u32x4*)(H + (size_t)r * 256 + col0) = o; }
    }
};
struct EpiStoreY {
    static constexpr bool PERM = true, AFTER_DRAIN = false;
    bf16_t* O;
    __device__ __forceinline__ void operator()(const f32x4 (&acc)[2][2][4][2], const pg8::Unit& u, int wr, int wc, int fr, int fq) const {
        const int row0 = u.pm * 256 + wr * 64 + fr, col0 = (u.pn & 3) * 256 + wc * 32 + 8 * fq;
#pragma unroll
        for (int ai = 0; ai < 2; ++ai)
#pragma unroll
            for (int m = 0; m < 4; ++m) { bf16_t* rowp = O + (size_t)(row0 + ai * 128 + m * 16) * D + col0;
#pragma unroll
                for (int bj = 0; bj < 2; ++bj) { const f32x4 v0 = acc[ai][bj][m][0], v1 = acc[ai][bj][m][1];
                    u32x4 w; w.x = cvt_pk(v0[0], v0[1]); w.y = cvt_pk(v0[2], v0[3]); w.z = cvt_pk(v1[0], v1[1]); w.w = cvt_pk(v1[2], v1[3]);
                    *(u32x4*)(rowp + bj * 128) = w; } }
    }
};
DI void ph_combine(const Args& a, float* lds, int bid, int nb, int l, int nrows, bool next_norm) {
    const int tid = otid(); const int lane = tid & 63, wv = tid >> 6;
    int* tab = (int*)lds; moe_tables(a, tab, l, tid);
    const float* mod = (const float*)(a.ws + WS_MOD) + (size_t)l * 9 * 6144; const float* modn = (const float*)(a.ws + WS_MOD) + (size_t)(l + 1) * 9 * 6144;
    const bf16_t* Y = (const bf16_t*)(a.ws + WS_U); bf16_t* XN = (bf16_t*)(a.ws + WS_XN);
    const int* tok_e = (const int*)(a.ws + WS_TOK); const int* tok_pos = tok_e + 2 * MALL;
    for (int m = bid * NWAVES + wv; m < nrows; m += nb * NWAVES) {
        f32x4* r = (f32x4*)row_ptr_w(a, m); const float* mr = mod + (size_t)mod_row(m) * 6144 + 5120;
        const bf16_t* y0 = Y + (size_t)(tab[tok_e[2 * m]] * 256 + tok_pos[2 * m]) * D; const bf16_t* y1 = Y + (size_t)(tab[tok_e[2 * m + 1]] * 256 + tok_pos[2 * m + 1]) * D;
        f32x4 v[4]; float s = 0.f;
#pragma unroll
        for (int j = 0; j < 4; ++j) { const int c4 = lane + 64 * j; const f32x4 g = *(const f32x4*)(mr + 4 * c4); const f32x4 ya = ld4bf(y0 + 4 * c4), yb = ld4bf(y1 + 4 * c4);
            v[j] = r[c4] + g * (ya + yb); r[c4] = v[j]; s += v[j].x * v[j].x + v[j].y * v[j].y + v[j].z * v[j].z + v[j].w * v[j].w; }
        if (next_norm) {
            s = wave_sum(s); const float rs = 1.f / sqrtf(s * (1.f / D) + EPS);
            const float* mn = modn + (size_t)mod_row(m) * 6144; u32x2* o = (u32x2*)(XN + (size_t)m * D);
#pragma unroll
            for (int j = 0; j < 4; ++j) { const f32x4 sh = *(const f32x4*)(mn + 4 * (lane + 64 * j)), sc = *(const f32x4*)(mn + 1024 + 4 * (lane + 64 * j));
                u32x2 w; w.x = pk2(v[j].x * rs * (1.f + sc.x) + sh.x, v[j].y * rs * (1.f + sc.y) + sh.y); w.y = pk2(v[j].z * rs * (1.f + sc.z) + sh.z, v[j].w * rs * (1.f + sc.w) + sh.w);
                o[lane + 64 * j] = w; }
        }
    }
}

constexpr size_t ATT_KR = 0, ATT_VRT = (size_t)32 * NPOS * 128, ATT_GK = 2 * ATT_VRT, ATT_GVT = ATT_GK + (size_t)16 * NPOS * 64;
constexpr size_t XN_QR = 0, XN_GQ = (size_t)32 * S * 128;
DI void rope1d_8(V8& x, int lane, int t, const float* r1t, float scale) {
    const int d0 = 8 * (lane & 15), f0 = d0 & 63; const bool lo = d0 < 64;
    const f32x4 c0 = *(const f32x4*)(r1t + t * 64 + f0), c1 = *(const f32x4*)(r1t + t * 64 + f0 + 4), s0 = *(const f32x4*)(r1t + S * 64 + t * 64 + f0), s1 = *(const f32x4*)(r1t + S * 64 + t * 64 + f0 + 4);
    const float cc[8] = {c0.x, c0.y, c0.z, c0.w, c1.x, c1.y, c1.z, c1.w}, sn[8] = {s0.x, s0.y, s0.z, s0.w, s1.x, s1.y, s1.z, s1.w};
#pragma unroll
    for (int i = 0; i < 8; ++i) { const float o = __shfl_xor(x.v[i], 8); x.v[i] = (lo ? (x.v[i] * cc[i] - o * sn[i]) : (x.v[i] * cc[i] + o * sn[i])) * scale; }
}
DI void ph_prep1(const Args& a, float* lds, int bid, int nb) {
    const int tid = otid(); const int lane = tid & 63, wv = tid >> 6;
    const bf16_t* U = (const bf16_t*)(a.ws + WS_U);
    bf16_t* XNb = (bf16_t*)(a.ws + WS_XN); bf16_t* ATb = (bf16_t*)(a.ws + WS_ATT);
    bf16_t* vs = (bf16_t*)lds;
    const float* axt = (const float*)(a.ws + WS_TRIG); const float* r1t = axt + 2048;
    float gq8[8], gk8[8];
#pragma unroll
    for (int i = 0; i < 8; ++i) { gq8[i] = a.in[I_GQQN][8 * (lane & 7) + i]; gk8[i] = a.in[I_GQKN][8 * (lane & 7) + i]; }
    const float rscale = 0.08838834764831845f;
    for (int it = bid; it < NB * 72; it += nb) {
        const int b = it / 72, ch = it % 72, p0 = ch * 32; const bool lat = p0 >= C;
        __syncthreads();
#pragma unroll
        for (int i = 0; i < 5; ++i) { const int c = tid + 512 * i, pp = c / 80, part = c % 80;
            const u32x4 w = *(const u32x4*)(U + (size_t)pos_row(b, p0 + pp) * O_IN + (part < 64 ? 1024 + part * 8 : 2688 + (part - 64) * 8));
            unsigned* d = (unsigned*)(vs + pp * 642 + part * 8); d[0] = w.x; d[1] = w.y; d[2] = w.z; d[3] = w.w; }
        V8 xq[4], xk[4], xg[4];
#pragma unroll
        for (int q = 0; q < 4; ++q) { const bf16_t* ur = U + (size_t)pos_row(b, p0 + wv + 8 * q) * O_IN + 8 * lane; xk[q] = ld8bf(ur + 512); if (lat) { xq[q] = ld8bf(ur); xg[q] = ld8bf(ur + 2048); } }
        const int pgk = p0 + 4 * wv + (lane >> 4);
        V8 xgk = ld8bf(U + (size_t)pos_row(b, pgk) * O_IN + 2560 + 8 * (lane & 15));
#pragma unroll
        for (int q = 0; q < 4; ++q) { const int p = p0 + wv + 8 * q; const int t = p - C; const int hd = lane >> 4, d0 = 8 * (lane & 15);
            if (lat) { rope1d_8(xk[q], lane, t, r1t, rscale); rope1d_8(xq[q], lane, t, r1t, 1.f);
                st8bf(XNb + XN_QR + ((size_t)(b * 4 + hd) * S + t) * 128 + d0, xq[q]);
                chunk_norm_rope(xg[q], gq8, lane, t, axt, 0.125f * 1.4426950408889634f);
                st8bf(XNb + XN_GQ + ((size_t)(b * 8 + (lane >> 3)) * S + t) * 64 + 8 * (lane & 7), xg[q]); }
            else {
#pragma unroll
                for (int i = 0; i < 8; ++i) xk[q].v[i] *= rscale; }
            st8bf(ATb + ATT_KR + ((size_t)(b * 4 + hd) * NPOS + p) * 128 + d0, xk[q]); }
        chunk_norm_rope(xgk, gk8, lane, lat ? pgk - C : -1, axt, 1.f);
        st8bf(ATb + ATT_GK + ((size_t)(b * 2 + ((lane >> 3) & 1)) * NPOS + pgk) * 64 + 8 * (lane & 7), xgk);
        __syncthreads();
#pragma unroll
        for (int rr = 0; rr < 2; ++rr) { const int r = tid + 512 * rr;
            if (r < 640) { unsigned w[16];
#pragma unroll
                for (int i = 0; i < 16; ++i) { const unsigned lo = vs[(2 * i) * 642 + r], hi = vs[(2 * i + 1) * 642 + r]; w[i] = lo | (hi << 16); }
                bf16_t* dr = r < 512 ? ATb + ATT_VRT + ((size_t)(b * 4 + (r >> 7)) * 128 + (r & 127)) * NPOS : ATb + ATT_GVT + ((size_t)(b * 2 + ((r - 512) >> 6)) * 64 + ((r - 512) & 63)) * NPOS;
                u32x4* d = (u32x4*)(dr + p0);
#pragma unroll
                for (int i = 0; i < 4; ++i) { u32x4 o = {w[4 * i], w[4 * i + 1], w[4 * i + 2], w[4 * i + 3]}; d[i] = o; } } }
    }
}

DI void ph_retention(const Args& a, unsigned char* lds, int bid, int nb) {
    const int tid = otid(); const int lane = tid & 63, wv = tid >> 6, q32 = lane & 31, hh = lane >> 5;
    const bf16_t* XNb = (const bf16_t*)(a.ws + WS_XN); const bf16_t* ATb = (const bf16_t*)(a.ws + WS_ATT);
    const bf16_t* U = (const bf16_t*)(a.ws + WS_U); bf16_t* MIX = (bf16_t*)(a.ws + WS_MIX);
    constexpr int KBUF = 64 * 272, VBUF = 128 * 136, TBUF = KBUF + VBUF;
    const bool xg = (nb % 8) == 0 && nb >= 8; const int xq = xg ? bid & 7 : 0, xj = xg ? bid >> 3 : bid, xn = xg ? nb >> 3 : nb, nxu = xg ? 32 : 256;
    for (int ui = xj; ui < nxu; ui += xn) {
        const int bh = xg ? xq + 8 * (ui >> 3) : ui >> 3, qb = ui & 7, b = bh >> 2, h = bh & 3, T0 = qb * 256;
        const int t = T0 + wv * 32 + q32;
        const float df = a.in[I_RETDEC][h], db = a.in[I_RETDEC][4 + h];
        const float lf = (fminf(df, 0.f) - log1pf(expf(-fabsf(df)))) * 1.4426950408889634f, lb = (fminf(db, 0.f) - log1pf(expf(-fabsf(db)))) * 1.4426950408889634f;
        bf16x8 qf[8];
        { const bf16_t* qg = XNb + XN_QR + ((size_t)bh * S + t) * 128 + 8 * hh;
#pragma unroll
          for (int ks = 0; ks < 8; ++ks) qf[ks] = *(const bf16x8*)(qg + 16 * ks); }
        const bf16_t* Kg = ATb + ATT_KR + (size_t)bh * NPOS * 128; const bf16_t* Vg = ATb + ATT_VRT + (size_t)bh * 128 * NPOS;
        float* tab = (float*)(lds + 2 * TBUF); const f32x4* tabf = (const f32x4*)tab; const f32x4* tabb = (const f32x4*)(tab + 64);
        __syncthreads();
        if (tid < 64) { tab[tid] = __builtin_amdgcn_exp2f(-(float)tid * lf); tab[64 + tid] = __builtin_amdgcn_exp2f((float)tid * lb); }
        u32x4 st[4];
        auto gload = [&](int tt) {
#pragma unroll
            for (int i = 0; i < 2; ++i) { const int c = tid + 512 * i;
                st[i] = *(const u32x4*)(Kg + ((size_t)tt * 64 + (c >> 4)) * 128 + (c & 15) * 8);
                st[2 + i] = *(const u32x4*)(Vg + (size_t)(c >> 3) * NPOS + tt * 64 + (c & 7) * 8); } };
        auto lstore = [&](int buf) {
            unsigned char* kb = lds + buf * TBUF; unsigned char* vb = kb + KBUF;
#pragma unroll
            for (int i = 0; i < 2; ++i) { const int c = tid + 512 * i;
                *(u32x4*)(kb + (c >> 4) * 272 + (c & 15) * 16) = st[i];
                u32x2* d = (u32x2*)(vb + (c >> 3) * 136 + (c & 7) * 16); u32x2 lo = {st[2 + i].x, st[2 + i].y}, hi = {st[2 + i].z, st[2 + i].w}; d[0] = lo; d[1] = hi; } };
        __syncthreads();
        gload(0); lstore(0);
        __syncthreads();
        f32x16 O[4];
#pragma unroll
        for (int d = 0; d < 4; ++d)
#pragma unroll
            for (int i = 0; i < 16; ++i) O[d][i] = 0.f;
        for (int tt = 0; tt < 36; ++tt) {
            if (tt + 1 < 36) gload(tt + 1);
            const unsigned char* kb = lds + (tt & 1) * TBUF; const unsigned char* vb = kb + KBUF;
            f32x16 S0, S1;
#pragma unroll
            for (int i = 0; i < 16; ++i) { S0[i] = 0.f; S1[i] = 0.f; }
#pragma unroll
            for (int ks = 0; ks < 8; ++ks) {
                const bf16x8 k0 = *(const bf16x8*)(kb + q32 * 272 + 32 * ks + 16 * hh), k1 = *(const bf16x8*)(kb + (32 + q32) * 272 + 32 * ks + 16 * hh);
                S0 = MFMA32(k0, qf[ks], S0); S1 = MFMA32(k1, qf[ks], S1);
                if (ks & 1) __builtin_amdgcn_sched_barrier(0);
            }
            const int p0 = tt * 64; const int s0 = p0 - C;
            const int type = tt < 4 ? 0 : (s0 + 64 <= T0 ? 1 : (s0 >= T0 + 256 ? 2 : 3));
            const float bf0 = (float)(t + C - p0 - 4 * hh) * lf;
            const float bb0 = (float)((tt < 4 ? p0 + S : s0) + 4 * hh - t) * lb;
            const float basef = __builtin_amdgcn_exp2f(bf0), baseb = __builtin_amdgcn_exp2f(bb0);
            const int dfl = t - (tt < 4 ? 0 : s0) - 4 * hh;
#pragma unroll
            for (int k = 0; k < 4; ++k) {
                const f32x4 f0 = tabf[2 * k], f1 = tabf[8 + 2 * k], g0 = tabb[2 * k], g1 = tabb[8 + 2 * k];
#pragma unroll
                for (int j = 0; j < 4; ++j) {
                    float w0, w1;
                    if (type == 1) { w0 = basef * f0[j]; w1 = basef * f1[j]; }
                    else if (type == 2) { w0 = baseb * g0[j]; w1 = baseb * g1[j]; }
                    else if (type == 0) { w0 = basef * f0[j] + baseb * g0[j]; w1 = basef * f1[j] + baseb * g1[j]; }
                    else { const int d0 = dfl - (8 * k + j), d1 = d0 - 32;
                        w0 = (d0 >= 0 ? basef * f0[j] : 0.f) + (d0 <= 0 ? baseb * g0[j] : 0.f); w1 = (d1 >= 0 ? basef * f1[j] : 0.f) + (d1 <= 0 ? baseb * g1[j] : 0.f); }
                    S0[4 * k + j] *= w0; S1[4 * k + j] *= w1;
                }
                __builtin_amdgcn_sched_barrier(0);
            }
            __builtin_amdgcn_sched_barrier(0);
            const bf16x8 p00 = pack8(S0, 0), p01 = pack8(S0, 1), p10 = pack8(S1, 0), p11 = pack8(S1, 1);
#pragma unroll
            for (int d = 0; d < 4; ++d) {
                const unsigned char* vr = vb + (32 * d + q32) * 136 + 8 * hh;
                auto vfrag = [&](int koff) { const s16x4 lo = *(const s16x4*)(vr + koff * 2), hi = *(const s16x4*)(vr + koff * 2 + 16); return __builtin_shufflevector(lo, hi, 0, 1, 2, 3, 4, 5, 6, 7); };
                O[d] = MFMA32(vfrag(0), p00, O[d]); O[d] = MFMA32(vfrag(16), p01, O[d]); O[d] = MFMA32(vfrag(32), p10, O[d]); O[d] = MFMA32(vfrag(48), p11, O[d]);
                __builtin_amdgcn_sched_barrier(0);
            }
            if (tt + 1 < 36) lstore((tt + 1) & 1);
            __syncthreads();
        }
        const int tid2 = otid(), q32e = tid2 & 31, hhe = (tid2 >> 5) & 1, wve = tid2 >> 6;
        float sm = 0.f;
#pragma unroll
        for (int d = 0; d < 4; ++d)
#pragma unroll
            for (int i = 0; i < 16; ++i) sm += O[d][i];
        sm += __shfl_xor(sm, 32); const float mu = sm * (1.f / 128.f); float sq = 0.f;
#pragma unroll
        for (int d = 0; d < 4; ++d)
#pragma unroll
            for (int i = 0; i < 16; ++i) { O[d][i] -= mu; sq += O[d][i] * O[d][i]; }
        sq += __shfl_xor(sq, 32); const float rs = 1.f / sqrtf(sq * (1.f / 128.f) + EPS);
        bf16_t* ob = (bf16_t*)lds;
#pragma unroll
        for (int d = 0; d < 4; ++d)
#pragma unroll
            for (int i = 0; i < 16; ++i) ob[(wve * 32 + q32e) * 136 + 32 * d + crow16(i, hhe)] = (bf16_t)f2bf(O[d][i] * rs);
        __syncthreads();
#pragma unroll
        for (int i = 0; i < 8; ++i) { const int c = tid2 + 512 * i, qq = c >> 4, part = c & 15; const int m = b * S + T0 + qq;
            const u32x2* s = (const u32x2*)(ob + qq * 136 + part * 8); const u32x2 lo = s[0], hi = s[1];
            const u32x4 gw = *(const u32x4*)(U + (size_t)m * O_IN + 1536 + h * 128 + part * 8);
            const float* gn = a.in[I_RETGN] + h * 128 + part * 8;
            const unsigned ow[4] = {lo.x, lo.y, hi.x, hi.y}; const unsigned gww[4] = {gw.x, gw.y, gw.z, gw.w}; unsigned r[4];
#pragma unroll
            for (int q = 0; q < 4; ++q) { const float o0 = __uint_as_float(ow[q] << 16), o1 = __uint_as_float(ow[q] & 0xffff0000u), g0 = __uint_as_float(gww[q] << 16), g1 = __uint_as_float(gww[q] & 0xffff0000u);
                r[q] = pk2(o0 * gn[2 * q] * silu_f(g0), o1 * gn[2 * q + 1] * silu_f(g1)); }
            u32x4 w = {r[0], r[1], r[2], r[3]};
            *(u32x4*)(MIX + (size_t)m * D + h * 128 + part * 8) = w; }
    }
}

DI void ph_gqa(const Args& a, unsigned char* lds, int bid, int nb) {
    const int tid = otid(); const int lane = tid & 63, wv = tid >> 6, q32 = lane & 31, hh = lane >> 5, g = wv >> 1, qsub = wv & 1;
    const bf16_t* XNb = (const bf16_t*)(a.ws + WS_XN); const bf16_t* ATb = (const bf16_t*)(a.ws + WS_ATT); bf16_t* MIX = (bf16_t*)(a.ws + WS_MIX);
    constexpr int KBUF = 64 * 144, VBUF = 64 * 136, TBUF = KBUF + VBUF;
    const bool xg = (nb % 8) == 0 && nb >= 8; const int xq = xg ? bid & 7 : 0, xj = xg ? bid >> 3 : bid, xn = xg ? nb >> 3 : nb, nxu = xg ? 64 : 512;
    for (int ui = xj; ui < nxu; ui += xn) {
        const int u = xg ? xq * 64 + ui : ui;
        const int b = u >> 6, kv = (u >> 5) & 1, qblk = u & 31, T0 = qblk * 64; const int hd = kv * 4 + g; const int t = T0 + qsub * 32 + q32;
        const float sink2 = a.in[I_GQSINK][hd] * 1.4426950408889634f;
        bf16x8 qf[4];
        { const bf16_t* qg = XNb + XN_GQ + ((size_t)(b * 8 + hd) * S + t) * 64 + 8 * hh;
#pragma unroll
          for (int ks = 0; ks < 4; ++ks) qf[ks] = *(const bf16x8*)(qg + 16 * ks); }
        const bf16_t* Kg = ATb + ATT_GK + (size_t)(b * 2 + kv) * NPOS * 64; const bf16_t* Vg = ATb + ATT_GVT + (size_t)(b * 2 + kv) * 64 * NPOS;
        auto tile_p = [&](int i) { return i < 4 ? 64 * i : C + T0 - 128 + 64 * (i - 4); };
        auto tile_ok = [&](int i) { if (i < 4) return true; const int s0 = T0 - 128 + 64 * (i - 4); return s0 >= 0 && s0 < S; };
        u32x4 st[2];
        auto gload = [&](int i) { const int p = tile_p(i);
            st[0] = *(const u32x4*)(Kg + ((size_t)p + (tid >> 3)) * 64 + (tid & 7) * 8);
            st[1] = *(const u32x4*)(Vg + (size_t)(tid >> 3) * NPOS + p + (tid & 7) * 8); };
        auto lstore = [&](int buf) {
            unsigned char* kb = lds + buf * TBUF; unsigned char* vb = kb + KBUF;
            *(u32x4*)(kb + (tid >> 3) * 144 + (tid & 7) * 16) = st[0];
            u32x2* d = (u32x2*)(vb + (tid >> 3) * 136 + (tid & 7) * 16); u32x2 lo = {st[1].x, st[1].y}, hi = {st[1].z, st[1].w}; d[0] = lo; d[1] = hi; };
        __syncthreads();
        gload(0); lstore(0);
        __syncthreads();
        f32x16 O[2];
#pragma unroll
        for (int d = 0; d < 2; ++d)
#pragma unroll
            for (int i = 0; i < 16; ++i) O[d][i] = 0.f;
        float m_run = -1e30f, l_run = 0.f;
        int buf = 0;
        for (int ti = 0; ti < 9; ++ti) {
            if (!tile_ok(ti)) continue;
            int nx = ti + 1; while (nx < 9 && !tile_ok(nx)) ++nx;
            if (nx < 9) gload(nx);
            const unsigned char* kb = lds + buf * TBUF; const unsigned char* vb = kb + KBUF;
            f32x16 S0, S1;
#pragma unroll
            for (int i = 0; i < 16; ++i) { S0[i] = 0.f; S1[i] = 0.f; }
#pragma unroll
            for (int ks = 0; ks < 4; ++ks) {
                const bf16x8 k0 = *(const bf16x8*)(kb + q32 * 144 + 32 * ks + 16 * hh), k1 = *(const bf16x8*)(kb + (32 + q32) * 144 + 32 * ks + 16 * hh);
                S0 = MFMA32(k0, qf[ks], S0); S1 = MFMA32(k1, qf[ks], S1);
            }
            if (ti >= 4) {
                const int dl = T0 - 128 + 64 * (ti - 4) + 4 * hh - t;
#pragma unroll
                for (int i = 0; i < 16; ++i) { const int d0 = dl + (i & 3) + 8 * (i >> 2), d1 = d0 + 32;
                    if (d0 < -128 || d0 > 128) S0[i] = -1e30f; if (d1 < -128 || d1 > 128) S1[i] = -1e30f; }
            }
            float mx = S0[0];
#pragma unroll
            for (int i = 1; i < 16; ++i) mx = fmaxf(mx, S0[i]);
#pragma unroll
            for (int i = 0; i < 16; ++i) mx = fmaxf(mx, S1[i]);
            mx = fmaxf(mx, __shfl_xor(mx, 32));
            const float m_new = fmaxf(m_run, mx); const float alpha = __builtin_amdgcn_exp2f(m_run - m_new); m_run = m_new;
            float rsum = 0.f;
#pragma unroll
            for (int i = 0; i < 16; ++i) { S0[i] = __builtin_amdgcn_exp2f(S0[i] - m_new); S1[i] = __builtin_amdgcn_exp2f(S1[i] - m_new); rsum += S0[i] + S1[i]; }
            rsum += __shfl_xor(rsum, 32);
            l_run = l_run * alpha + rsum;
            if (!__all(alpha == 1.f)) {
#pragma unroll
            for (int d = 0; d < 2; ++d)
#pragma unroll
                for (int i = 0; i < 16; ++i) O[d][i] *= alpha; }
            const bf16x8 p00 = pack8(S0, 0), p01 = pack8(S0, 1), p10 = pack8(S1, 0), p11 = pack8(S1, 1);
#pragma unroll
            for (int d = 0; d < 2; ++d) {
                const unsigned char* vr = vb + (32 * d + q32) * 136 + 8 * hh;
                auto vfrag = [&](int koff) { const s16x4 lo = *(const s16x4*)(vr + koff * 2), hi = *(const s16x4*)(vr + koff * 2 + 16); return __builtin_shufflevector(lo, hi, 0, 1, 2, 3, 4, 5, 6, 7); };
                O[d] = MFMA32(vfrag(0), p00, O[d]); O[d] = MFMA32(vfrag(16), p01, O[d]); O[d] = MFMA32(vfrag(32), p10, O[d]); O[d] = MFMA32(vfrag(48), p11, O[d]);
            }
            if (nx < 9) lstore(buf ^ 1);
            buf ^= 1;
            __syncthreads();
        }
        const float il = 1.f / (l_run + __builtin_amdgcn_exp2f(sink2 - m_run));
        bf16_t* ob = (bf16_t*)(lds + 2 * TBUF);
#pragma unroll
        for (int d = 0; d < 2; ++d)
#pragma unroll
            for (int i = 0; i < 16; ++i) ob[(qsub * 32 + q32) * 264 + g * 64 + 32 * d + crow16(i, hh)] = (bf16_t)f2bf(O[d][i] * il);
        __syncthreads();
#pragma unroll
        for (int i = 0; i < 4; ++i) { const int c = tid + 512 * i, qq = c >> 5, part = c & 31;
            const u32x4 w = *(const u32x4*)(ob + qq * 264 + part * 8);
            *(u32x4*)(MIX + (size_t)(b * S + T0 + qq) * D + 512 + kv * 256 + part * 8) = w; }
    }
}

constexpr int N_PHASES = 20;
#ifndef DUPMASK
#define DUPMASK 0u
#endif
#define DUP(k) (((DUPMASK) >> (k)) & 1u)
#ifndef ABLV
#define ABLV 0
#endif
DI int opq(int v) { asm volatile("" : "+s"(v)); return v; }
template <class Epi> DI void run_gemm(LAS unsigned char* lds, const bf16_t* A, const bf16_t* Bt, int M, int N, int K, const Epi& E) {
    pg8::Gemm g{A, Bt, M, N, opq(K)}; pg8::StaticOrder So; So.init(M, N, (int)gridDim.x, (int)blockIdx.x);
    pg8::gemm_phase<Epi, pg8::StaticOrder, true, true>(lds, g, So, E);
}
struct L1Order {
    pg8::StaticOrder so; int G, c;
    __device__ void init(int G_, int c_) { so.init(MLAT, O_IN, G_, c_); G = G_; c = c_; }
    __device__ bool next(int i, pg8::Unit& u) const {
        if (so.next(i, u)) return true;
        const int L = i * G + c - 64 * 11; if (L < 0 || L >= 40) return false;
        const int q = L % 5; u.pm = 64 + L / 5; u.pn = q < 4 ? 2 + q : 10; return true; }
    __device__ __forceinline__ void a_ready(const pg8::Unit&) const {}
    __device__ __forceinline__ void done(const pg8::Unit&) const {}
};
DI void moe_gemm1(const Args& a, float* lds, LAS unsigned char* ldsl, int l) {
    int* tab = (int*)(lds + 33792); moe_tables(a, tab, l, otid());
    pg8::Gemm g{(const bf16_t*)(a.ws + WS_XN), (const bf16_t*)(a.ws + WS_MW1), MOE_MAXT * 256, 32 * 512, opq(D)};
    MoeOrder<2> So{tab, (int)gridDim.x, (int)blockIdx.x, (const int*)(a.ws + WS_ELIST)}; EpiSwiGLU E{(bf16_t*)(a.ws + WS_MIX), (const float*)(a.ws + WS_ELIST) + (size_t)32 * MALL, tab};
    pg8::gemm_phase<EpiSwiGLU, MoeOrder<2>, true, true, true>(ldsl, g, So, E);
}
DI void moe_gemm2(const Args& a, float* lds, LAS unsigned char* ldsl, int l) {
    int* tab = (int*)(lds + 33792); moe_tables(a, tab, l, otid());
    pg8::Gemm g{(const bf16_t*)(a.ws + WS_MIX), (const bf16_t*)(a.ws + WS_MW2), MOE_MAXT * 256, 32 * 1024, opq(256)};
    MoeOrder<4> So{tab, (int)gridDim.x, (int)blockIdx.x, nullptr}; EpiStoreY E{(bf16_t*)(a.ws + WS_U)};
    pg8::gemm_phase<EpiStoreY, MoeOrder<4>, true, true>(ldsl, g, So, E);
}
__global__ void __launch_bounds__(NTHR, 2) fwd_kernel(Args a) {
    extern __shared__ __attribute__((aligned(16))) unsigned char lds_raw[];
    float* lds = (float*)lds_raw;
    LAS unsigned char* ldsl = (LAS unsigned char*)lds_raw;
    volatile LAS unsigned* MISC = (volatile LAS unsigned*)(ldsl + LDS_BYTES - 64);
    const int bid = blockIdx.x, nb = gridDim.x;
    if (threadIdx.x < 16) MISC[threadIdx.x] = 0u;
    __syncthreads();
    XcdBarrier bar; bar.bar = (unsigned*)(a.ws + WS_CTL); bar.x = 0; bar.st = nullptr;
    const bool multi = (a.ph_hi - a.ph_lo) > 1;
    if (multi) bar = xcd_barrier_post((unsigned*)(a.ws + WS_CTL), MISC);
    const float* modb = (const float*)(a.ws + WS_MOD);
    bf16_t* U = (bf16_t*)(a.ws + WS_U); bf16_t* MIX = (bf16_t*)(a.ws + WS_MIX); bf16_t* XN = (bf16_t*)(a.ws + WS_XN); float* HC = (float*)(a.ws + WS_HC);
    const int lo = a.ph_lo, hi = a.ph_hi;
#define IN(k) (lo <= (k) && (k) < hi)
#define SEAM(k) do { if (IN(k) && IN((k) + 1)) xcd_barrier(bar); } while (0)
    if (IN(0)) { ph_init(a, lds, bid, nb); if (DUP(0)) { __syncthreads(); ph_init(a, lds, bid, nb); } } SEAM(0);
    if (IN(1)) { ph_norm(a, bid, nb, MALL, modb, 0, 1024, a.in[I_X], a.in[I_CTX]); if (DUP(1)) ph_norm(a, bid, nb, MALL, modb, 0, 1024, a.in[I_X], a.in[I_CTX]); } SEAM(1);
    if (IN(2)) { EpiStoreL0 E{(bf16_t*)(a.ws + WS_UT), (bf16_t*)(a.ws + WS_UA)}; run_gemm(ldsl, XN, (const bf16_t*)(a.ws + WS_WEIN), MALL, E_IN, D, E); if (DUP(2)) run_gemm(ldsl, XN, (const bf16_t*)(a.ws + WS_WEIN), MALL, E_IN, D, E); } SEAM(2);
    if (IN(3)) { ph_prep0(a, lds, bid, nb); if (DUP(3)) ph_prep0(a, lds, bid, nb); } SEAM(3);
    if (IN(4)) { if (DUP(20)) { ph_diffattn(a, lds_raw, bid, nb); __syncthreads(); } ph_diffattn(a, lds_raw, bid, nb); __syncthreads(); if (DUP(23)) { ph_hyena(a, lds_raw, bid, nb, true); __syncthreads(); } ph_hyena(a, lds_raw, bid, nb); xcd_barrier(bar); ph_hy_transpose(a, lds, bid, nb); if (DUP(24)) ph_hy_transpose(a, lds, bid, nb); } SEAM(4);
    if (IN(5)) { EpiResid E{a.in[I_X], a.in[I_CTX], a.out, HC, modb, 2048}; run_gemm(ldsl, MIX, (const bf16_t*)(a.ws + WS_WEOUT), MALL, D, D, E); if (DUP(5)) run_gemm(ldsl, MIX, (const bf16_t*)(a.ws + WS_WEOUT), MALL, D, D, E); } SEAM(5);
    if (IN(6)) { ph_route(a, lds, bid, nb, 0, MALL); if (DUP(6)) ph_route(a, lds, bid, nb, 0, MALL, true); } if (IN(6) && IN(8)) xcd_barrier(bar);
    if (IN(8)) { moe_gemm1(a, lds, ldsl, 0); if (DUP(8)) moe_gemm1(a, lds, ldsl, 0); } SEAM(8);
    if (IN(9)) { moe_gemm2(a, lds, ldsl, 0); if (DUP(9)) moe_gemm2(a, lds, ldsl, 0); } SEAM(9);
    if (IN(10)) { ph_combine(a, lds, bid, nb, 0, MALL, true); } SEAM(10);
    if (IN(11)) { EpiStoreBf16 E{U, O_IN}; pg8::Gemm g{XN, (const bf16_t*)(a.ws + WS_WOIN), MALL, O_IN, opq(D)}; L1Order So; So.init((int)gridDim.x, (int)blockIdx.x);
        pg8::gemm_phase<EpiStoreBf16, L1Order, true, true>(ldsl, g, So, E); } SEAM(11);
    if (IN(12)) { ph_prep1(a, lds, bid, nb); ph_moe_convert(a, lds, bid, nb, 1); if (DUP(12)) { ph_prep1(a, lds, bid, nb); } if (DUP(25)) { ph_moe_convert(a, lds, bid, nb, 1); } } SEAM(12);
    if (IN(13)) { ph_retention(a, lds_raw, bid, nb); __syncthreads(); if (DUP(21)) { ph_retention(a, lds_raw, bid, nb); __syncthreads(); } ph_gqa(a, lds_raw, bid, nb); if (DUP(22)) { __syncthreads(); ph_gqa(a, lds_raw, bid, nb); } } SEAM(13);
    if (IN(14)) { EpiResid E{a.out, HC, a.out, HC, modb + 9 * 6144, 2048}; run_gemm(ldsl, MIX, (const bf16_t*)(a.ws + WS_WOOUT), MLAT, D, D, E); } SEAM(14);
    if (IN(15)) { ph_route(a, lds, bid, nb, 1, MLAT); } if (IN(15) && IN(17)) xcd_barrier(bar);
    if (IN(17)) { moe_gemm1(a, lds, ldsl, 1); } SEAM(17);
    if (IN(18)) { moe_gemm2(a, lds, ldsl, 1); } SEAM(18);
    if (IN(19)) { ph_combine(a, lds, bid, nb, 1, MLAT, false); }
#undef IN
#undef SEAM
}

extern "C" void kernel_launch(void* const* d_in, const int* in_sizes, int n_in, void* d_out, int out_size, void* d_ws, size_t ws_size, hipStream_t stream) {
    static int grid = 0;
    if (grid == 0) {
        if (n_in != N_IN || out_size != MLAT * D || ws_size < WS_END) { fprintf(stderr, "kernel_launch: unexpected shapes (n_in %d out %d ws %zu)\n", n_in, out_size, ws_size); grid = -1; return; }
        int dev = 0, cus = 0;
        if (hipGetDevice(&dev) != hipSuccess || hipDeviceGetAttribute(&cus, hipDeviceAttributeMultiprocessorCount, dev) != hipSuccess) { grid = -1; return; }
        if (hipFuncSetAttribute((const void*)fwd_kernel, hipFuncAttributeMaxDynamicSharedMemorySize, LDS_BYTES) != hipSuccess) { grid = -1; return; }
        grid = cus;
    }
    if (grid < 0) return;
    (void)hipMemsetAsync((char*)d_ws + WS_CTL, 0, CTL_ZERO_BYTES, stream);
    Args a{};
    for (int i = 0; i < N_IN; ++i) a.in[i] = (const float*)d_in[i];
    a.out = (float*)d_out; a.ws = (unsigned char*)d_ws;
#if MK_PER_PHASE
    for (int p = 0; p < N_PHASES; ++p) { a.ph_lo = p; a.ph_hi = p + 1; hipLaunchKernelGGL(fwd_kernel, dim3(grid), dim3(NTHR), LDS_BYTES, stream, a); }
#else
    a.ph_lo = 0; a.ph_hi = N_PHASES;
    hipLaunchKernelGGL(fwd_kernel, dim3(grid), dim3(NTHR), LDS_BYTES, stream, a);
#endif
}
```
